# Optimizing an MI355X kernel written in HIP

```python
import math
import jax, jax.numpy as jnp
from jax import lax
import numpy as np

D_MODEL = 1024
BATCH = 16
SEQ = 2048
DEPTH = 2

CHUNK = 64
D_PLE = 256
EPS = 1e-6

A_HEADS = 8
A_HEAD_DIM = 64
A_WIDTH = A_HEADS * A_HEAD_DIM
A_LEFT_CHUNKS = 8
A_BAND = (A_LEFT_CHUNKS + 1) * CHUNK
REL_MAX = 128

B_HEADS = 4
B_NOPE = 128
B_ROPE = 64
B_VDIM = 128
B_WIDTH = B_HEADS * B_VDIM
Q_LORA = 256
KV_LORA = 128
ROPE_THETA = 10000.0
Q_BLOCK = 128
MAX_POS_OFFSET = 4096

D_MIX = A_WIDTH + B_WIDTH
IN_SIZES = (A_WIDTH, A_WIDTH, A_WIDTH, A_WIDTH, Q_LORA, KV_LORA, B_ROPE, B_WIDTH)
D_IN = 4 * A_WIDTH + Q_LORA + KV_LORA + B_ROPE + B_WIDTH

kernel_name = "hybrid_chunked_relpos_mla_trunk"


def rmsnorm(x, g):
    xf = x.astype(jnp.float32)
    y = xf * lax.rsqrt(jnp.mean(xf * xf, axis=-1, keepdims=True) + EPS)
    return (y * g.astype(jnp.float32)).astype(x.dtype)


def split_cols(z, sizes):
    idx = np.cumsum(np.array(sizes[:-1])).tolist()
    return jnp.split(z, idx, axis=-1)


def rope_tables(positions, dim):
    inv_freq = ROPE_THETA ** (-jnp.arange(0, dim, 2, dtype=jnp.float32) / dim)
    ang = positions.astype(jnp.float32)[..., None] * inv_freq
    return jnp.cos(ang), jnp.sin(ang)


def apply_rope(x, cos, sin):
    half = x.shape[-1] // 2
    x1 = x[..., :half].astype(jnp.float32)
    x2 = x[..., half:].astype(jnp.float32)
    out = jnp.concatenate([x1 * cos - x2 * sin, x2 * cos + x1 * sin], axis=-1)
    return out.astype(x.dtype)


def chunked_relpos_attention(q, k, v, rel_bias):
    B, S = q.shape[0], q.shape[1]
    nc = S // CHUNK
    qc = q.reshape(B, nc, CHUNK, A_HEADS, A_HEAD_DIM)
    pad = jnp.zeros((B, A_LEFT_CHUNKS * CHUNK, A_HEADS, A_HEAD_DIM), k.dtype)
    kc = jnp.concatenate([pad, k], axis=1).reshape(B, nc + A_LEFT_CHUNKS, CHUNK, A_HEADS, A_HEAD_DIM)
    vc = jnp.concatenate([pad, v], axis=1).reshape(B, nc + A_LEFT_CHUNKS, CHUNK, A_HEADS, A_HEAD_DIM)
    band = jnp.arange(nc)[:, None] + jnp.arange(A_LEFT_CHUNKS + 1)[None, :]
    kb = kc[:, band].reshape(B, nc, A_BAND, A_HEADS, A_HEAD_DIM)
    vb = vc[:, band].reshape(B, nc, A_BAND, A_HEADS, A_HEAD_DIM)
    s = jnp.einsum('bnqhd,bnkhd->bhnqk', qc, kb).astype(jnp.float32) * (A_HEAD_DIM ** -0.5)
    q_off = jnp.arange(CHUNK) + A_LEFT_CHUNKS * CHUNK
    k_off = jnp.arange(A_BAND)
    rel = jnp.clip(q_off[:, None] - k_off[None, :], -REL_MAX, REL_MAX) + REL_MAX
    bias = rel_bias.astype(jnp.float32)[:, rel]
    valid = jnp.repeat(band >= A_LEFT_CHUNKS, CHUNK, axis=1)
    s = jnp.where(valid[None, None, :, None, :], s + bias[:, None], -jnp.inf)
    pr = jax.nn.softmax(s, axis=-1).astype(v.dtype)
    o = jnp.einsum('bhnqk,bnkhd->bnqhd', pr, vb)
    return o.reshape(B, S, A_WIDTH)


def mla_attention(c_q, c_kv, k_rope_raw, g_q, w_uq, g_kv, w_ukv, cos, sin):
    B, S = c_q.shape[0], c_q.shape[1]
    q = (rmsnorm(c_q, g_q) @ w_uq).reshape(B, S, B_HEADS, B_NOPE + B_ROPE)
    q_nope, q_rope = q[..., :B_NOPE], q[..., B_NOPE:]
    q_rope = apply_rope(q_rope, cos[:, :, None, :], sin[:, :, None, :])
    kv = (rmsnorm(c_kv, g_kv) @ w_ukv).reshape(B, S, B_HEADS, B_NOPE + B_VDIM)
    k_nope, v = kv[..., :B_NOPE], kv[..., B_NOPE:]
    k_rope = apply_rope(k_rope_raw, cos, sin)
    scale = (B_NOPE + B_ROPE) ** -0.5
    nqb = S // Q_BLOCK
    qn = q_nope.reshape(B, nqb, Q_BLOCK, B_HEADS, B_NOPE).transpose(1, 0, 2, 3, 4)
    qr = q_rope.reshape(B, nqb, Q_BLOCK, B_HEADS, B_ROPE).transpose(1, 0, 2, 3, 4)
    key_chunk = jnp.arange(S) // CHUNK

    def block(args):
        qn_b, qr_b, qb = args
        s = (jnp.einsum('bqhd,bkhd->bhqk', qn_b, k_nope)
             + jnp.einsum('bqhd,bkd->bhqk', qr_b, k_rope)).astype(jnp.float32) * scale
        q_chunk = (qb * Q_BLOCK + jnp.arange(Q_BLOCK)) // CHUNK
        mask = key_chunk[None, :] <= q_chunk[:, None]
        s = jnp.where(mask[None, None], s, -jnp.inf)
        pr = jax.nn.softmax(s, axis=-1).astype(v.dtype)
        return jnp.einsum('bhqk,bkhd->bqhd', pr, v)

    o = lax.map(block, (qn, qr, jnp.arange(nqb)))
    return o.transpose(1, 0, 2, 3, 4).reshape(B, S, B_WIDTH)


def setup_inputs(seed: int = 0) -> dict:
    key = jax.random.key(seed)
    ks = jax.random.split(key, 20)
    f32 = jnp.float32
    nrm = lambda k, shape, fan_in: jax.random.normal(k, shape, f32) * (fan_in ** -0.5)
    gain = lambda k, shape: 1.0 + 0.05 * jax.random.normal(k, shape, f32)
    x = jax.random.normal(ks[0], (BATCH, SEQ, D_MODEL), f32)
    p = jax.random.normal(ks[1], (DEPTH, BATCH, SEQ, D_PLE), f32)
    offs = jax.random.randint(ks[2], (BATCH, 1), 0, MAX_POS_OFFSET, dtype=jnp.int32)
    positions = (jnp.arange(SEQ, dtype=jnp.int32)[None, :] + offs).astype(jnp.int32)
    return {
        "x": x,
        "p": p,
        "positions": positions,
        "norm_mix": gain(ks[3], (DEPTH, D_MODEL)),
        "w_in": nrm(ks[4], (DEPTH, D_MODEL, D_IN), D_MODEL),
        "rel_bias": 0.5 * jax.random.normal(ks[5], (DEPTH, A_HEADS, 2 * REL_MAX + 1), f32),
        "g_q": gain(ks[6], (DEPTH, Q_LORA)),
        "w_uq": nrm(ks[7], (DEPTH, Q_LORA, B_HEADS * (B_NOPE + B_ROPE)), Q_LORA),
        "g_kv": gain(ks[8], (DEPTH, KV_LORA)),
        "w_ukv": nrm(ks[9], (DEPTH, KV_LORA, B_HEADS * (B_NOPE + B_VDIM)), KV_LORA),
        "w_out": nrm(ks[10], (DEPTH, D_MIX, D_MODEL), D_MIX),
        "norm_ple": gain(ks[11], (DEPTH, D_MODEL)),
        "w_pe": nrm(ks[12], (DEPTH, D_PLE, D_MODEL), D_PLE),
        "w_pg": nrm(ks[13], (DEPTH, D_MODEL, D_MODEL), D_MODEL),
        "b_pg": 0.02 * jax.random.normal(ks[14], (DEPTH, D_MODEL), f32),
        "norm_final": gain(ks[15], (D_MODEL,)),
    }


def reference(x, p, positions, norm_mix, w_in, rel_bias, g_q, w_uq, g_kv, w_ukv, w_out,
              norm_ple, w_pe, w_pg, b_pg, norm_final):
    B, S = x.shape[0], x.shape[1]
    cos, sin = rope_tables(positions, B_ROPE)
    h = x
    for i in range(DEPTH):
        xn = rmsnorm(h, norm_mix[i])
        z = xn @ w_in[i]
        q_a, k_a, v_a, gate_a, c_q, c_kv, k_rope_raw, gate_b = split_cols(z, IN_SIZES)
        shp = (B, S, A_HEADS, A_HEAD_DIM)
        o_a = chunked_relpos_attention(q_a.reshape(shp), k_a.reshape(shp), v_a.reshape(shp), rel_bias[i])
        o_b = mla_attention(c_q, c_kv, k_rope_raw, g_q[i], w_uq[i], g_kv[i], w_ukv[i], cos, sin)
        mixed = jnp.concatenate([o_a * jax.nn.silu(gate_a), o_b * jax.nn.silu(gate_b)], axis=-1)
        h = h + mixed @ w_out[i]
        gate = jax.nn.sigmoid(rmsnorm(h, norm_ple[i]) @ w_pg[i] + b_pg[i])
        h = h + (p[i] @ w_pe[i]) * gate
    return rmsnorm(h, norm_final)
```

```cpp
#include <hip/hip_runtime.h>
#include <cstdio>
#include <cstdint>

#ifndef MK_N_LAUNCHES
#define MK_N_LAUNCHES 12
#endif
#ifndef MK_NAIVE
#define MK_NAIVE 0xF
#endif

constexpr int NB = 16, SEQ = 2048, T = NB * SEQ, DM = 1024, DIN = 3008, DINP = 3072, DPLE = 256, DEPTH = 2;
constexpr int DUP = 1792, KUP = 384;
constexpr float EPS = 1e-6f;
constexpr float LOG2E = 1.4426950408889634f;
constexpr float QA_SCALE = 0.125f * LOG2E;
constexpr float QB_SCALE = 0.07216878364870322f * LOG2E;
constexpr int ZC_QA = 0, ZC_KA = 512, ZC_VA = 1024, ZC_GA = 1536, ZC_GB = 2048, ZC_CQ = 2560, ZC_CKV = 2816, ZC_KR = 2944, ZC_PAD = 3008;
constexpr int UC_QN = 0, UC_QR = 512, UC_KN = 768, UC_V = 1280;

constexpr size_t MiB = 1u << 20;
constexpr size_t WS_CTL = 0, CTL_ZERO_BYTES = 1 * MiB;
constexpr size_t WS_WIN = 1 * MiB;
constexpr size_t WS_WUP = 13 * MiB;
constexpr size_t WS_WOUT = 16 * MiB;
constexpr size_t WS_WPG = 20 * MiB;
constexpr size_t WS_WPE = 24 * MiB;
constexpr size_t WS_CS = 25 * MiB;
constexpr size_t WS_SSQ1 = 33 * MiB;
constexpr size_t WS_SSQ2 = 37 * MiB;
constexpr size_t WS_SSQQ = 41 * MiB;
constexpr size_t WS_SSQKV = 42 * MiB;
constexpr size_t WS_PB = 43 * MiB;
constexpr size_t WS_BUFA = 75 * MiB;
constexpr size_t WS_BUFB = 139 * MiB;
constexpr size_t WS_Z = 203 * MiB;
constexpr size_t WS_U = 395 * MiB;
constexpr size_t WS_END = 507 * MiB;

constexpr int NWAVES = 8, NTHREADS = 512;
constexpr int RING_BYTES = 131072, LDSCTL_OFF = RING_BYTES, MISC_OFF = LDSCTL_OFF + 320, LDS_BYTES = 147456;

#define GAS __attribute__((address_space(1)))
#define LAS __attribute__((address_space(3)))
typedef unsigned short bf16;
typedef unsigned v4u __attribute__((ext_vector_type(4)));
typedef unsigned v2u __attribute__((ext_vector_type(2)));
typedef float f32x4 __attribute__((ext_vector_type(4)));
typedef float f32x2 __attribute__((ext_vector_type(2)));
typedef float f32x16 __attribute__((ext_vector_type(16)));
typedef short bf16x8 __attribute__((ext_vector_type(8)));
typedef short s16x4 __attribute__((ext_vector_type(4)));
typedef __bf16 bf16x2_t __attribute__((ext_vector_type(2)));
typedef GAS unsigned gu32;
#define RLX_AGENT __ATOMIC_RELAXED, __HIP_MEMORY_SCOPE_AGENT

__device__ __forceinline__ float bf2f(unsigned b) { return __uint_as_float(b << 16); }
__device__ __forceinline__ unsigned f2bf(float f) { unsigned u = __float_as_uint(f); return (u + 0x7fffu + ((u >> 16) & 1u)) >> 16; }
__device__ __forceinline__ unsigned pk2(float lo, float hi) { f32x2 v = {lo, hi}; bf16x2_t b = __builtin_convertvector(v, bf16x2_t); return __builtin_bit_cast(unsigned, b); }
__device__ __forceinline__ float silu_f(float v) { return v / (1.0f + __expf(-v)); }
__device__ __forceinline__ float sigmoid_f(float v) { return 1.0f / (1.0f + __expf(-v)); }
__device__ __forceinline__ void unpack8(v4u w, float (&f)[8]) {
    f[0] = bf2f(w.x & 0xffffu); f[1] = bf2f(w.x >> 16); f[2] = bf2f(w.y & 0xffffu); f[3] = bf2f(w.y >> 16);
    f[4] = bf2f(w.z & 0xffffu); f[5] = bf2f(w.z >> 16); f[6] = bf2f(w.w & 0xffffu); f[7] = bf2f(w.w >> 16);
}
__device__ __forceinline__ v4u pack8(const float (&f)[8]) { v4u w; w.x = pk2(f[0], f[1]); w.y = pk2(f[2], f[3]); w.z = pk2(f[4], f[5]); w.w = pk2(f[6], f[7]); return w; }

__device__ const float INV_FREQ[32] = {
    1.000000000e+00f, 7.498942614e-01f, 5.623413324e-01f, 4.216965139e-01f, 3.162277639e-01f, 2.371373773e-01f, 1.778279394e-01f, 1.333521307e-01f,
    1.000000015e-01f, 7.498941571e-02f, 5.623413250e-02f, 4.216965288e-02f, 3.162277490e-02f, 2.371373773e-02f, 1.778279431e-02f, 1.333521493e-02f,
    9.999999776e-03f, 7.498941850e-03f, 5.623413250e-03f, 4.216964822e-03f, 3.162277630e-03f, 2.371373586e-03f, 1.778279431e-03f, 1.333521446e-03f,
    1.000000047e-03f, 7.498942432e-04f, 5.623413017e-04f, 4.216965172e-04f, 3.162277571e-04f, 2.371373703e-04f, 1.778279402e-04f, 1.333521504e-04f};

#define XB_TMO      128
#define XB_XCNT(j)  (256  + 64 * (j))
#define XB_XSUB(j)  (1280 + 64 * (j))
#define XB_XGEN(j)  (2304 + 64 * (j))
#define XB_TOP      3328
#define XB_TOPGEN   3392
#define XCD_BAR_WORDS 3456
#define XB_SPIN_CAP (1u << 22)
constexpr int CW_BAR = 4096;

__device__ __forceinline__ unsigned xb_ld(unsigned* p)              { return __hip_atomic_load(p, __ATOMIC_RELAXED, __HIP_MEMORY_SCOPE_AGENT); }
__device__ __forceinline__ unsigned xb_add(unsigned* p, unsigned v) { return __hip_atomic_fetch_add(p, v, __ATOMIC_RELAXED, __HIP_MEMORY_SCOPE_AGENT); }
__device__ __forceinline__ unsigned xb_xcc_id() { return (unsigned)__builtin_amdgcn_s_getreg((3 << 11) | 20) & 0xFu; }
#define XB_SPIN(cond, bar) do { unsigned _sp = 0; while (cond) { __builtin_amdgcn_s_sleep(1); \
    if ((++_sp & 255u) == 0u) { if (xb_ld(&(bar)[XB_TMO])) break; if (_sp > XB_SPIN_CAP) { atomicAdd(&(bar)[XB_TMO], 1u); break; } } } } while (0)
struct XcdBarrier { unsigned* bar; unsigned x; volatile LAS unsigned* st; };
__device__ __forceinline__ XcdBarrier xcd_barrier_post(unsigned* bar, volatile LAS unsigned* st) {
    XcdBarrier b; b.bar = bar; b.x = xb_xcc_id(); b.st = st;
    if (threadIdx.x == 0) (void)xb_add(&bar[XB_XCNT(b.x)], 1u);
    return b;
}
__device__ __forceinline__ void xcd_barrier_complete(unsigned* bar, unsigned x, unsigned& nloc, unsigned& nx) {
    const unsigned G = gridDim.x * gridDim.y * gridDim.z;
    unsigned sum, cnt, mine, sp = 0u;
    for (;;) {
        sum = 0u; cnt = 0u; mine = 0u;
#pragma unroll
        for (unsigned j = 0; j < 16; ++j) { const unsigned c = xb_ld(&bar[XB_XCNT(j)]); sum += c; cnt += (c > 0u) ? 1u : 0u; mine = (j == x) ? c : mine; }
        if (sum == G) break;
        __builtin_amdgcn_s_sleep(1);
        if ((++sp & 255u) == 0u) { if (xb_ld(&bar[XB_TMO])) break; if (sp > XB_SPIN_CAP) { atomicAdd(&bar[XB_TMO], 1u); break; } }
    }
    nloc = mine > 0u ? mine : 1u; nx = cnt > 0u ? cnt : 1u;
}
__device__ __forceinline__ void xcd_barrier(const XcdBarrier& b) {
    asm volatile("s_waitcnt vmcnt(0)" ::: "memory");
    __syncthreads();
    if (threadIdx.x == 0) {
        unsigned* bar = b.bar;
        __builtin_amdgcn_s_waitcnt(0);
        unsigned nloc = b.st[0], nx = b.st[1];
        if (nloc == 0u) { xcd_barrier_complete(bar, b.x, nloc, nx); b.st[0] = nloc; b.st[1] = nx; }
        const unsigned old = xb_add(&bar[XB_XSUB(b.x)], 1u);
        const unsigned gen = old / nloc;
        if (old + 1u == (gen + 1u) * nloc) {
            __builtin_amdgcn_fence(__ATOMIC_RELEASE, "agent");
            asm volatile("s_waitcnt vmcnt(0)" ::: "memory");
            const unsigned og = xb_add(&bar[XB_TOP], 1u);
            const unsigned tg = og / nx;
            if (og + 1u == (tg + 1u) * nx) xb_add(&bar[XB_TOPGEN], 1u);
            else XB_SPIN(xb_ld(&bar[XB_TOPGEN]) == tg, bar);
            __builtin_amdgcn_fence(__ATOMIC_ACQUIRE, "agent");
            xb_add(&bar[XB_XGEN(b.x)], 1u);
            asm volatile("s_waitcnt vmcnt(0)" ::: "memory");
        } else {
            XB_SPIN(xb_ld(&bar[XB_XGEN(b.x)]) == gen, bar);
            __builtin_amdgcn_fence(__ATOMIC_ACQUIRE, "agent");
            asm volatile("s_waitcnt vmcnt(0)" ::: "memory");
        }
    }
    __syncthreads();
}

struct Args { const void* in[16]; float* out; unsigned char* ws; int ph_lo, ph_hi, li, pad; };
struct Frame {
    LAS unsigned char* lds;
    unsigned char* ws;
    int tid, lane, wave, vcu, G;
    const float *x, *p, *norm_mix, *w_in, *rel_bias, *g_q, *w_uq, *g_kv, *w_ukv, *w_out, *norm_ple, *w_pe, *w_pg, *b_pg, *norm_final;
    const int* positions;
    float* out;
};
__device__ __forceinline__ float wave_sum(float v) {
#pragma unroll
    for (int o = 1; o < 64; o <<= 1) v += __shfl_xor(v, o);
    return v;
}
__device__ __forceinline__ float wave_max(float v) {
#pragma unroll
    for (int o = 1; o < 64; o <<= 1) v = fmaxf(v, __shfl_xor(v, o));
    return v;
}

__device__ __forceinline__ float wsrc(const Frame& F, int mat, int L, int n, int k) {
    if (mat == 0) {
        int sc;
        if (n < 2048) sc = n;
        else if (n < ZC_CQ) sc = 2496 + (n - ZC_GB);
        else if (n < ZC_CKV) sc = 2048 + (n - ZC_CQ);
        else if (n < ZC_KR) sc = 2304 + (n - ZC_CKV);
        else if (n < ZC_PAD) { const int j = n - ZC_KR; sc = 2432 + (j >> 1) + 32 * (j & 1); }
        else return 0.f;
        return F.w_in[((size_t)L * DM + k) * DIN + sc] * F.norm_mix[L * DM + k];
    } else if (mat == 1) {
        if (n < UC_KN) {
            if (k >= 256) return 0.f;
            int sc;
            if (n < UC_QR) sc = (n >> 7) * 192 + (n & 127);
            else { const int j = (n - UC_QR) & 63, hh = (n - UC_QR) >> 6; sc = hh * 192 + 128 + (j >> 1) + 32 * (j & 1); }
            return F.w_uq[((size_t)L * 256 + k) * 768 + sc] * F.g_q[L * 256 + k];
        } else {
            if (k < 256) return 0.f;
            const int kk = k - 256; int sc;
            if (n < UC_V) { const int m = n - UC_KN; sc = (m >> 7) * 256 + (m & 127); }
            else { const int m = n - UC_V; sc = (m >> 7) * 256 + 128 + (m & 127); }
            return F.w_ukv[((size_t)L * 128 + kk) * 1024 + sc] * F.g_kv[L * 128 + kk];
        }
    } else if (mat == 2) return F.w_out[((size_t)L * DM + k) * DM + n];
    else if (mat == 3) return F.w_pg[((size_t)L * DM + k) * DM + n] * F.norm_ple[L * DM + k];
    else return F.w_pe[((size_t)L * DPLE + k) * DM + n];
}
__device__ __forceinline__ void p0_prologue(const Frame& F) {
    {
        LAS float* scr = (LAS float*)F.lds;
        constexpr int NT0 = (DINP / 64) * (DM / 64), NT1 = (DUP / 64) * (KUP / 64), NT2 = 16 * 16, NT3 = 16 * 16, NT4 = 16 * 4;
        constexpr int NTL = NT0 + NT1 + NT2 + NT3 + NT4;
        for (int it = F.vcu; it < 2 * NTL; it += F.G) {
            const int L = it / NTL; int r = it % NTL; int mat, K, tn, tk; size_t base;
            if (r < NT0) { mat = 0; K = DM; base = WS_WIN + (size_t)L * DINP * DM * 2; }
            else if ((r -= NT0) < NT1) { mat = 1; K = KUP; base = WS_WUP + (size_t)L * DUP * KUP * 2; }
            else if ((r -= NT1) < NT2) { mat = 2; K = DM; base = WS_WOUT + (size_t)L * DM * DM * 2; }
            else if ((r -= NT2) < NT3) { mat = 3; K = DM; base = WS_WPG + (size_t)L * DM * DM * 2; }
            else { r -= NT3; mat = 4; K = DPLE; base = WS_WPE + (size_t)L * DM * DPLE * 2; }
            const int nkt = K / 64; tn = r / nkt; tk = r % nkt;
            const int n0 = tn * 64, k0 = tk * 64;
#pragma unroll
            for (int e = 0; e < 8; ++e) { const int idx = F.tid + 512 * e, kk = idx >> 6, nn = idx & 63; scr[kk * 65 + nn] = wsrc(F, mat, L, n0 + nn, k0 + kk); }
            __syncthreads();
            unsigned* dst = (unsigned*)(F.ws + base);
#pragma unroll
            for (int e = 0; e < 4; ++e) { const int idx = F.tid + 512 * e, nn = idx >> 5, kp = idx & 31;
                dst[((size_t)(n0 + nn) * K + k0) / 2 + kp] = pk2(scr[(2 * kp) * 65 + nn], scr[(2 * kp + 1) * 65 + nn]); }
            __syncthreads();
        }
    }
    const int gw = F.vcu * NWAVES + F.wave, NGW = F.G * NWAVES;
    {
        bf16* hb = (bf16*)(F.ws + WS_BUFA); float* ssq = (float*)(F.ws + WS_SSQ2);
        for (int m = gw; m < T; m += NGW) {
            const f32x4* xr = (const f32x4*)(F.x + (size_t)m * DM) + F.lane;
            f32x4 v[4]; float s = 0.f;
#pragma unroll
            for (int j = 0; j < 4; ++j) { v[j] = xr[64 * j]; s += (v[j].x * v[j].x + v[j].y * v[j].y) + (v[j].z * v[j].z + v[j].w * v[j].w); }
            s = wave_sum(s);
            v2u* o8 = (v2u*)(hb + (size_t)m * DM) + F.lane;
#pragma unroll
            for (int j = 0; j < 4; ++j) { v2u w; w.x = pk2(v[j].x, v[j].y); w.y = pk2(v[j].z, v[j].w); o8[64 * j] = w; }
            if (F.lane < 32) ssq[(size_t)m * 32 + F.lane] = (F.lane == 0) ? s : 0.f;
        }
    }
    const int gt = F.vcu * NTHREADS + F.tid, NGT = F.G * NTHREADS;
    {
        v4u* pb = (v4u*)(F.ws + WS_PB);
        for (int i = gt; i < 2 * T * DPLE / 8; i += NGT) {
            const f32x4 a = ((const f32x4*)F.p)[2 * i], b = ((const f32x4*)F.p)[2 * i + 1];
            v4u w; w.x = pk2(a.x, a.y); w.y = pk2(a.z, a.w); w.z = pk2(b.x, b.y); w.w = pk2(b.z, b.w); pb[i] = w;
        }
    }
    {
        f32x2* cs = (f32x2*)(F.ws + WS_CS);
        for (int i = gt; i < T * 32; i += NGT) {
            const int t = i >> 5, fi = i & 31;
            const float angf = (float)F.positions[t] * INV_FREQ[fi];
            const double a = (double)angf;
            const double kq = __builtin_rint(a * 0.63661977236758134308);
            const double r = (a - kq * 1.57079632679489655800) - kq * 6.12323399573676603587e-17;
            const double r2 = r * r;
            const double sn = r * (1.0 + r2 * (-1.0 / 6 + r2 * (1.0 / 120 + r2 * (-1.0 / 5040 + r2 * (1.0 / 362880 + r2 * (-1.0 / 39916800))))));
            const double cn = 1.0 + r2 * (-0.5 + r2 * (1.0 / 24 + r2 * (-1.0 / 720 + r2 * (1.0 / 40320 + r2 * (-1.0 / 3628800 + r2 * (1.0 / 479001600))))));
            const int q = (int)((long long)kq & 3);
            const double c = (q == 0) ? cn : (q == 1) ? -sn : (q == 2) ? -cn : sn;
            const double s = (q == 0) ? sn : (q == 1) ? cn : (q == 2) ? -sn : -cn;
            cs[i] = (f32x2){(float)c, (float)s};
        }
    }
}

struct EpiP1 {
    static constexpr bool HAS_SSQ = true;
    bf16* Z; const float* ssq_h; float* ssq_q; float* ssq_kv; const f32x2* cs;
    __device__ __forceinline__ float rowsum_part(int row, int part, int) const { const f32x4* s = (const f32x4*)(ssq_h + (size_t)row * 32 + part * 8); const f32x4 a = s[0], b = s[1]; return ((a.x + a.y) + (a.z + a.w)) + ((b.x + b.y) + (b.z + b.w)); }
    __device__ __forceinline__ float rowscale_from(float tot, int) const { return rsqrtf(tot * (1.0f / DM) + EPS); }
    __device__ __forceinline__ float run8(int row, int col0, float rs, float (&v)[8]) const {
        float ss = 0.f;
#pragma unroll
        for (int j = 0; j < 8; ++j) v[j] *= rs;
        if (col0 < ZC_KA) {
#pragma unroll
            for (int j = 0; j < 8; ++j) v[j] *= QA_SCALE;
        } else if (col0 >= ZC_GA && col0 < ZC_CQ) {
#pragma unroll
            for (int j = 0; j < 8; ++j) v[j] = silu_f(v[j]);
        } else if (col0 >= ZC_KR && col0 < ZC_PAD) {
            const f32x4* c4 = (const f32x4*)(cs + (size_t)row * 32 + ((col0 - ZC_KR) >> 1));
            const f32x4 c01 = c4[0], c23 = c4[1];
            const float cc[4] = {c01.x, c01.z, c23.x, c23.z}, sn[4] = {c01.y, c01.w, c23.y, c23.w};
#pragma unroll
            for (int i = 0; i < 4; ++i) { const float x1 = v[2 * i], x2 = v[2 * i + 1]; v[2 * i] = x1 * cc[i] - x2 * sn[i]; v[2 * i + 1] = x2 * cc[i] + x1 * sn[i]; }
        }
        const v4u w = pack8(v);
        *(v4u*)(Z + (size_t)row * DINP + col0) = w;
        if (col0 >= ZC_CQ && col0 < ZC_KR) { float f[8]; unpack8(w, f);
#pragma unroll
            for (int j = 0; j < 8; ++j) ss += f[j] * f[j]; }
        return ss;
    }
    __device__ __forceinline__ void ssq(int row, int grp, float s) const {
        if (grp >= ZC_CQ / 32 && grp < ZC_CKV / 32) ssq_q[(size_t)row * 8 + (grp - ZC_CQ / 32)] = s;
        else if (grp >= ZC_CKV / 32 && grp < ZC_KR / 32) ssq_kv[(size_t)row * 4 + (grp - ZC_CKV / 32)] = s;
    }
};
struct EpiUp {
    static constexpr bool HAS_SSQ = false;
    bf16* U; const float* ssq_q; const float* ssq_kv; const f32x2* cs;
    __device__ __forceinline__ float rowsum_part(int row, int part, int col0) const {
        if (col0 < UC_KN) { const f32x2 a = *(const f32x2*)(ssq_q + (size_t)row * 8 + part * 2); return a.x + a.y; }
        return ssq_kv[(size_t)row * 4 + part];
    }
    __device__ __forceinline__ float rowscale_from(float tot, int col0) const { return (col0 < UC_KN) ? rsqrtf(tot * (1.0f / 256) + EPS) * QB_SCALE : rsqrtf(tot * (1.0f / 128) + EPS); }
    __device__ __forceinline__ float run8(int row, int col0, float rs, float (&v)[8]) const {
#pragma unroll
        for (int j = 0; j < 8; ++j) v[j] *= rs;
        if (col0 >= UC_QR && col0 < UC_KN) {
            const f32x4* c4 = (const f32x4*)(cs + (size_t)row * 32 + (((col0 - UC_QR) & 63) >> 1));
            const f32x4 c01 = c4[0], c23 = c4[1];
            const float cc[4] = {c01.x, c01.z, c23.x, c23.z}, sn[4] = {c01.y, c01.w, c23.y, c23.w};
#pragma unroll
            for (int i = 0; i < 4; ++i) { const float x1 = v[2 * i], x2 = v[2 * i + 1]; v[2 * i] = x1 * cc[i] - x2 * sn[i]; v[2 * i + 1] = x2 * cc[i] + x1 * sn[i]; }
        }
        *(v4u*)(U + (size_t)row * DUP + col0) = pack8(v);
        return 0.f;
    }
    __device__ __forceinline__ void ssq(int, int, float) const {}
};
struct EpiPe {
    static constexpr bool HAS_SSQ = false;
    bf16* PE;
    __device__ __forceinline__ float rowsum_part(int, int, int) const { return 0.f; }
    __device__ __forceinline__ float rowscale_from(float, int) const { return 1.f; }
    __device__ __forceinline__ float run8(int row, int col0, float, float (&v)[8]) const { *(v4u*)(PE + (size_t)row * DM + col0) = pack8(v); return 0.f; }
    __device__ __forceinline__ void ssq(int, int, float) const {}
};
struct EpiOut {
    static constexpr bool HAS_SSQ = true;
    const float* res; float* out; bf16* hb; float* ssq_o;
    __device__ __forceinline__ float rowsum_part(int, int, int) const { return 0.f; }
    __device__ __forceinline__ float rowscale_from(float, int) const { return 1.f; }
    __device__ __forceinline__ float run8(int row, int col0, float, float (&v)[8]) const {
        const size_t off = (size_t)row * DM + col0;
        const f32x4 a = *(const f32x4*)(res + off), b = *(const f32x4*)(res + off + 4);
        v[0] += a.x; v[1] += a.y; v[2] += a.z; v[3] += a.w; v[4] += b.x; v[5] += b.y; v[6] += b.z; v[7] += b.w;
        *(f32x4*)(out + off) = (f32x4){v[0], v[1], v[2], v[3]}; *(f32x4*)(out + off + 4) = (f32x4){v[4], v[5], v[6], v[7]};
        *(v4u*)(hb + off) = pack8(v);
        float ss = 0.f;
#pragma unroll
        for (int j = 0; j < 8; ++j) ss += v[j] * v[j];
        return ss;
    }
    __device__ __forceinline__ void ssq(int row, int grp, float s) const { ssq_o[(size_t)row * 32 + grp] = s; }
};
struct EpiGate {
    static constexpr bool HAS_SSQ = true;
    float* out; bf16* hb; const bf16* PE; const float* bias; const float* ssq_i; float* ssq_o;
    __device__ __forceinline__ float rowsum_part(int row, int part, int) const { const f32x4* s = (const f32x4*)(ssq_i + (size_t)row * 32 + part * 8); const f32x4 a = s[0], b = s[1]; return ((a.x + a.y) + (a.z + a.w)) + ((b.x + b.y) + (b.z + b.w)); }
    __device__ __forceinline__ float rowscale_from(float tot, int) const { return rsqrtf(tot * (1.0f / DM) + EPS); }
    __device__ __forceinline__ float run8(int row, int col0, float rs, float (&v)[8]) const {
        const size_t off = (size_t)row * DM + col0;
        const f32x4 a = *(const f32x4*)(out + off), b = *(const f32x4*)(out + off + 4);
        const f32x4 ba = *(const f32x4*)(bias + col0), bb = *(const f32x4*)(bias + col0 + 4);
        float pe[8]; unpack8(*(const v4u*)(PE + off), pe);
        const float h[8] = {a.x, a.y, a.z, a.w, b.x, b.y, b.z, b.w}, bs[8] = {ba.x, ba.y, ba.z, ba.w, bb.x, bb.y, bb.z, bb.w};
        float ss = 0.f;
#pragma unroll
        for (int j = 0; j < 8; ++j) { v[j] = h[j] + pe[j] * sigmoid_f(v[j] * rs + bs[j]); ss += v[j] * v[j]; }
        *(f32x4*)(out + off) = (f32x4){v[0], v[1], v[2], v[3]}; *(f32x4*)(out + off + 4) = (f32x4){v[4], v[5], v[6], v[7]};
        *(v4u*)(hb + off) = pack8(v);
        return ss;
    }
    __device__ __forceinline__ void ssq(int row, int grp, float s) const { ssq_o[(size_t)row * 32 + grp] = s; }
};

template <class EP> __device__ __forceinline__ void naive_gemm(const Frame& F, const bf16* A, int lda, const bf16* Bt, int K, int N, const EP& E) {
    const int gt = F.vcu * NTHREADS + F.tid, NGT = F.G * NTHREADS;
    const int ng = N / 32;
    for (int it = gt; it < T * ng; it += NGT) {
        const int row = it % T, cg = it / T, col0 = cg * 32;
        float acc[32];
#pragma unroll
        for (int j = 0; j < 32; ++j) acc[j] = 0.f;
        const bf16* ap = A + (size_t)row * lda; const bf16* bp = Bt + (size_t)col0 * K;
        for (int k0 = 0; k0 < K; k0 += 8) {
            float a[8]; unpack8(*(const v4u*)(ap + k0), a);
#pragma unroll
            for (int j = 0; j < 32; ++j) { float b[8]; unpack8(*(const v4u*)(bp + (size_t)j * K + k0), b);
#pragma unroll
                for (int e = 0; e < 8; ++e) acc[j] += a[e] * b[e]; }
        }
        float tot = 0.f;
#pragma unroll
        for (int part = 0; part < 4; ++part) tot += E.rowsum_part(row, part, col0);
        const float rs = E.rowscale_from(tot, col0);
        float ss = 0.f;
#pragma unroll
        for (int g = 0; g < 4; ++g) { float v[8];
#pragma unroll
            for (int j = 0; j < 8; ++j) v[j] = acc[g * 8 + j];
            ss += E.run8(row, col0 + g * 8, rs, v); }
        if (EP::HAS_SSQ) E.ssq(row, cg, ss);
    }
}
__device__ __forceinline__ void naive_attn_a(const Frame& F, int L) {
    const bf16* Z = (const bf16*)(F.ws + WS_Z); bf16* MIX = (bf16*)(F.ws + ((L & 1) ? WS_BUFA : WS_BUFB));
    LAS float* sc = (LAS float*)F.lds + F.wave * 640;
    const float* rb = F.rel_bias + (size_t)L * 8 * 257;
    const int gw = F.vcu * NWAVES + F.wave, NGW = F.G * NWAVES;
    for (int it = gw; it < T * 8; it += NGW) {
        const int row = it >> 3, h = it & 7, b = row >> 11, sq = row & 2047, cq = sq >> 6, ql = sq & 63;
        float q[64];
#pragma unroll
        for (int c = 0; c < 8; ++c) { float f[8]; unpack8(*(const v4u*)(Z + (size_t)row * DINP + ZC_QA + 64 * h + 8 * c), f);
#pragma unroll
            for (int e = 0; e < 8; ++e) q[8 * c + e] = f[e]; }
        float s[9]; float mx = -1e30f;
#pragma unroll
        for (int bi = 0; bi < 9; ++bi) {
            const int j = cq - 8 + bi; s[bi] = -1e30f;
            if (j >= 0) {
                const bf16* kp = Z + (size_t)(b * SEQ + 64 * j + F.lane) * DINP + ZC_KA + 64 * h; float d = 0.f;
#pragma unroll
                for (int c = 0; c < 8; ++c) { float f[8]; unpack8(*(const v4u*)(kp + 8 * c), f);
#pragma unroll
                    for (int e = 0; e < 8; ++e) d += q[8 * c + e] * f[e]; }
                int rel = (ql + 512) - (64 * bi + F.lane); rel = rel > 128 ? 128 : rel;
                s[bi] = d + rb[h * 257 + rel + 128] * LOG2E; mx = fmaxf(mx, s[bi]);
            }
        }
        mx = wave_max(mx); float l = 0.f;
#pragma unroll
        for (int bi = 0; bi < 9; ++bi) { const float pv = (cq - 8 + bi >= 0) ? exp2f(s[bi] - mx) : 0.f; l += pv; sc[64 * bi + F.lane] = pv; }
        l = wave_sum(l);
        asm volatile("s_waitcnt lgkmcnt(0)" ::: "memory");
        float o = 0.f;
        for (int bi = 0; bi < 9; ++bi) { const int j = cq - 8 + bi; if (j < 0) continue;
            const bf16* vp = Z + (size_t)(b * SEQ + 64 * j) * DINP + ZC_VA + 64 * h + F.lane;
            for (int kl = 0; kl < 64; ++kl) o += sc[64 * bi + kl] * bf2f(vp[(size_t)kl * DINP]); }
        const float g = bf2f(Z[(size_t)row * DINP + ZC_GA + 64 * h + F.lane]);
        MIX[(size_t)row * DM + 64 * h + F.lane] = (bf16)f2bf(o / l * g);
        asm volatile("s_waitcnt lgkmcnt(0)" ::: "memory");
    }
}
__device__ __forceinline__ void naive_attn_b(const Frame& F, int L) {
    const bf16* Z = (const bf16*)(F.ws + WS_Z); const bf16* U = (const bf16*)(F.ws + WS_U); bf16* MIX = (bf16*)(F.ws + ((L & 1) ? WS_BUFA : WS_BUFB));
    LAS float* sc = (LAS float*)F.lds + F.wave * 2048;
    const int gw = F.vcu * NWAVES + F.wave, NGW = F.G * NWAVES;
    for (int it = gw; it < T * 4; it += NGW) {
        const int row = it >> 2, h = it & 3, b = row >> 11, sq = row & 2047, cq = sq >> 6;
        const int nk = (cq + 1) * 64;
        const bf16* qn = U + (size_t)row * DUP + UC_QN + 128 * h; const bf16* qr = U + (size_t)row * DUP + UC_QR + 64 * h;
        float mx = -1e30f;
        for (int k0 = 0; k0 < nk; k0 += 64) {
            const int key = b * SEQ + k0 + F.lane;
            const bf16* kn = U + (size_t)key * DUP + UC_KN + 128 * h; const bf16* kr = Z + (size_t)key * DINP + ZC_KR;
            float d = 0.f;
            for (int c = 0; c < 16; ++c) { float a[8], f[8]; unpack8(*(const v4u*)(qn + 8 * c), a); unpack8(*(const v4u*)(kn + 8 * c), f);
#pragma unroll
                for (int e = 0; e < 8; ++e) d += a[e] * f[e]; }
            for (int c = 0; c < 8; ++c) { float a[8], f[8]; unpack8(*(const v4u*)(qr + 8 * c), a); unpack8(*(const v4u*)(kr + 8 * c), f);
#pragma unroll
                for (int e = 0; e < 8; ++e) d += a[e] * f[e]; }
            sc[k0 + F.lane] = d; mx = fmaxf(mx, d);
        }
        mx = wave_max(mx); float l = 0.f;
        for (int k0 = 0; k0 < nk; k0 += 64) { const float pv = exp2f(sc[k0 + F.lane] - mx); l += pv; sc[k0 + F.lane] = pv; }
        l = wave_sum(l);
        asm volatile("s_waitcnt lgkmcnt(0)" ::: "memory");
        float o0 = 0.f, o1 = 0.f;
        const bf16* vp = U + (size_t)(b * SEQ) * DUP + UC_V + 128 * h + F.lane;
        for (int k = 0; k < nk; ++k) { const float pv = sc[k]; o0 += pv * bf2f(vp[(size_t)k * DUP]); o1 += pv * bf2f(vp[(size_t)k * DUP + 64]); }
        const float g0 = bf2f(Z[(size_t)row * DINP + ZC_GB + 128 * h + F.lane]), g1 = bf2f(Z[(size_t)row * DINP + ZC_GB + 128 * h + 64 + F.lane]);
        MIX[(size_t)row * DM + 512 + 128 * h + F.lane] = (bf16)f2bf(o0 / l * g0);
        MIX[(size_t)row * DM + 512 + 128 * h + 64 + F.lane] = (bf16)f2bf(o1 / l * g1);
        asm volatile("s_waitcnt lgkmcnt(0)" ::: "memory");
    }
}

template <class EP> __device__ __forceinline__ void fast_gemm(const Frame& F, const bf16* A, int lda, const bf16* Bt, int K, int N, const EP& E) { naive_gemm(F, A, lda, Bt, K, N, E); }
__device__ __forceinline__ void fast_attn_a(const Frame& F, int L) { naive_attn_a(F, L); }
__device__ __forceinline__ void fast_attn_b(const Frame& F, int L) { naive_attn_b(F, L); }

__device__ __forceinline__ void final_norm(const Frame& F) {
    const float* ssq = (const float*)(F.ws + WS_SSQ2);
    const int gw = F.vcu * NWAVES + F.wave, NGW = F.G * NWAVES;
    for (int m = gw; m < T; m += NGW) {
        float s = (F.lane < 32) ? ssq[(size_t)m * 32 + F.lane] : 0.f; s = wave_sum(s);
        const float r = rsqrtf(s * (1.0f / DM) + EPS);
        f32x4* o = (f32x4*)(F.out + (size_t)m * DM) + F.lane; const f32x4* g = (const f32x4*)F.norm_final + F.lane;
#pragma unroll
        for (int j = 0; j < 4; ++j) { f32x4 v = o[64 * j]; const f32x4 gg = g[64 * j]; v.x *= r * gg.x; v.y *= r * gg.y; v.z *= r * gg.z; v.w *= r * gg.w; o[64 * j] = v; }
    }
}

constexpr int N_PHASES = 12;
__global__ void __launch_bounds__(NTHREADS, 2) trunk_fwd(Args args) {
    extern __shared__ __attribute__((aligned(16))) unsigned char lds[];
    Frame F;
    F.lds = (LAS unsigned char*)lds; F.ws = args.ws;
    F.tid = threadIdx.x; F.lane = F.tid & 63; F.wave = __builtin_amdgcn_readfirstlane(F.tid >> 6);
    F.G = gridDim.x; { const int bx = blockIdx.x; F.vcu = (F.G % 8 == 0) ? (bx % 8) * (F.G / 8) + bx / 8 : bx; }
    F.x = (const float*)args.in[0]; F.p = (const float*)args.in[1]; F.positions = (const int*)args.in[2]; F.norm_mix = (const float*)args.in[3];
    F.w_in = (const float*)args.in[4]; F.rel_bias = (const float*)args.in[5]; F.g_q = (const float*)args.in[6]; F.w_uq = (const float*)args.in[7];
    F.g_kv = (const float*)args.in[8]; F.w_ukv = (const float*)args.in[9]; F.w_out = (const float*)args.in[10]; F.norm_ple = (const float*)args.in[11];
    F.w_pe = (const float*)args.in[12]; F.w_pg = (const float*)args.in[13]; F.b_pg = (const float*)args.in[14]; F.norm_final = (const float*)args.in[15];
    F.out = args.out;
    volatile LAS unsigned* MISC = (volatile LAS unsigned*)(F.lds + MISC_OFF);
    for (int u = F.tid; u < (LDS_BYTES - LDSCTL_OFF) / 4; u += NTHREADS) ((LAS unsigned*)(F.lds + LDSCTL_OFF))[u] = 0u;
    __syncthreads();
    XcdBarrier bar; bar.bar = (unsigned*)(F.ws + WS_CTL) + CW_BAR; bar.x = 0; bar.st = nullptr;
    if (MK_N_LAUNCHES == 1) bar = xcd_barrier_post((unsigned*)(F.ws + WS_CTL) + CW_BAR, MISC + 8);

    bf16* Z = (bf16*)(F.ws + WS_Z); bf16* U = (bf16*)(F.ws + WS_U); bf16* PE = (bf16*)(F.ws + WS_Z);
    float* SSQ1 = (float*)(F.ws + WS_SSQ1); float* SSQ2 = (float*)(F.ws + WS_SSQ2); float* SSQQ = (float*)(F.ws + WS_SSQQ); float* SSQKV = (float*)(F.ws + WS_SSQKV);
    const f32x2* CS = (const f32x2*)(F.ws + WS_CS);

    for (int ph = args.ph_lo; ph < args.ph_hi; ++ph) {
        if (ph == 0) p0_prologue(F);
        else if (ph == N_PHASES - 1) final_norm(F);
        else {
            const int L = (ph - 1) / 5, kind = (ph - 1) % 5;
            bf16* HIN = (bf16*)(F.ws + ((L & 1) ? WS_BUFB : WS_BUFA));
            bf16* MIX = (bf16*)(F.ws + ((L & 1) ? WS_BUFA : WS_BUFB));
            if (kind == 0) {
                EpiP1 E{Z, SSQ2, SSQQ, SSQKV, CS};
                const bf16* Bt = (const bf16*)(F.ws + WS_WIN) + (size_t)L * DINP * DM;
                if (MK_NAIVE & 1) naive_gemm(F, HIN, DM, Bt, DM, DINP, E);
                else fast_gemm(F, HIN, DM, Bt, DM, DINP, E);
            } else if (kind == 1) {
                EpiUp E{U, SSQQ, SSQKV, CS};
                const bf16* Bt = (const bf16*)(F.ws + WS_WUP) + (size_t)L * DUP * KUP;
                if (MK_NAIVE & 1) naive_gemm(F, Z + ZC_CQ, DINP, Bt, KUP, DUP, E);
                else fast_gemm(F, Z + ZC_CQ, DINP, Bt, KUP, DUP, E);
                __syncthreads();
                if (MK_NAIVE & 2) naive_attn_a(F, L); else fast_attn_a(F, L);
            } else if (kind == 2) {
                if (MK_NAIVE & 4) naive_attn_b(F, L); else fast_attn_b(F, L);
            } else if (kind == 3) {
                EpiPe E0{PE};
                const bf16* Bpe = (const bf16*)(F.ws + WS_WPE) + (size_t)L * DM * DPLE;
                const bf16* PBl = (const bf16*)(F.ws + WS_PB) + (size_t)L * T * DPLE;
                if (MK_NAIVE & 1) naive_gemm(F, PBl, DPLE, Bpe, DPLE, DM, E0);
                else fast_gemm(F, PBl, DPLE, Bpe, DPLE, DM, E0);
                __syncthreads();
                EpiOut E1{L == 0 ? F.x : F.out, F.out, HIN, SSQ1};
                const bf16* Bo = (const bf16*)(F.ws + WS_WOUT) + (size_t)L * DM * DM;
                if (MK_NAIVE & 1) naive_gemm(F, MIX, DM, Bo, DM, DM, E1);
                else fast_gemm(F, MIX, DM, Bo, DM, DM, E1);
            } else {
                EpiGate E{F.out, MIX, PE, F.b_pg + (size_t)L * DM, SSQ1, SSQ2};
                const bf16* Bg = (const bf16*)(F.ws + WS_WPG) + (size_t)L * DM * DM;
                if (MK_NAIVE & 1) naive_gemm(F, HIN, DM, Bg, DM, DM, E);
                else fast_gemm(F, HIN, DM, Bg, DM, DM, E);
            }
        }
        if (ph + 1 < args.ph_hi) xcd_barrier(bar);
    }
}

extern "C" void kernel_launch(void* const* d_in, const int* in_sizes, int n_in, void* d_out, int out_size, void* d_ws, size_t ws_size, hipStream_t stream) {
    static int grid = 0;
    if (grid == 0) {
        if (n_in != 16 || in_sizes[0] != T * DM || out_size != T * DM || ws_size < WS_END) {
            fprintf(stderr, "kernel_launch: unexpected shapes (n_in %d, in0 %d, out %d, ws %zu); nothing launched\n", n_in, n_in > 0 ? in_sizes[0] : -1, out_size, ws_size); grid = -1; return; }
        int dev = 0, cus = 0, per_cu = 0;
        if (hipGetDevice(&dev) != hipSuccess || hipDeviceGetAttribute(&cus, hipDeviceAttributeMultiprocessorCount, dev) != hipSuccess) { grid = -1; return; }
        if (hipFuncSetAttribute((const void*)trunk_fwd, hipFuncAttributeMaxDynamicSharedMemorySize, LDS_BYTES) != hipSuccess) { fprintf(stderr, "kernel_launch: hipFuncSetAttribute failed\n"); grid = -1; return; }
        if (hipOccupancyMaxActiveBlocksPerMultiprocessor(&per_cu, (const void*)trunk_fwd, NTHREADS, LDS_BYTES) != hipSuccess || per_cu < 1)
            fprintf(stderr, "kernel_launch: note: occupancy query reports %d workgroups per CU\n", per_cu);
        (void)hipGetLastError();
        grid = cus;
    }
    if (grid < 0) return;
    if (hipMemsetAsync((char*)d_ws + WS_CTL, 0, CTL_ZERO_BYTES, stream) != hipSuccess) { fprintf(stderr, "kernel_launch: hipMemsetAsync failed\n"); return; }
    Args a{};
    for (int i = 0; i < 16; ++i) a.in[i] = d_in[i];
    a.out = (float*)d_out; a.ws = (unsigned char*)d_ws;
    for (int li = 0; li < MK_N_LAUNCHES; ++li) {
        a.ph_lo = (MK_N_LAUNCHES == 1) ? 0 : li; a.ph_hi = (MK_N_LAUNCHES == 1) ? N_PHASES : li + 1; a.li = li;
        hipLaunchKernelGGL(trunk_fwd, dim3(grid), dim3(NTHREADS), LDS_BYTES, stream, a);
        const hipError_t le = hipPeekAtLastError();
        if (le != hipSuccess) { fprintf(stderr, "kernel_launch: launch %d failed: %s\n", li, hipGetErrorName(le)); break; }
    }
}
```

```cpp
#include <hip/hip_runtime.h>
#include <cstdio>
#include <cstdint>

#ifndef MK_N_LAUNCHES
#define MK_N_LAUNCHES 1
#endif
#ifndef MK_NAIVE
#define MK_NAIVE 0xF
#endif

constexpr int NB = 16, SEQ = 2048, T = NB * SEQ, DM = 1024, DIN = 3008, DINP = 3072, DPLE = 256, DEPTH = 2;
constexpr int DUP = 1792, KUP = 384;
constexpr float EPS = 1e-6f;
constexpr float LOG2E = 1.4426950408889634f;
constexpr float QA_SCALE = 0.125f * LOG2E;
constexpr float QB_SCALE = 0.07216878364870322f * LOG2E;
constexpr int ZC_QA = 0, ZC_KA = 512, ZC_VA = 1024, ZC_GA = 1536, ZC_GB = 2048, ZC_CQ = 2560, ZC_CKV = 2816, ZC_KR = 2944, ZC_PAD = 3008;
constexpr int UC_QN = 0, UC_QR = 512, UC_KN = 768, UC_V = 1280;

constexpr size_t MiB = 1u << 20;
constexpr size_t WS_CTL = 0, CTL_ZERO_BYTES = 1 * MiB;
constexpr size_t WS_WIN = 1 * MiB;
constexpr size_t WS_WUP = 13 * MiB;
constexpr size_t WS_WOUT = 16 * MiB;
constexpr size_t WS_WPG = 20 * MiB;
constexpr size_t WS_WPE = 24 * MiB;
constexpr size_t WS_CS = 25 * MiB;
constexpr size_t WS_SSQ1 = 33 * MiB;
constexpr size_t WS_SSQ2 = 37 * MiB;
constexpr size_t WS_SSQQ = 41 * MiB;
constexpr size_t WS_SSQKV = 42 * MiB;
constexpr size_t WS_PB = 43 * MiB;
constexpr size_t WS_BUFA = 75 * MiB;
constexpr size_t WS_BUFB = 139 * MiB;
constexpr size_t WS_Z = 203 * MiB;
constexpr size_t WS_U = 395 * MiB;
constexpr size_t WS_END = 507 * MiB;

constexpr int NWAVES = 8, NTHREADS = 512;
constexpr int RING_BYTES = 131072, LDSCTL_OFF = RING_BYTES, MISC_OFF = LDSCTL_OFF + 320, LDS_BYTES = 147456;

#define GAS __attribute__((address_space(1)))
#define LAS __attribute__((address_space(3)))
typedef unsigned short bf16;
typedef unsigned v4u __attribute__((ext_vector_type(4)));
typedef unsigned v2u __attribute__((ext_vector_type(2)));
typedef float f32x4 __attribute__((ext_vector_type(4)));
typedef float f32x2 __attribute__((ext_vector_type(2)));
typedef float f32x16 __attribute__((ext_vector_type(16)));
typedef short bf16x8 __attribute__((ext_vector_type(8)));
typedef short s16x4 __attribute__((ext_vector_type(4)));
typedef __bf16 bf16x2_t __attribute__((ext_vector_type(2)));
typedef GAS unsigned gu32;
#define RLX_AGENT __ATOMIC_RELAXED, __HIP_MEMORY_SCOPE_AGENT

__device__ __forceinline__ float bf2f(unsigned b) { return __uint_as_float(b << 16); }
__device__ __forceinline__ unsigned f2bf(float f) { unsigned u = __float_as_uint(f); return (u + 0x7fffu + ((u >> 16) & 1u)) >> 16; }
__device__ __forceinline__ unsigned pk2(float lo, float hi) { f32x2 v = {lo, hi}; bf16x2_t b = __builtin_convertvector(v, bf16x2_t); return __builtin_bit_cast(unsigned, b); }
__device__ __forceinline__ float silu_f(float v) { return v / (1.0f + __expf(-v)); }
__device__ __forceinline__ float sigmoid_f(float v) { return 1.0f / (1.0f + __expf(-v)); }
__device__ __forceinline__ void unpack8(v4u w, float (&f)[8]) {
    f[0] = bf2f(w.x & 0xffffu); f[1] = bf2f(w.x >> 16); f[2] = bf2f(w.y & 0xffffu); f[3] = bf2f(w.y >> 16);
    f[4] = bf2f(w.z & 0xffffu); f[5] = bf2f(w.z >> 16); f[6] = bf2f(w.w & 0xffffu); f[7] = bf2f(w.w >> 16);
}
__device__ __forceinline__ v4u pack8(const float (&f)[8]) { v4u w; w.x = pk2(f[0], f[1]); w.y = pk2(f[2], f[3]); w.z = pk2(f[4], f[5]); w.w = pk2(f[6], f[7]); return w; }

__device__ const float INV_FREQ[32] = {
    1.000000000e+00f, 7.498942614e-01f, 5.623413324e-01f, 4.216965139e-01f, 3.162277639e-01f, 2.371373773e-01f, 1.778279394e-01f, 1.333521307e-01f,
    1.000000015e-01f, 7.498941571e-02f, 5.623413250e-02f, 4.216965288e-02f, 3.162277490e-02f, 2.371373773e-02f, 1.778279431e-02f, 1.333521493e-02f,
    9.999999776e-03f, 7.498941850e-03f, 5.623413250e-03f, 4.216964822e-03f, 3.162277630e-03f, 2.371373586e-03f, 1.778279431e-03f, 1.333521446e-03f,
    1.000000047e-03f, 7.498942432e-04f, 5.623413017e-04f, 4.216965172e-04f, 3.162277571e-04f, 2.371373703e-04f, 1.778279402e-04f, 1.333521504e-04f};

#define XB_TMO      128
#define XB_XCNT(j)  (256  + 64 * (j))
#define XB_XSUB(j)  (1280 + 64 * (j))
#define XB_XGEN(j)  (2304 + 64 * (j))
#define XB_TOP      3328
#define XB_TOPGEN   3392
#define XCD_BAR_WORDS 3456
#define XB_SPIN_CAP (1u << 22)
constexpr int CW_BAR = 4096;

__device__ __forceinline__ unsigned xb_ld(unsigned* p)              { return __hip_atomic_load(p, __ATOMIC_RELAXED, __HIP_MEMORY_SCOPE_AGENT); }
__device__ __forceinline__ unsigned xb_add(unsigned* p, unsigned v) { return __hip_atomic_fetch_add(p, v, __ATOMIC_RELAXED, __HIP_MEMORY_SCOPE_AGENT); }
__device__ __forceinline__ unsigned xb_xcc_id() { return (unsigned)__builtin_amdgcn_s_getreg((3 << 11) | 20) & 0xFu; }
#define XB_SPIN(cond, bar) do { unsigned _sp = 0; while (cond) { __builtin_amdgcn_s_sleep(1); \
    if ((++_sp & 255u) == 0u) { if (xb_ld(&(bar)[XB_TMO])) break; if (_sp > XB_SPIN_CAP) { atomicAdd(&(bar)[XB_TMO], 1u); break; } } } } while (0)
struct XcdBarrier { unsigned* bar; unsigned x; volatile LAS unsigned* st; };
__device__ __forceinline__ XcdBarrier xcd_barrier_post(unsigned* bar, volatile LAS unsigned* st) {
    XcdBarrier b; b.bar = bar; b.x = xb_xcc_id(); b.st = st;
    if (threadIdx.x == 0) (void)xb_add(&bar[XB_XCNT(b.x)], 1u);
    return b;
}
__device__ __forceinline__ void xcd_barrier_complete(unsigned* bar, unsigned x, unsigned& nloc, unsigned& nx) {
    const unsigned G = gridDim.x * gridDim.y * gridDim.z;
    unsigned sum, cnt, mine, sp = 0u;
    for (;;) {
        sum = 0u; cnt = 0u; mine = 0u;
#pragma unroll
        for (unsigned j = 0; j < 16; ++j) { const unsigned c = xb_ld(&bar[XB_XCNT(j)]); sum += c; cnt += (c > 0u) ? 1u : 0u; mine = (j == x) ? c : mine; }
        if (sum == G) break;
        __builtin_amdgcn_s_sleep(1);
        if ((++sp & 255u) == 0u) { if (xb_ld(&bar[XB_TMO])) break; if (sp > XB_SPIN_CAP) { atomicAdd(&bar[XB_TMO], 1u); break; } }
    }
    nloc = mine > 0u ? mine : 1u; nx = cnt > 0u ? cnt : 1u;
}
__device__ __forceinline__ void xcd_barrier(const XcdBarrier& b) {
    asm volatile("s_waitcnt vmcnt(0)" ::: "memory");
    __syncthreads();
    if (threadIdx.x == 0) {
        unsigned* bar = b.bar;
        __builtin_amdgcn_s_waitcnt(0);
        unsigned nloc = b.st[0], nx = b.st[1];
        if (nloc == 0u) { xcd_barrier_complete(bar, b.x, nloc, nx); b.st[0] = nloc; b.st[1] = nx; }
        const unsigned old = xb_add(&bar[XB_XSUB(b.x)], 1u);
        const unsigned gen = old / nloc;
        if (old + 1u == (gen + 1u) * nloc) {
            __builtin_amdgcn_fence(__ATOMIC_RELEASE, "agent");
            asm volatile("s_waitcnt vmcnt(0)" ::: "memory");
            const unsigned og = xb_add(&bar[XB_TOP], 1u);
            const unsigned tg = og / nx;
            if (og + 1u == (tg + 1u) * nx) xb_add(&bar[XB_TOPGEN], 1u);
            else XB_SPIN(xb_ld(&bar[XB_TOPGEN]) == tg, bar);
            __builtin_amdgcn_fence(__ATOMIC_ACQUIRE, "agent");
            xb_add(&bar[XB_XGEN(b.x)], 1u);
            asm volatile("s_waitcnt vmcnt(0)" ::: "memory");
        } else {
            XB_SPIN(xb_ld(&bar[XB_XGEN(b.x)]) == gen, bar);
            __builtin_amdgcn_fence(__ATOMIC_ACQUIRE, "agent");
            asm volatile("s_waitcnt vmcnt(0)" ::: "memory");
        }
    }
    __syncthreads();
}

struct Args { const void* in[16]; float* out; unsigned char* ws; int ph_lo, ph_hi, li, pad; };
struct Frame {
    LAS unsigned char* lds;
    unsigned char* ws;
    int tid, lane, wave, vcu, G;
    const float *x, *p, *norm_mix, *w_in, *rel_bias, *g_q, *w_uq, *g_kv, *w_ukv, *w_out, *norm_ple, *w_pe, *w_pg, *b_pg, *norm_final;
    const int* positions;
    float* out;
};
__device__ __forceinline__ float wave_sum(float v) {
#pragma unroll
    for (int o = 1; o < 64; o <<= 1) v += __shfl_xor(v, o);
    return v;
}
__device__ __forceinline__ float wave_max(float v) {
#pragma unroll
    for (int o = 1; o < 64; o <<= 1) v = fmaxf(v, __shfl_xor(v, o));
    return v;
}

__device__ __forceinline__ float wsrc(const Frame& F, int mat, int L, int n, int k) {
    if (mat == 0) {
        int sc;
        if (n < 2048) sc = n;
        else if (n < ZC_CQ) sc = 2496 + (n - ZC_GB);
        else if (n < ZC_CKV) sc = 2048 + (n - ZC_CQ);
        else if (n < ZC_KR) sc = 2304 + (n - ZC_CKV);
        else if (n < ZC_PAD) { const int j = n - ZC_KR; sc = 2432 + (j >> 1) + 32 * (j & 1); }
        else return 0.f;
        return F.w_in[((size_t)L * DM + k) * DIN + sc] * F.norm_mix[L * DM + k];
    } else if (mat == 1) {
        if (n < UC_KN) {
            if (k >= 256) return 0.f;
            int sc;
            if (n < UC_QR) sc = (n >> 7) * 192 + (n & 127);
            else { const int j = (n - UC_QR) & 63, hh = (n - UC_QR) >> 6; sc = hh * 192 + 128 + (j >> 1) + 32 * (j & 1); }
            return F.w_uq[((size_t)L * 256 + k) * 768 + sc] * F.g_q[L * 256 + k];
        } else {
            if (k < 256) return 0.f;
            const int kk = k - 256; int sc;
            if (n < UC_V) { const int m = n - UC_KN; sc = (m >> 7) * 256 + (m & 127); }
            else { const int m = n - UC_V; sc = (m >> 7) * 256 + 128 + (m & 127); }
            return F.w_ukv[((size_t)L * 128 + kk) * 1024 + sc] * F.g_kv[L * 128 + kk];
        }
    } else if (mat == 2) return F.w_out[((size_t)L * DM + k) * DM + n];
    else if (mat == 3) return F.w_pg[((size_t)L * DM + k) * DM + n] * F.norm_ple[L * DM + k];
    else return F.w_pe[((size_t)L * DPLE + k) * DM + n];
}
__device__ __forceinline__ void p0_prologue(const Frame& F) {
    {
        LAS float* scr = (LAS float*)F.lds;
        constexpr int NT0 = (DINP / 64) * (DM / 64), NT1 = (DUP / 64) * (KUP / 64), NT2 = 16 * 16, NT3 = 16 * 16, NT4 = 16 * 4;
        constexpr int NTL = NT0 + NT1 + NT2 + NT3 + NT4;
        for (int it = F.vcu; it < 2 * NTL; it += F.G) {
            const int L = it / NTL; int r = it % NTL; int mat, K, tn, tk; size_t base;
            if (r < NT0) { mat = 0; K = DM; base = WS_WIN + (size_t)L * DINP * DM * 2; }
            else if ((r -= NT0) < NT1) { mat = 1; K = KUP; base = WS_WUP + (size_t)L * DUP * KUP * 2; }
            else if ((r -= NT1) < NT2) { mat = 2; K = DM; base = WS_WOUT + (size_t)L * DM * DM * 2; }
            else if ((r -= NT2) < NT3) { mat = 3; K = DM; base = WS_WPG + (size_t)L * DM * DM * 2; }
            else { r -= NT3; mat = 4; K = DPLE; base = WS_WPE + (size_t)L * DM * DPLE * 2; }
            const int nkt = K / 64; tn = r / nkt; tk = r % nkt;
            const int n0 = tn * 64, k0 = tk * 64;
#pragma unroll
            for (int e = 0; e < 8; ++e) { const int idx = F.tid + 512 * e, kk = idx >> 6, nn = idx & 63; scr[kk * 65 + nn] = wsrc(F, mat, L, n0 + nn, k0 + kk); }
            __syncthreads();
            unsigned* dst = (unsigned*)(F.ws + base);
#pragma unroll
            for (int e = 0; e < 4; ++e) { const int idx = F.tid + 512 * e, nn = idx >> 5, kp = idx & 31;
                dst[((size_t)(n0 + nn) * K + k0) / 2 + kp] = pk2(scr[(2 * kp) * 65 + nn], scr[(2 * kp + 1) * 65 + nn]); }
            __syncthreads();
        }
    }
    const int gw = F.vcu * NWAVES + F.wave, NGW = F.G * NWAVES;
    {
        bf16* hb = (bf16*)(F.ws + WS_BUFA); float* ssq = (float*)(F.ws + WS_SSQ2);
        for (int m = gw; m < T; m += NGW) {
            const f32x4* xr = (const f32x4*)(F.x + (size_t)m * DM) + F.lane;
            f32x4 v[4]; float s = 0.f;
#pragma unroll
            for (int j = 0; j < 4; ++j) { v[j] = xr[64 * j]; s += (v[j].x * v[j].x + v[j].y * v[j].y) + (v[j].z * v[j].z + v[j].w * v[j].w); }
            s = wave_sum(s);
            v2u* o8 = (v2u*)(hb + (size_t)m * DM) + F.lane;
#pragma unroll
            for (int j = 0; j < 4; ++j) { v2u w; w.x = pk2(v[j].x, v[j].y); w.y = pk2(v[j].z, v[j].w); o8[64 * j] = w; }
            if (F.lane < 32) ssq[(size_t)m * 32 + F.lane] = (F.lane == 0) ? s : 0.f;
        }
    }
    const int gt = F.vcu * NTHREADS + F.tid, NGT = F.G * NTHREADS;
    {
        v4u* pb = (v4u*)(F.ws + WS_PB);
        for (int i = gt; i < 2 * T * DPLE / 8; i += NGT) {
            const f32x4 a = ((const f32x4*)F.p)[2 * i], b = ((const f32x4*)F.p)[2 * i + 1];
            v4u w; w.x = pk2(a.x, a.y); w.y = pk2(a.z, a.w); w.z = pk2(b.x, b.y); w.w = pk2(b.z, b.w); pb[i] = w;
        }
    }
    {
        f32x2* cs = (f32x2*)(F.ws + WS_CS);
        for (int i = gt; i < T * 32; i += NGT) {
            const int t = i >> 5, fi = i & 31;
            const float angf = (float)F.positions[t] * INV_FREQ[fi];
            const double a = (double)angf;
            const double kq = __builtin_rint(a * 0.63661977236758134308);
            const double r = (a - kq * 1.57079632679489655800) - kq * 6.12323399573676603587e-17;
            const double r2 = r * r;
            const double sn = r * (1.0 + r2 * (-1.0 / 6 + r2 * (1.0 / 120 + r2 * (-1.0 / 5040 + r2 * (1.0 / 362880 + r2 * (-1.0 / 39916800))))));
            const double cn = 1.0 + r2 * (-0.5 + r2 * (1.0 / 24 + r2 * (-1.0 / 720 + r2 * (1.0 / 40320 + r2 * (-1.0 / 3628800 + r2 * (1.0 / 479001600))))));
            const int q = (int)((long long)kq & 3);
            const double c = (q == 0) ? cn : (q == 1) ? -sn : (q == 2) ? -cn : sn;
            const double s = (q == 0) ? sn : (q == 1) ? cn : (q == 2) ? -sn : -cn;
            cs[i] = (f32x2){(float)c, (float)s};
        }
    }
}

struct EpiP1 {
    static constexpr bool HAS_SSQ = true;
    bf16* Z; const float* ssq_h; float* ssq_q; float* ssq_kv; const f32x2* cs;
    __device__ __forceinline__ float rowsum_part(int row, int part, int) const { const f32x4* s = (const f32x4*)(ssq_h + (size_t)row * 32 + part * 8); const f32x4 a = s[0], b = s[1]; return ((a.x + a.y) + (a.z + a.w)) + ((b.x + b.y) + (b.z + b.w)); }
    __device__ __forceinline__ float rowscale_from(float tot, int) const { return rsqrtf(tot * (1.0f / DM) + EPS); }
    __device__ __forceinline__ float run8(int row, int col0, float rs, float (&v)[8]) const {
        float ss = 0.f;
#pragma unroll
        for (int j = 0; j < 8; ++j) v[j] *= rs;
        if (col0 < ZC_KA) {
#pragma unroll
            for (int j = 0; j < 8; ++j) v[j] *= QA_SCALE;
        } else if (col0 >= ZC_GA && col0 < ZC_CQ) {
#pragma unroll
            for (int j = 0; j < 8; ++j) v[j] = silu_f(v[j]);
        } else if (col0 >= ZC_KR && col0 < ZC_PAD) {
            const f32x4* c4 = (const f32x4*)(cs + (size_t)row * 32 + ((col0 - ZC_KR) >> 1));
            const f32x4 c01 = c4[0], c23 = c4[1];
            const float cc[4] = {c01.x, c01.z, c23.x, c23.z}, sn[4] = {c01.y, c01.w, c23.y, c23.w};
#pragma unroll
            for (int i = 0; i < 4; ++i) { const float x1 = v[2 * i], x2 = v[2 * i + 1]; v[2 * i] = x1 * cc[i] - x2 * sn[i]; v[2 * i + 1] = x2 * cc[i] + x1 * sn[i]; }
        }
        const v4u w = pack8(v);
        *(v4u*)(Z + (size_t)row * DINP + col0) = w;
        if (col0 >= ZC_CQ && col0 < ZC_KR) { float f[8]; unpack8(w, f);
#pragma unroll
            for (int j = 0; j < 8; ++j) ss += f[j] * f[j]; }
        return ss;
    }
    __device__ __forceinline__ void ssq(int row, int grp, float s) const {
        if (grp >= ZC_CQ / 32 && grp < ZC_CKV / 32) ssq_q[(size_t)row * 8 + (grp - ZC_CQ / 32)] = s;
        else if (grp >= ZC_CKV / 32 && grp < ZC_KR / 32) ssq_kv[(size_t)row * 4 + (grp - ZC_CKV / 32)] = s;
    }
};
struct EpiUp {
    static constexpr bool HAS_SSQ = false;
    bf16* U; const float* ssq_q; const float* ssq_kv; const f32x2* cs;
    __device__ __forceinline__ float rowsum_part(int row, int part, int col0) const {
        if (col0 < UC_KN) { const f32x2 a = *(const f32x2*)(ssq_q + (size_t)row * 8 + part * 2); return a.x + a.y; }
        return ssq_kv[(size_t)row * 4 + part];
    }
    __device__ __forceinline__ float rowscale_from(float tot, int col0) const { return (col0 < UC_KN) ? rsqrtf(tot * (1.0f / 256) + EPS) * QB_SCALE : rsqrtf(tot * (1.0f / 128) + EPS); }
    __device__ __forceinline__ float run8(int row, int col0, float rs, float (&v)[8]) const {
#pragma unroll
        for (int j = 0; j < 8; ++j) v[j] *= rs;
        if (col0 >= UC_QR && col0 < UC_KN) {
            const f32x4* c4 = (const f32x4*)(cs + (size_t)row * 32 + (((col0 - UC_QR) & 63) >> 1));
            const f32x4 c01 = c4[0], c23 = c4[1];
            const float cc[4] = {c01.x, c01.z, c23.x, c23.z}, sn[4] = {c01.y, c01.w, c23.y, c23.w};
#pragma unroll
            for (int i = 0; i < 4; ++i) { const float x1 = v[2 * i], x2 = v[2 * i + 1]; v[2 * i] = x1 * cc[i] - x2 * sn[i]; v[2 * i + 1] = x2 * cc[i] + x1 * sn[i]; }
        }
        *(v4u*)(U + (size_t)row * DUP + col0) = pack8(v);
        return 0.f;
    }
    __device__ __forceinline__ void ssq(int, int, float) const {}
};
struct EpiPe {
    static constexpr bool HAS_SSQ = false;
    bf16* PE;
    __device__ __forceinline__ float rowsum_part(int, int, int) const { return 0.f; }
    __device__ __forceinline__ float rowscale_from(float, int) const { return 1.f; }
    __device__ __forceinline__ float run8(int row, int col0, float, float (&v)[8]) const { *(v4u*)(PE + (size_t)row * DM + col0) = pack8(v); return 0.f; }
    __device__ __forceinline__ void ssq(int, int, float) const {}
};
struct EpiOut {
    static constexpr bool HAS_SSQ = true;
    const float* res; float* out; bf16* hb; float* ssq_o;
    __device__ __forceinline__ float rowsum_part(int, int, int) const { return 0.f; }
    __device__ __forceinline__ float rowscale_from(float, int) const { return 1.f; }
    __device__ __forceinline__ float run8(int row, int col0, float, float (&v)[8]) const {
        const size_t off = (size_t)row * DM + col0;
        const f32x4 a = *(const f32x4*)(res + off), b = *(const f32x4*)(res + off + 4);
        v[0] += a.x; v[1] += a.y; v[2] += a.z; v[3] += a.w; v[4] += b.x; v[5] += b.y; v[6] += b.z; v[7] += b.w;
        *(f32x4*)(out + off) = (f32x4){v[0], v[1], v[2], v[3]}; *(f32x4*)(out + off + 4) = (f32x4){v[4], v[5], v[6], v[7]};
        *(v4u*)(hb + off) = pack8(v);
        float ss = 0.f;
#pragma unroll
        for (int j = 0; j < 8; ++j) ss += v[j] * v[j];
        return ss;
    }
    __device__ __forceinline__ void ssq(int row, int grp, float s) const { ssq_o[(size_t)row * 32 + grp] = s; }
};
struct EpiGate {
    static constexpr bool HAS_SSQ = true;
    float* out; bf16* hb; const bf16* PE; const float* bias; const float* ssq_i; float* ssq_o;
    __device__ __forceinline__ float rowsum_part(int row, int part, int) const { const f32x4* s = (const f32x4*)(ssq_i + (size_t)row * 32 + part * 8); const f32x4 a = s[0], b = s[1]; return ((a.x + a.y) + (a.z + a.w)) + ((b.x + b.y) + (b.z + b.w)); }
    __device__ __forceinline__ float rowscale_from(float tot, int) const { return rsqrtf(tot * (1.0f / DM) + EPS); }
    __device__ __forceinline__ float run8(int row, int col0, float rs, float (&v)[8]) const {
        const size_t off = (size_t)row * DM + col0;
        const f32x4 a = *(const f32x4*)(out + off), b = *(const f32x4*)(out + off + 4);
        const f32x4 ba = *(const f32x4*)(bias + col0), bb = *(const f32x4*)(bias + col0 + 4);
        float pe[8]; unpack8(*(const v4u*)(PE + off), pe);
        const float h[8] = {a.x, a.y, a.z, a.w, b.x, b.y, b.z, b.w}, bs[8] = {ba.x, ba.y, ba.z, ba.w, bb.x, bb.y, bb.z, bb.w};
        float ss = 0.f;
#pragma unroll
        for (int j = 0; j < 8; ++j) { v[j] = h[j] + pe[j] * sigmoid_f(v[j] * rs + bs[j]); ss += v[j] * v[j]; }
        *(f32x4*)(out + off) = (f32x4){v[0], v[1], v[2], v[3]}; *(f32x4*)(out + off + 4) = (f32x4){v[4], v[5], v[6], v[7]};
        *(v4u*)(hb + off) = pack8(v);
        return ss;
    }
    __device__ __forceinline__ void ssq(int row, int grp, float s) const { ssq_o[(size_t)row * 32 + grp] = s; }
};

template <class EP> __device__ __forceinline__ void naive_gemm(const Frame& F, const bf16* A, int lda, const bf16* Bt, int K, int N, const EP& E) {
    const int gt = F.vcu * NTHREADS + F.tid, NGT = F.G * NTHREADS;
    const int ng = N / 32;
    for (int it = gt; it < T * ng; it += NGT) {
        const int row = it % T, cg = it / T, col0 = cg * 32;
        float acc[32];
#pragma unroll
        for (int j = 0; j < 32; ++j) acc[j] = 0.f;
        const bf16* ap = A + (size_t)row * lda; const bf16* bp = Bt + (size_t)col0 * K;
        for (int k0 = 0; k0 < K; k0 += 8) {
            float a[8]; unpack8(*(const v4u*)(ap + k0), a);
#pragma unroll
            for (int j = 0; j < 32; ++j) { float b[8]; unpack8(*(const v4u*)(bp + (size_t)j * K + k0), b);
#pragma unroll
                for (int e = 0; e < 8; ++e) acc[j] += a[e] * b[e]; }
        }
        float tot = 0.f;
#pragma unroll
        for (int part = 0; part < 4; ++part) tot += E.rowsum_part(row, part, col0);
        const float rs = E.rowscale_from(tot, col0);
        float ss = 0.f;
#pragma unroll
        for (int g = 0; g < 4; ++g) { float v[8];
#pragma unroll
            for (int j = 0; j < 8; ++j) v[j] = acc[g * 8 + j];
            ss += E.run8(row, col0 + g * 8, rs, v); }
        if (EP::HAS_SSQ) E.ssq(row, cg, ss);
    }
}
__device__ __forceinline__ void naive_attn_a(const Frame& F, int L) {
    const bf16* Z = (const bf16*)(F.ws + WS_Z); bf16* MIX = (bf16*)(F.ws + ((L & 1) ? WS_BUFA : WS_BUFB));
    LAS float* sc = (LAS float*)F.lds + F.wave * 640;
    const float* rb = F.rel_bias + (size_t)L * 8 * 257;
    const int gw = F.vcu * NWAVES + F.wave, NGW = F.G * NWAVES;
    for (int it = gw; it < T * 8; it += NGW) {
        const int row = it >> 3, h = it & 7, b = row >> 11, sq = row & 2047, cq = sq >> 6, ql = sq & 63;
        float q[64];
#pragma unroll
        for (int c = 0; c < 8; ++c) { float f[8]; unpack8(*(const v4u*)(Z + (size_t)row * DINP + ZC_QA + 64 * h + 8 * c), f);
#pragma unroll
            for (int e = 0; e < 8; ++e) q[8 * c + e] = f[e]; }
        float s[9]; float mx = -1e30f;
#pragma unroll
        for (int bi = 0; bi < 9; ++bi) {
            const int j = cq - 8 + bi; s[bi] = -1e30f;
            if (j >= 0) {
                const bf16* kp = Z + (size_t)(b * SEQ + 64 * j + F.lane) * DINP + ZC_KA + 64 * h; float d = 0.f;
#pragma unroll
                for (int c = 0; c < 8; ++c) { float f[8]; unpack8(*(const v4u*)(kp + 8 * c), f);
#pragma unroll
                    for (int e = 0; e < 8; ++e) d += q[8 * c + e] * f[e]; }
                int rel = (ql + 512) - (64 * bi + F.lane); rel = rel > 128 ? 128 : rel;
                s[bi] = d + rb[h * 257 + rel + 128] * LOG2E; mx = fmaxf(mx, s[bi]);
            }
        }
        mx = wave_max(mx); float l = 0.f;
#pragma unroll
        for (int bi = 0; bi < 9; ++bi) { const float pv = (cq - 8 + bi >= 0) ? exp2f(s[bi] - mx) : 0.f; l += pv; sc[64 * bi + F.lane] = pv; }
        l = wave_sum(l);
        asm volatile("s_waitcnt lgkmcnt(0)" ::: "memory");
        float o = 0.f;
        for (int bi = 0; bi < 9; ++bi) { const int j = cq - 8 + bi; if (j < 0) continue;
            const bf16* vp = Z + (size_t)(b * SEQ + 64 * j) * DINP + ZC_VA + 64 * h + F.lane;
            for (int kl = 0; kl < 64; ++kl) o += sc[64 * bi + kl] * bf2f(vp[(size_t)kl * DINP]); }
        const float g = bf2f(Z[(size_t)row * DINP + ZC_GA + 64 * h + F.lane]);
        MIX[(size_t)row * DM + 64 * h + F.lane] = (bf16)f2bf(o / l * g);
        asm volatile("s_waitcnt lgkmcnt(0)" ::: "memory");
    }
}
__device__ __forceinline__ void naive_attn_b(const Frame& F, int L) {
    const bf16* Z = (const bf16*)(F.ws + WS_Z); const bf16* U = (const bf16*)(F.ws + WS_U); bf16* MIX = (bf16*)(F.ws + ((L & 1) ? WS_BUFA : WS_BUFB));
    LAS float* sc = (LAS float*)F.lds + F.wave * 2048;
    const int gw = F.vcu * NWAVES + F.wave, NGW = F.G * NWAVES;
    for (int it = gw; it < T * 4; it += NGW) {
        const int row = it >> 2, h = it & 3, b = row >> 11, sq = row & 2047, cq = sq >> 6;
        const int nk = (cq + 1) * 64;
        const bf16* qn = U + (size_t)row * DUP + UC_QN + 128 * h; const bf16* qr = U + (size_t)row * DUP + UC_QR + 64 * h;
        float mx = -1e30f;
        for (int k0 = 0; k0 < nk; k0 += 64) {
            const int key = b * SEQ + k0 + F.lane;
            const bf16* kn = U + (size_t)key * DUP + UC_KN + 128 * h; const bf16* kr = Z + (size_t)key * DINP + ZC_KR;
            float d = 0.f;
            for (int c = 0; c < 16; ++c) { float a[8], f[8]; unpack8(*(const v4u*)(qn + 8 * c), a); unpack8(*(const v4u*)(kn + 8 * c), f);
#pragma unroll
                for (int e = 0; e < 8; ++e) d += a[e] * f[e]; }
            for (int c = 0; c < 8; ++c) { float a[8], f[8]; unpack8(*(const v4u*)(qr + 8 * c), a); unpack8(*(const v4u*)(kr + 8 * c), f);
#pragma unroll
                for (int e = 0; e < 8; ++e) d += a[e] * f[e]; }
            sc[k0 + F.lane] = d; mx = fmaxf(mx, d);
        }
        mx = wave_max(mx); float l = 0.f;
        for (int k0 = 0; k0 < nk; k0 += 64) { const float pv = exp2f(sc[k0 + F.lane] - mx); l += pv; sc[k0 + F.lane] = pv; }
        l = wave_sum(l);
        asm volatile("s_waitcnt lgkmcnt(0)" ::: "memory");
        float o0 = 0.f, o1 = 0.f;
        const bf16* vp = U + (size_t)(b * SEQ) * DUP + UC_V + 128 * h + F.lane;
        for (int k = 0; k < nk; ++k) { const float pv = sc[k]; o0 += pv * bf2f(vp[(size_t)k * DUP]); o1 += pv * bf2f(vp[(size_t)k * DUP + 64]); }
        const float g0 = bf2f(Z[(size_t)row * DINP + ZC_GB + 128 * h + F.lane]), g1 = bf2f(Z[(size_t)row * DINP + ZC_GB + 128 * h + 64 + F.lane]);
        MIX[(size_t)row * DM + 512 + 128 * h + F.lane] = (bf16)f2bf(o0 / l * g0);
        MIX[(size_t)row * DM + 512 + 128 * h + 64 + F.lane] = (bf16)f2bf(o1 / l * g1);
        asm volatile("s_waitcnt lgkmcnt(0)" ::: "memory");
    }
}

template <class EP> __device__ __forceinline__ void fast_gemm(const Frame& F, const bf16* A, int lda, const bf16* Bt, int K, int N, const EP& E) { naive_gemm(F, A, lda, Bt, K, N, E); }
__device__ __forceinline__ void fast_attn_a(const Frame& F, int L) { naive_attn_a(F, L); }
__device__ __forceinline__ void fast_attn_b(const Frame& F, int L) { naive_attn_b(F, L); }

__device__ __forceinline__ void final_norm(const Frame& F) {
    const float* ssq = (const float*)(F.ws + WS_SSQ2);
    const int gw = F.vcu * NWAVES + F.wave, NGW = F.G * NWAVES;
    for (int m = gw; m < T; m += NGW) {
        float s = (F.lane < 32) ? ssq[(size_t)m * 32 + F.lane] : 0.f; s = wave_sum(s);
        const float r = rsqrtf(s * (1.0f / DM) + EPS);
        f32x4* o = (f32x4*)(F.out + (size_t)m * DM) + F.lane; const f32x4* g = (const f32x4*)F.norm_final + F.lane;
#pragma unroll
        for (int j = 0; j < 4; ++j) { f32x4 v = o[64 * j]; const f32x4 gg = g[64 * j]; v.x *= r * gg.x; v.y *= r * gg.y; v.z *= r * gg.z; v.w *= r * gg.w; o[64 * j] = v; }
    }
}

constexpr int N_PHASES = 12;
__global__ void __launch_bounds__(NTHREADS, 2) trunk_fwd(Args args) {
    extern __shared__ __attribute__((aligned(16))) unsigned char lds[];
    Frame F;
    F.lds = (LAS unsigned char*)lds; F.ws = args.ws;
    F.tid = threadIdx.x; F.lane = F.tid & 63; F.wave = __builtin_amdgcn_readfirstlane(F.tid >> 6);
    F.G = gridDim.x; { const int bx = blockIdx.x; F.vcu = (F.G % 8 == 0) ? (bx % 8) * (F.G / 8) + bx / 8 : bx; }
    F.x = (const float*)args.in[0]; F.p = (const float*)args.in[1]; F.positions = (const int*)args.in[2]; F.norm_mix = (const float*)args.in[3];
    F.w_in = (const float*)args.in[4]; F.rel_bias = (const float*)args.in[5]; F.g_q = (const float*)args.in[6]; F.w_uq = (const float*)args.in[7];
    F.g_kv = (const float*)args.in[8]; F.w_ukv = (const float*)args.in[9]; F.w_out = (const float*)args.in[10]; F.norm_ple = (const float*)args.in[11];
    F.w_pe = (const float*)args.in[12]; F.w_pg = (const float*)args.in[13]; F.b_pg = (const float*)args.in[14]; F.norm_final = (const float*)args.in[15];
    F.out = args.out;
    volatile LAS unsigned* MISC = (volatile LAS unsigned*)(F.lds + MISC_OFF);
    for (int u = F.tid; u < (LDS_BYTES - LDSCTL_OFF) / 4; u += NTHREADS) ((LAS unsigned*)(F.lds + LDSCTL_OFF))[u] = 0u;
    __syncthreads();
    XcdBarrier bar; bar.bar = (unsigned*)(F.ws + WS_CTL) + CW_BAR; bar.x = 0; bar.st = nullptr;
    if (MK_N_LAUNCHES == 1) bar = xcd_barrier_post((unsigned*)(F.ws + WS_CTL) + CW_BAR, MISC + 8);

    bf16* Z = (bf16*)(F.ws + WS_Z); bf16* U = (bf16*)(F.ws + WS_U); bf16* PE = (bf16*)(F.ws + WS_Z);
    float* SSQ1 = (float*)(F.ws + WS_SSQ1); float* SSQ2 = (float*)(F.ws + WS_SSQ2); float* SSQQ = (float*)(F.ws + WS_SSQQ); float* SSQKV = (float*)(F.ws + WS_SSQKV);
    const f32x2* CS = (const f32x2*)(F.ws + WS_CS);

    for (int ph = args.ph_lo; ph < args.ph_hi; ++ph) {
        if (ph == 0) p0_prologue(F);
        else if (ph == N_PHASES - 1) final_norm(F);
        else {
            const int L = (ph - 1) / 5, kind = (ph - 1) % 5;
            bf16* HIN = (bf16*)(F.ws + ((L & 1) ? WS_BUFB : WS_BUFA));
            bf16* MIX = (bf16*)(F.ws + ((L & 1) ? WS_BUFA : WS_BUFB));
            if (kind == 0) {
                EpiP1 E{Z, SSQ2, SSQQ, SSQKV, CS};
                const bf16* Bt = (const bf16*)(F.ws + WS_WIN) + (size_t)L * DINP * DM;
                if (MK_NAIVE & 1) naive_gemm(F, HIN, DM, Bt, DM, DINP, E);
                else fast_gemm(F, HIN, DM, Bt, DM, DINP, E);
            } else if (kind == 1) {
                EpiUp E{U, SSQQ, SSQKV, CS};
                const bf16* Bt = (const bf16*)(F.ws + WS_WUP) + (size_t)L * DUP * KUP;
                if (MK_NAIVE & 1) naive_gemm(F, Z + ZC_CQ, DINP, Bt, KUP, DUP, E);
                else fast_gemm(F, Z + ZC_CQ, DINP, Bt, KUP, DUP, E);
                __syncthreads();
                if (MK_NAIVE & 2) naive_attn_a(F, L); else fast_attn_a(F, L);
            } else if (kind == 2) {
                if (MK_NAIVE & 4) naive_attn_b(F, L); else fast_attn_b(F, L);
            } else if (kind == 3) {
                EpiPe E0{PE};
                const bf16* Bpe = (const bf16*)(F.ws + WS_WPE) + (size_t)L * DM * DPLE;
                const bf16* PBl = (const bf16*)(F.ws + WS_PB) + (size_t)L * T * DPLE;
                if (MK_NAIVE & 1) naive_gemm(F, PBl, DPLE, Bpe, DPLE, DM, E0);
                else fast_gemm(F, PBl, DPLE, Bpe, DPLE, DM, E0);
                __syncthreads();
                EpiOut E1{L == 0 ? F.x : F.out, F.out, HIN, SSQ1};
                const bf16* Bo = (const bf16*)(F.ws + WS_WOUT) + (size_t)L * DM * DM;
                if (MK_NAIVE & 1) naive_gemm(F, MIX, DM, Bo, DM, DM, E1);
                else fast_gemm(F, MIX, DM, Bo, DM, DM, E1);
            } else {
                EpiGate E{F.out, MIX, PE, F.b_pg + (size_t)L * DM, SSQ1, SSQ2};
                const bf16* Bg = (const bf16*)(F.ws + WS_WPG) + (size_t)L * DM * DM;
                if (MK_NAIVE & 1) naive_gemm(F, HIN, DM, Bg, DM, DM, E);
                else fast_gemm(F, HIN, DM, Bg, DM, DM, E);
            }
        }
        if (ph + 1 < args.ph_hi) xcd_barrier(bar);
    }
}

extern "C" void kernel_launch(void* const* d_in, const int* in_sizes, int n_in, void* d_out, int out_size, void* d_ws, size_t ws_size, hipStream_t stream) {
    static int grid = 0;
    if (grid == 0) {
        if (n_in != 16 || in_sizes[0] != T * DM || out_size != T * DM || ws_size < WS_END) {
            fprintf(stderr, "kernel_launch: unexpected shapes (n_in %d, in0 %d, out %d, ws %zu); nothing launched\n", n_in, n_in > 0 ? in_sizes[0] : -1, out_size, ws_size); grid = -1; return; }
        int dev = 0, cus = 0, per_cu = 0;
        if (hipGetDevice(&dev) != hipSuccess || hipDeviceGetAttribute(&cus, hipDeviceAttributeMultiprocessorCount, dev) != hipSuccess) { grid = -1; return; }
        if (hipFuncSetAttribute((const void*)trunk_fwd, hipFuncAttributeMaxDynamicSharedMemorySize, LDS_BYTES) != hipSuccess) { fprintf(stderr, "kernel_launch: hipFuncSetAttribute failed\n"); grid = -1; return; }
        if (hipOccupancyMaxActiveBlocksPerMultiprocessor(&per_cu, (const void*)trunk_fwd, NTHREADS, LDS_BYTES) != hipSuccess || per_cu < 1)
            fprintf(stderr, "kernel_launch: note: occupancy query reports %d workgroups per CU\n", per_cu);
        (void)hipGetLastError();
        grid = cus;
    }
    if (grid < 0) return;
    if (hipMemsetAsync((char*)d_ws + WS_CTL, 0, CTL_ZERO_BYTES, stream) != hipSuccess) { fprintf(stderr, "kernel_launch: hipMemsetAsync failed\n"); return; }
    Args a{};
    for (int i = 0; i < 16; ++i) a.in[i] = d_in[i];
    a.out = (float*)d_out; a.ws = (unsigned char*)d_ws;
    for (int li = 0; li < MK_N_LAUNCHES; ++li) {
        a.ph_lo = (MK_N_LAUNCHES == 1) ? 0 : li; a.ph_hi = (MK_N_LAUNCHES == 1) ? N_PHASES : li + 1; a.li = li;
        hipLaunchKernelGGL(trunk_fwd, dim3(grid), dim3(NTHREADS), LDS_BYTES, stream, a);
        const hipError_t le = hipPeekAtLastError();
        if (le != hipSuccess) { fprintf(stderr, "kernel_launch: launch %d failed: %s\n", li, hipGetErrorName(le)); break; }
    }
}
```

```cpp
#include <hip/hip_runtime.h>
#include <cstdio>
#include <cstdint>

#ifndef MK_N_LAUNCHES
#define MK_N_LAUNCHES 1
#endif
#ifndef MK_NAIVE
#define MK_NAIVE 0xE
#endif

constexpr int NB = 16, SEQ = 2048, T = NB * SEQ, DM = 1024, DIN = 3008, DINP = 3072, DPLE = 256, DEPTH = 2;
constexpr int DUP = 1792, KUP = 384;
constexpr float EPS = 1e-6f;
constexpr float LOG2E = 1.4426950408889634f;
constexpr float QA_SCALE = 0.125f * LOG2E;
constexpr float QB_SCALE = 0.07216878364870322f * LOG2E;
constexpr int ZC_QA = 0, ZC_KA = 512, ZC_VA = 1024, ZC_GA = 1536, ZC_GB = 2048, ZC_CQ = 2560, ZC_CKV = 2816, ZC_KR = 2944, ZC_PAD = 3008;
constexpr int UC_QN = 0, UC_QR = 512, UC_KN = 768, UC_V = 1280;

constexpr size_t MiB = 1u << 20;
constexpr size_t WS_CTL = 0, CTL_ZERO_BYTES = 1 * MiB;
constexpr size_t WS_WIN = 1 * MiB;
constexpr size_t WS_WUP = 13 * MiB;
constexpr size_t WS_WOUT = 16 * MiB;
constexpr size_t WS_WPG = 20 * MiB;
constexpr size_t WS_WPE = 24 * MiB;
constexpr size_t WS_CS = 25 * MiB;
constexpr size_t WS_SSQ1 = 33 * MiB;
constexpr size_t WS_SSQ2 = 37 * MiB;
constexpr size_t WS_SSQQ = 41 * MiB;
constexpr size_t WS_SSQKV = 42 * MiB;
constexpr size_t WS_PB = 43 * MiB;
constexpr size_t WS_BUFA = 75 * MiB;
constexpr size_t WS_BUFB = 139 * MiB;
constexpr size_t WS_Z = 203 * MiB;
constexpr size_t WS_U = 395 * MiB;
constexpr size_t WS_END = 507 * MiB;

constexpr int NWAVES = 8, NTHREADS = 512;
constexpr int RING_BYTES = 131072, LDSCTL_OFF = RING_BYTES, MISC_OFF = LDSCTL_OFF + 320, LDS_BYTES = 147456;

#define GAS __attribute__((address_space(1)))
#define LAS __attribute__((address_space(3)))
typedef unsigned short bf16;
typedef unsigned v4u __attribute__((ext_vector_type(4)));
typedef unsigned v2u __attribute__((ext_vector_type(2)));
typedef float f32x4 __attribute__((ext_vector_type(4)));
typedef float f32x2 __attribute__((ext_vector_type(2)));
typedef float f32x16 __attribute__((ext_vector_type(16)));
typedef short bf16x8 __attribute__((ext_vector_type(8)));
typedef short s16x4 __attribute__((ext_vector_type(4)));
typedef __bf16 bf16x2_t __attribute__((ext_vector_type(2)));
typedef GAS unsigned gu32;
#define RLX_AGENT __ATOMIC_RELAXED, __HIP_MEMORY_SCOPE_AGENT

__device__ __forceinline__ float bf2f(unsigned b) { return __uint_as_float(b << 16); }
__device__ __forceinline__ unsigned f2bf(float f) { unsigned u = __float_as_uint(f); return (u + 0x7fffu + ((u >> 16) & 1u)) >> 16; }
__device__ __forceinline__ unsigned pk2(float lo, float hi) { f32x2 v = {lo, hi}; bf16x2_t b = __builtin_convertvector(v, bf16x2_t); return __builtin_bit_cast(unsigned, b); }
__device__ __forceinline__ float silu_f(float v) { return v / (1.0f + __expf(-v)); }
__device__ __forceinline__ float sigmoid_f(float v) { return 1.0f / (1.0f + __expf(-v)); }
__device__ __forceinline__ void unpack8(v4u w, float (&f)[8]) {
    f[0] = bf2f(w.x & 0xffffu); f[1] = bf2f(w.x >> 16); f[2] = bf2f(w.y & 0xffffu); f[3] = bf2f(w.y >> 16);
    f[4] = bf2f(w.z & 0xffffu); f[5] = bf2f(w.z >> 16); f[6] = bf2f(w.w & 0xffffu); f[7] = bf2f(w.w >> 16);
}
__device__ __forceinline__ v4u pack8(const float (&f)[8]) { v4u w; w.x = pk2(f[0], f[1]); w.y = pk2(f[2], f[3]); w.z = pk2(f[4], f[5]); w.w = pk2(f[6], f[7]); return w; }

__device__ const float INV_FREQ[32] = {
    1.000000000e+00f, 7.498942614e-01f, 5.623413324e-01f, 4.216965139e-01f, 3.162277639e-01f, 2.371373773e-01f, 1.778279394e-01f, 1.333521307e-01f,
    1.000000015e-01f, 7.498941571e-02f, 5.623413250e-02f, 4.216965288e-02f, 3.162277490e-02f, 2.371373773e-02f, 1.778279431e-02f, 1.333521493e-02f,
    9.999999776e-03f, 7.498941850e-03f, 5.623413250e-03f, 4.216964822e-03f, 3.162277630e-03f, 2.371373586e-03f, 1.778279431e-03f, 1.333521446e-03f,
    1.000000047e-03f, 7.498942432e-04f, 5.623413017e-04f, 4.216965172e-04f, 3.162277571e-04f, 2.371373703e-04f, 1.778279402e-04f, 1.333521504e-04f};

#define XB_TMO      128
#define XB_XCNT(j)  (256  + 64 * (j))
#define XB_XSUB(j)  (1280 + 64 * (j))
#define XB_XGEN(j)  (2304 + 64 * (j))
#define XB_TOP      3328
#define XB_TOPGEN   3392
#define XCD_BAR_WORDS 3456
#define XB_SPIN_CAP (1u << 22)
constexpr int CW_BAR = 4096;

__device__ __forceinline__ unsigned xb_ld(unsigned* p)              { return __hip_atomic_load(p, __ATOMIC_RELAXED, __HIP_MEMORY_SCOPE_AGENT); }
__device__ __forceinline__ unsigned xb_add(unsigned* p, unsigned v) { return __hip_atomic_fetch_add(p, v, __ATOMIC_RELAXED, __HIP_MEMORY_SCOPE_AGENT); }
__device__ __forceinline__ unsigned xb_xcc_id() { return (unsigned)__builtin_amdgcn_s_getreg((3 << 11) | 20) & 0xFu; }
#define XB_SPIN(cond, bar) do { unsigned _sp = 0; while (cond) { __builtin_amdgcn_s_sleep(1); \
    if ((++_sp & 255u) == 0u) { if (xb_ld(&(bar)[XB_TMO])) break; if (_sp > XB_SPIN_CAP) { atomicAdd(&(bar)[XB_TMO], 1u); break; } } } } while (0)
struct XcdBarrier { unsigned* bar; unsigned x; volatile LAS unsigned* st; };
__device__ __forceinline__ XcdBarrier xcd_barrier_post(unsigned* bar, volatile LAS unsigned* st) {
    XcdBarrier b; b.bar = bar; b.x = xb_xcc_id(); b.st = st;
    if (threadIdx.x == 0) (void)xb_add(&bar[XB_XCNT(b.x)], 1u);
    return b;
}
__device__ __forceinline__ void xcd_barrier_complete(unsigned* bar, unsigned x, unsigned& nloc, unsigned& nx) {
    const unsigned G = gridDim.x * gridDim.y * gridDim.z;
    unsigned sum, cnt, mine, sp = 0u;
    for (;;) {
        sum = 0u; cnt = 0u; mine = 0u;
#pragma unroll
        for (unsigned j = 0; j < 16; ++j) { const unsigned c = xb_ld(&bar[XB_XCNT(j)]); sum += c; cnt += (c > 0u) ? 1u : 0u; mine = (j == x) ? c : mine; }
        if (sum == G) break;
        __builtin_amdgcn_s_sleep(1);
        if ((++sp & 255u) == 0u) { if (xb_ld(&bar[XB_TMO])) break; if (sp > XB_SPIN_CAP) { atomicAdd(&bar[XB_TMO], 1u); break; } }
    }
    nloc = mine > 0u ? mine : 1u; nx = cnt > 0u ? cnt : 1u;
}
__device__ __forceinline__ void xcd_barrier(const XcdBarrier& b) {
    asm volatile("s_waitcnt vmcnt(0)" ::: "memory");
    __syncthreads();
    if (threadIdx.x == 0) {
        unsigned* bar = b.bar;
        __builtin_amdgcn_s_waitcnt(0);
        unsigned nloc = b.st[0], nx = b.st[1];
        if (nloc == 0u) { xcd_barrier_complete(bar, b.x, nloc, nx); b.st[0] = nloc; b.st[1] = nx; }
        const unsigned old = xb_add(&bar[XB_XSUB(b.x)], 1u);
        const unsigned gen = old / nloc;
        if (old + 1u == (gen + 1u) * nloc) {
            __builtin_amdgcn_fence(__ATOMIC_RELEASE, "agent");
            asm volatile("s_waitcnt vmcnt(0)" ::: "memory");
            const unsigned og = xb_add(&bar[XB_TOP], 1u);
            const unsigned tg = og / nx;
            if (og + 1u == (tg + 1u) * nx) xb_add(&bar[XB_TOPGEN], 1u);
            else XB_SPIN(xb_ld(&bar[XB_TOPGEN]) == tg, bar);
            __builtin_amdgcn_fence(__ATOMIC_ACQUIRE, "agent");
            xb_add(&bar[XB_XGEN(b.x)], 1u);
            asm volatile("s_waitcnt vmcnt(0)" ::: "memory");
        } else {
            XB_SPIN(xb_ld(&bar[XB_XGEN(b.x)]) == gen, bar);
            __builtin_amdgcn_fence(__ATOMIC_ACQUIRE, "agent");
            asm volatile("s_waitcnt vmcnt(0)" ::: "memory");
        }
    }
    __syncthreads();
}

struct Args { const void* in[16]; float* out; unsigned char* ws; int ph_lo, ph_hi, li, pad; };
struct Frame {
    LAS unsigned char* lds;
    unsigned char* ws;
    const Args* a;
    int tid, lane, wave, vcu, G;
    float* out;
};
__device__ __forceinline__ void relaunder(Frame& F) {
    int tid = F.tid; asm volatile("" : "+v"(tid)); F.tid = tid; F.lane = tid & 63; F.wave = __builtin_amdgcn_readfirstlane(tid >> 6);
    unsigned char* w = F.ws; asm volatile("" : "+s"(w)); F.ws = w;
    float* o = F.out; asm volatile("" : "+s"(o)); F.out = o;
    unsigned lb = 0; asm volatile("" : "+s"(lb)); F.lds = F.lds + lb;
}
template <int I> __device__ __forceinline__ const float* inp(const Frame& F) { const void* p = F.a->in[I]; asm volatile("" : "+s"(p)); return (const float*)p; }
__device__ __forceinline__ float wave_sum(float v) {
#pragma unroll
    for (int o = 1; o < 64; o <<= 1) v += __shfl_xor(v, o);
    return v;
}
__device__ __forceinline__ float wave_max(float v) {
#pragma unroll
    for (int o = 1; o < 64; o <<= 1) v = fmaxf(v, __shfl_xor(v, o));
    return v;
}

struct WPtrs { const float *norm_mix, *w_in, *g_q, *w_uq, *g_kv, *w_ukv, *w_out, *norm_ple, *w_pe, *w_pg; };
__device__ __forceinline__ float wsrc(const WPtrs& F, int mat, int L, int n, int k) {
    if (mat == 0) {
        int sc;
        if (n < 2048) sc = n;
        else if (n < ZC_CQ) sc = 2496 + (n - ZC_GB);
        else if (n < ZC_CKV) sc = 2048 + (n - ZC_CQ);
        else if (n < ZC_KR) sc = 2304 + (n - ZC_CKV);
        else if (n < ZC_PAD) { const int j = n - ZC_KR; sc = 2432 + (j >> 1) + 32 * (j & 1); }
        else return 0.f;
        return F.w_in[((size_t)L * DM + k) * DIN + sc] * F.norm_mix[L * DM + k];
    } else if (mat == 1) {
        if (n < UC_KN) {
            if (k >= 256) return 0.f;
            int sc;
            if (n < UC_QR) sc = (n >> 7) * 192 + (n & 127);
            else { const int j = (n - UC_QR) & 63, hh = (n - UC_QR) >> 6; sc = hh * 192 + 128 + (j >> 1) + 32 * (j & 1); }
            return F.w_uq[((size_t)L * 256 + k) * 768 + sc] * F.g_q[L * 256 + k];
        } else {
            if (k < 256) return 0.f;
            const int kk = k - 256; int sc;
            if (n < UC_V) { const int m = n - UC_KN; sc = (m >> 7) * 256 + (m & 127); }
            else { const int m = n - UC_V; sc = (m >> 7) * 256 + 128 + (m & 127); }
            return F.w_ukv[((size_t)L * 128 + kk) * 1024 + sc] * F.g_kv[L * 128 + kk];
        }
    } else if (mat == 2) return F.w_out[((size_t)L * DM + k) * DM + n];
    else if (mat == 3) return F.w_pg[((size_t)L * DM + k) * DM + n] * F.norm_ple[L * DM + k];
    else return F.w_pe[((size_t)L * DPLE + k) * DM + n];
}
__device__ __forceinline__ void p0_prologue(const Frame& F) {
    const WPtrs W{inp<3>(F), inp<4>(F), inp<6>(F), inp<7>(F), inp<8>(F), inp<9>(F), inp<10>(F), inp<11>(F), inp<12>(F), inp<13>(F)};
    const float* xin = inp<0>(F); const float* pin = inp<1>(F); const int* positions = (const int*)inp<2>(F);
    {
        LAS float* scr = (LAS float*)F.lds;
        constexpr int NT0 = (DINP / 64) * (DM / 64), NT1 = (DUP / 64) * (KUP / 64), NT2 = 16 * 16, NT3 = 16 * 16, NT4 = 16 * 4;
        constexpr int NTL = NT0 + NT1 + NT2 + NT3 + NT4;
        for (int it = F.vcu; it < 2 * NTL; it += F.G) {
            const int L = it / NTL; int r = it % NTL; int mat, K, tn, tk; size_t base;
            if (r < NT0) { mat = 0; K = DM; base = WS_WIN + (size_t)L * DINP * DM * 2; }
            else if ((r -= NT0) < NT1) { mat = 1; K = KUP; base = WS_WUP + (size_t)L * DUP * KUP * 2; }
            else if ((r -= NT1) < NT2) { mat = 2; K = DM; base = WS_WOUT + (size_t)L * DM * DM * 2; }
            else if ((r -= NT2) < NT3) { mat = 3; K = DM; base = WS_WPG + (size_t)L * DM * DM * 2; }
            else { r -= NT3; mat = 4; K = DPLE; base = WS_WPE + (size_t)L * DM * DPLE * 2; }
            const int nkt = K / 64; tn = r / nkt; tk = r % nkt;
            const int n0 = tn * 64, k0 = tk * 64;
#pragma unroll
            for (int e = 0; e < 8; ++e) { const int idx = F.tid + 512 * e, kk = idx >> 6, nn = idx & 63; scr[kk * 65 + nn] = wsrc(W, mat, L, n0 + nn, k0 + kk); }
            __syncthreads();
            unsigned* dst = (unsigned*)(F.ws + base);
#pragma unroll
            for (int e = 0; e < 4; ++e) { const int idx = F.tid + 512 * e, nn = idx >> 5, kp = idx & 31;
                dst[((size_t)(n0 + nn) * K + k0) / 2 + kp] = pk2(scr[(2 * kp) * 65 + nn], scr[(2 * kp + 1) * 65 + nn]); }
            __syncthreads();
        }
    }
    const int gw = F.vcu * NWAVES + F.wave, NGW = F.G * NWAVES;
    {
        bf16* hb = (bf16*)(F.ws + WS_BUFA); float* ssq = (float*)(F.ws + WS_SSQ2);
        for (int m = gw; m < T; m += NGW) {
            const f32x4* xr = (const f32x4*)(xin + (size_t)m * DM) + F.lane;
            f32x4 v[4]; float s = 0.f;
#pragma unroll
            for (int j = 0; j < 4; ++j) { v[j] = xr[64 * j]; s += (v[j].x * v[j].x + v[j].y * v[j].y) + (v[j].z * v[j].z + v[j].w * v[j].w); }
            s = wave_sum(s);
            v2u* o8 = (v2u*)(hb + (size_t)m * DM) + F.lane;
#pragma unroll
            for (int j = 0; j < 4; ++j) { v2u w; w.x = pk2(v[j].x, v[j].y); w.y = pk2(v[j].z, v[j].w); o8[64 * j] = w; }
            if (F.lane < 32) ssq[(size_t)m * 32 + F.lane] = (F.lane == 0) ? s : 0.f;
        }
    }
    const int gt = F.vcu * NTHREADS + F.tid, NGT = F.G * NTHREADS;
    {
        v4u* pb = (v4u*)(F.ws + WS_PB);
        for (int i = gt; i < 2 * T * DPLE / 8; i += NGT) {
            const f32x4 a = ((const f32x4*)pin)[2 * i], b = ((const f32x4*)pin)[2 * i + 1];
            v4u w; w.x = pk2(a.x, a.y); w.y = pk2(a.z, a.w); w.z = pk2(b.x, b.y); w.w = pk2(b.z, b.w); pb[i] = w;
        }
    }
    {
        f32x2* cs = (f32x2*)(F.ws + WS_CS);
        for (int i = gt; i < T * 32; i += NGT) {
            const int t = i >> 5, fi = i & 31;
            const float angf = (float)positions[t] * INV_FREQ[fi];
            const double a = (double)angf;
            const double kq = __builtin_rint(a * 0.63661977236758134308);
            const double r = (a - kq * 1.57079632679489655800) - kq * 6.12323399573676603587e-17;
            const double r2 = r * r;
            const double sn = r * (1.0 + r2 * (-1.0 / 6 + r2 * (1.0 / 120 + r2 * (-1.0 / 5040 + r2 * (1.0 / 362880 + r2 * (-1.0 / 39916800))))));
            const double cn = 1.0 + r2 * (-0.5 + r2 * (1.0 / 24 + r2 * (-1.0 / 720 + r2 * (1.0 / 40320 + r2 * (-1.0 / 3628800 + r2 * (1.0 / 479001600))))));
            const int q = (int)((long long)kq & 3);
            const double c = (q == 0) ? cn : (q == 1) ? -sn : (q == 2) ? -cn : sn;
            const double s = (q == 0) ? sn : (q == 1) ? cn : (q == 2) ? -sn : -cn;
            cs[i] = (f32x2){(float)c, (float)s};
        }
    }
}

struct EpiP1 {
    static constexpr bool HAS_SSQ = true;
    bf16* Z; const float* ssq_h; float* ssq_q; float* ssq_kv; const f32x2* cs;
    __device__ __forceinline__ float rowsum_part(int row, int part, int) const { const f32x4* s = (const f32x4*)(ssq_h + (size_t)row * 32 + part * 8); const f32x4 a = s[0], b = s[1]; return ((a.x + a.y) + (a.z + a.w)) + ((b.x + b.y) + (b.z + b.w)); }
    __device__ __forceinline__ float rowscale_from(float tot, int) const { return rsqrtf(tot * (1.0f / DM) + EPS); }
    __device__ __forceinline__ float run8(int row, int col0, float rs, float (&v)[8]) const {
        float ss = 0.f;
#pragma unroll
        for (int j = 0; j < 8; ++j) v[j] *= rs;
        if (col0 < ZC_KA) {
#pragma unroll
            for (int j = 0; j < 8; ++j) v[j] *= QA_SCALE;
        } else if (col0 >= ZC_GA && col0 < ZC_CQ) {
#pragma unroll
            for (int j = 0; j < 8; ++j) v[j] = silu_f(v[j]);
        } else if (col0 >= ZC_KR && col0 < ZC_PAD) {
            const f32x4* c4 = (const f32x4*)(cs + (size_t)row * 32 + ((col0 - ZC_KR) >> 1));
            const f32x4 c01 = c4[0], c23 = c4[1];
            const float cc[4] = {c01.x, c01.z, c23.x, c23.z}, sn[4] = {c01.y, c01.w, c23.y, c23.w};
#pragma unroll
            for (int i = 0; i < 4; ++i) { const float x1 = v[2 * i], x2 = v[2 * i + 1]; v[2 * i] = x1 * cc[i] - x2 * sn[i]; v[2 * i + 1] = x2 * cc[i] + x1 * sn[i]; }
        }
        const v4u w = pack8(v);
        *(v4u*)(Z + (size_t)row * DINP + col0) = w;
        if (col0 >= ZC_CQ && col0 < ZC_KR) { float f[8]; unpack8(w, f);
#pragma unroll
            for (int j = 0; j < 8; ++j) ss += f[j] * f[j]; }
        return ss;
    }
    __device__ __forceinline__ void ssq(int row, int grp, float s) const {
        if (grp >= ZC_CQ / 32 && grp < ZC_CKV / 32) ssq_q[(size_t)row * 8 + (grp - ZC_CQ / 32)] = s;
        else if (grp >= ZC_CKV / 32 && grp < ZC_KR / 32) ssq_kv[(size_t)row * 4 + (grp - ZC_CKV / 32)] = s;
    }
};
struct EpiUp {
    static constexpr bool HAS_SSQ = false;
    bf16* U; const float* ssq_q; const float* ssq_kv; const f32x2* cs;
    __device__ __forceinline__ float rowsum_part(int row, int part, int col0) const {
        if (col0 < UC_KN) { const f32x2 a = *(const f32x2*)(ssq_q + (size_t)row * 8 + part * 2); return a.x + a.y; }
        return ssq_kv[(size_t)row * 4 + part];
    }
    __device__ __forceinline__ float rowscale_from(float tot, int col0) const { return (col0 < UC_KN) ? rsqrtf(tot * (1.0f / 256) + EPS) * QB_SCALE : rsqrtf(tot * (1.0f / 128) + EPS); }
    __device__ __forceinline__ float run8(int row, int col0, float rs, float (&v)[8]) const {
#pragma unroll
        for (int j = 0; j < 8; ++j) v[j] *= rs;
        if (col0 >= UC_QR && col0 < UC_KN) {
            const f32x4* c4 = (const f32x4*)(cs + (size_t)row * 32 + (((col0 - UC_QR) & 63) >> 1));
            const f32x4 c01 = c4[0], c23 = c4[1];
            const float cc[4] = {c01.x, c01.z, c23.x, c23.z}, sn[4] = {c01.y, c01.w, c23.y, c23.w};
#pragma unroll
            for (int i = 0; i < 4; ++i) { const float x1 = v[2 * i], x2 = v[2 * i + 1]; v[2 * i] = x1 * cc[i] - x2 * sn[i]; v[2 * i + 1] = x2 * cc[i] + x1 * sn[i]; }
        }
        *(v4u*)(U + (size_t)row * DUP + col0) = pack8(v);
        return 0.f;
    }
    __device__ __forceinline__ void ssq(int, int, float) const {}
};
struct EpiPe {
    static constexpr bool HAS_SSQ = false;
    bf16* PE;
    __device__ __forceinline__ float rowsum_part(int, int, int) const { return 0.f; }
    __device__ __forceinline__ float rowscale_from(float, int) const { return 1.f; }
    __device__ __forceinline__ float run8(int row, int col0, float, float (&v)[8]) const { *(v4u*)(PE + (size_t)row * DM + col0) = pack8(v); return 0.f; }
    __device__ __forceinline__ void ssq(int, int, float) const {}
};
struct EpiOut {
    static constexpr bool HAS_SSQ = true;
    const float* res; float* out; bf16* hb; float* ssq_o;
    __device__ __forceinline__ float rowsum_part(int, int, int) const { return 0.f; }
    __device__ __forceinline__ float rowscale_from(float, int) const { return 1.f; }
    __device__ __forceinline__ float run8(int row, int col0, float, float (&v)[8]) const {
        const size_t off = (size_t)row * DM + col0;
        const f32x4 a = *(const f32x4*)(res + off), b = *(const f32x4*)(res + off + 4);
        v[0] += a.x; v[1] += a.y; v[2] += a.z; v[3] += a.w; v[4] += b.x; v[5] += b.y; v[6] += b.z; v[7] += b.w;
        *(f32x4*)(out + off) = (f32x4){v[0], v[1], v[2], v[3]}; *(f32x4*)(out + off + 4) = (f32x4){v[4], v[5], v[6], v[7]};
        *(v4u*)(hb + off) = pack8(v);
        float ss = 0.f;
#pragma unroll
        for (int j = 0; j < 8; ++j) ss += v[j] * v[j];
        return ss;
    }
    __device__ __forceinline__ void ssq(int row, int grp, float s) const { ssq_o[(size_t)row * 32 + grp] = s; }
};
struct EpiGate {
    static constexpr bool HAS_SSQ = true;
    float* out; bf16* hb; const bf16* PE; const float* bias; const float* ssq_i; float* ssq_o;
    __device__ __forceinline__ float rowsum_part(int row, int part, int) const { const f32x4* s = (const f32x4*)(ssq_i + (size_t)row * 32 + part * 8); const f32x4 a = s[0], b = s[1]; return ((a.x + a.y) + (a.z + a.w)) + ((b.x + b.y) + (b.z + b.w)); }
    __device__ __forceinline__ float rowscale_from(float tot, int) const { return rsqrtf(tot * (1.0f / DM) + EPS); }
    __device__ __forceinline__ float run8(int row, int col0, float rs, float (&v)[8]) const {
        const size_t off = (size_t)row * DM + col0;
        const f32x4 a = *(const f32x4*)(out + off), b = *(const f32x4*)(out + off + 4);
        const f32x4 ba = *(const f32x4*)(bias + col0), bb = *(const f32x4*)(bias + col0 + 4);
        float pe[8]; unpack8(*(const v4u*)(PE + off), pe);
        const float h[8] = {a.x, a.y, a.z, a.w, b.x, b.y, b.z, b.w}, bs[8] = {ba.x, ba.y, ba.z, ba.w, bb.x, bb.y, bb.z, bb.w};
        float ss = 0.f;
#pragma unroll
        for (int j = 0; j < 8; ++j) { v[j] = h[j] + pe[j] * sigmoid_f(v[j] * rs + bs[j]); ss += v[j] * v[j]; }
        *(f32x4*)(out + off) = (f32x4){v[0], v[1], v[2], v[3]}; *(f32x4*)(out + off + 4) = (f32x4){v[4], v[5], v[6], v[7]};
        *(v4u*)(hb + off) = pack8(v);
        return ss;
    }
    __device__ __forceinline__ void ssq(int row, int grp, float s) const { ssq_o[(size_t)row * 32 + grp] = s; }
};

template <class EP> __device__ __forceinline__ void naive_gemm(const Frame& F, const bf16* A, int lda, const bf16* Bt, int K, int N, const EP& E) {
    const int gt = F.vcu * NTHREADS + F.tid, NGT = F.G * NTHREADS;
    const int ng = N / 32;
    for (int it = gt; it < T * ng; it += NGT) {
        const int row = it % T, cg = it / T, col0 = cg * 32;
        float acc[32];
#pragma unroll
        for (int j = 0; j < 32; ++j) acc[j] = 0.f;
        const bf16* ap = A + (size_t)row * lda; const bf16* bp = Bt + (size_t)col0 * K;
        for (int k0 = 0; k0 < K; k0 += 8) {
            float a[8]; unpack8(*(const v4u*)(ap + k0), a);
#pragma unroll
            for (int j = 0; j < 32; ++j) { float b[8]; unpack8(*(const v4u*)(bp + (size_t)j * K + k0), b);
#pragma unroll
                for (int e = 0; e < 8; ++e) acc[j] += a[e] * b[e]; }
        }
        float tot = 0.f;
#pragma unroll
        for (int part = 0; part < 4; ++part) tot += E.rowsum_part(row, part, col0);
        const float rs = E.rowscale_from(tot, col0);
        float ss = 0.f;
#pragma unroll
        for (int g = 0; g < 4; ++g) { float v[8];
#pragma unroll
            for (int j = 0; j < 8; ++j) v[j] = acc[g * 8 + j];
            ss += E.run8(row, col0 + g * 8, rs, v); }
        if (EP::HAS_SSQ) E.ssq(row, cg, ss);
    }
}
__device__ __forceinline__ void naive_attn_a(const Frame& F, int L) {
    const bf16* Z = (const bf16*)(F.ws + WS_Z); bf16* MIX = (bf16*)(F.ws + ((L & 1) ? WS_BUFA : WS_BUFB));
    LAS float* sc = (LAS float*)F.lds + F.wave * 640;
    const float* rb = inp<5>(F) + (size_t)L * 8 * 257;
    const int gw = F.vcu * NWAVES + F.wave, NGW = F.G * NWAVES;
    for (int it = gw; it < T * 8; it += NGW) {
        const int row = it >> 3, h = it & 7, b = row >> 11, sq = row & 2047, cq = sq >> 6, ql = sq & 63;
        float q[64];
#pragma unroll
        for (int c = 0; c < 8; ++c) { float f[8]; unpack8(*(const v4u*)(Z + (size_t)row * DINP + ZC_QA + 64 * h + 8 * c), f);
#pragma unroll
            for (int e = 0; e < 8; ++e) q[8 * c + e] = f[e]; }
        float s[9]; float mx = -1e30f;
#pragma unroll
        for (int bi = 0; bi < 9; ++bi) {
            const int j = cq - 8 + bi; s[bi] = -1e30f;
            if (j >= 0) {
                const bf16* kp = Z + (size_t)(b * SEQ + 64 * j + F.lane) * DINP + ZC_KA + 64 * h; float d = 0.f;
#pragma unroll
                for (int c = 0; c < 8; ++c) { float f[8]; unpack8(*(const v4u*)(kp + 8 * c), f);
#pragma unroll
                    for (int e = 0; e < 8; ++e) d += q[8 * c + e] * f[e]; }
                int rel = (ql + 512) - (64 * bi + F.lane); rel = rel > 128 ? 128 : rel;
                s[bi] = d + rb[h * 257 + rel + 128] * LOG2E; mx = fmaxf(mx, s[bi]);
            }
        }
        mx = wave_max(mx); float l = 0.f;
#pragma unroll
        for (int bi = 0; bi < 9; ++bi) { const float pv = (cq - 8 + bi >= 0) ? exp2f(s[bi] - mx) : 0.f; l += pv; sc[64 * bi + F.lane] = pv; }
        l = wave_sum(l);
        asm volatile("s_waitcnt lgkmcnt(0)" ::: "memory");
        float o = 0.f;
        for (int bi = 0; bi < 9; ++bi) { const int j = cq - 8 + bi; if (j < 0) continue;
            const bf16* vp = Z + (size_t)(b * SEQ + 64 * j) * DINP + ZC_VA + 64 * h + F.lane;
            for (int kl = 0; kl < 64; ++kl) o += sc[64 * bi + kl] * bf2f(vp[(size_t)kl * DINP]); }
        const float g = bf2f(Z[(size_t)row * DINP + ZC_GA + 64 * h + F.lane]);
        MIX[(size_t)row * DM + 64 * h + F.lane] = (bf16)f2bf(o / l * g);
        asm volatile("s_waitcnt lgkmcnt(0)" ::: "memory");
    }
}
__device__ __forceinline__ void naive_attn_b(const Frame& F, int L) {
    const bf16* Z = (const bf16*)(F.ws + WS_Z); const bf16* U = (const bf16*)(F.ws + WS_U); bf16* MIX = (bf16*)(F.ws + ((L & 1) ? WS_BUFA : WS_BUFB));
    LAS float* sc = (LAS float*)F.lds + F.wave * 2048;
    const int gw = F.vcu * NWAVES + F.wave, NGW = F.G * NWAVES;
    for (int it = gw; it < T * 4; it += NGW) {
        const int row = it >> 2, h = it & 3, b = row >> 11, sq = row & 2047, cq = sq >> 6;
        const int nk = (cq + 1) * 64;
        const bf16* qn = U + (size_t)row * DUP + UC_QN + 128 * h; const bf16* qr = U + (size_t)row * DUP + UC_QR + 64 * h;
        float mx = -1e30f;
        for (int k0 = 0; k0 < nk; k0 += 64) {
            const int key = b * SEQ + k0 + F.lane;
            const bf16* kn = U + (size_t)key * DUP + UC_KN + 128 * h; const bf16* kr = Z + (size_t)key * DINP + ZC_KR;
            float d = 0.f;
            for (int c = 0; c < 16; ++c) { float a[8], f[8]; unpack8(*(const v4u*)(qn + 8 * c), a); unpack8(*(const v4u*)(kn + 8 * c), f);
#pragma unroll
                for (int e = 0; e < 8; ++e) d += a[e] * f[e]; }
            for (int c = 0; c < 8; ++c) { float a[8], f[8]; unpack8(*(const v4u*)(qr + 8 * c), a); unpack8(*(const v4u*)(kr + 8 * c), f);
#pragma unroll
                for (int e = 0; e < 8; ++e) d += a[e] * f[e]; }
            sc[k0 + F.lane] = d; mx = fmaxf(mx, d);
        }
        mx = wave_max(mx); float l = 0.f;
        for (int k0 = 0; k0 < nk; k0 += 64) { const float pv = exp2f(sc[k0 + F.lane] - mx); l += pv; sc[k0 + F.lane] = pv; }
        l = wave_sum(l);
        asm volatile("s_waitcnt lgkmcnt(0)" ::: "memory");
        float o0 = 0.f, o1 = 0.f;
        const bf16* vp = U + (size_t)(b * SEQ) * DUP + UC_V + 128 * h + F.lane;
        for (int k = 0; k < nk; ++k) { const float pv = sc[k]; o0 += pv * bf2f(vp[(size_t)k * DUP]); o1 += pv * bf2f(vp[(size_t)k * DUP + 64]); }
        const float g0 = bf2f(Z[(size_t)row * DINP + ZC_GB + 128 * h + F.lane]), g1 = bf2f(Z[(size_t)row * DINP + ZC_GB + 128 * h + 64 + F.lane]);
        MIX[(size_t)row * DM + 512 + 128 * h + F.lane] = (bf16)f2bf(o0 / l * g0);
        MIX[(size_t)row * DM + 512 + 128 * h + 64 + F.lane] = (bf16)f2bf(o1 / l * g1);
        asm volatile("s_waitcnt lgkmcnt(0)" ::: "memory");
    }
}

namespace pg8 {
#define PG8_LAS __attribute__((address_space(3)))
constexpr int BM = 256, BK = 64, HALF = 128, HTB = HALF * BK * 2, STAGE_BYTES = 8 * HTB, NXCD = 8, WGM = 8;
__host__ __device__ __forceinline__ int lds_byte(int r, int c) { const int st = (r >> 4) * 2 + (c >> 5), rr = r & 15, cc = c & 31, ob = rr * 64 + cc * 2; return st * 1024 + (ob ^ (((ob >> 9) & 1) << 5)); }
__host__ __device__ __forceinline__ void stage_rc(int b, int& R, int& C) { const int st = b / 1024, sb = b % 1024, swz = sb ^ (((sb >> 9) & 1) << 5); R = (st >> 1) * 16 + swz / 64; C = (st & 1) * 32 + (swz % 64) / 2; }
__host__ __device__ __forceinline__ int perm32(int rho) { const int n = rho >> 4, i = rho & 15; return 8 * (i >> 2) + 4 * n + (i & 3); }
struct Unit { int pm, pn; };
struct Gemm { const bf16* A; int lda; const bf16* Bt; int M, N, K; };
struct StaticOrder {
    int nM, nN, nwg, G, c;
    __device__ void init(int M, int N, int G_, int c_) { nM = M / BM; nN = N / BM; nwg = nM * nN; G = G_; c = c_; }
    __device__ bool next(int i, Unit& u) const {
        const long L = (long)i * G + c; if (L >= nwg) return false;
        int wgid = (int)L; { const int q = nwg / NXCD, r = nwg % NXCD, xcd = wgid % NXCD, off = wgid / NXCD; wgid = (xcd < r ? xcd * (q + 1) : r * (q + 1) + (xcd - r) * q) + off; }
        const int nig = WGM * nN, gid = wgid / nig, fm = gid * WGM, gsz = (nM - fm) < WGM ? (nM - fm) : WGM;
        u.pm = fm + ((wgid % nig) % gsz); u.pn = (wgid % nig) / gsz; return true;
    }
};
template <class EP> struct FastEpi {
    EP e;
    __device__ __forceinline__ void operator()(const f32x4 (&acc)[2][2][4][2], const Unit& u, int wr, int wc, int fr, int fq) const {
        const int colt = u.pn * BM + wc * 32 + 8 * fq;
#pragma unroll
        for (int ai = 0; ai < 2; ++ai)
#pragma unroll
            for (int m = 0; m < 4; ++m) {
                const int row = u.pm * BM + ai * HALF + wr * 64 + m * 16 + fr;
                float part = e.rowsum_part(row, fq, u.pn * BM); part += __shfl_xor(part, 16); part += __shfl_xor(part, 32);
                const float rs = e.rowscale_from(part, u.pn * BM);
#pragma unroll
                for (int bj = 0; bj < 2; ++bj) {
                    float v[8] = {acc[ai][bj][m][0][0], acc[ai][bj][m][0][1], acc[ai][bj][m][0][2], acc[ai][bj][m][0][3], acc[ai][bj][m][1][0], acc[ai][bj][m][1][1], acc[ai][bj][m][1][2], acc[ai][bj][m][1][3]};
                    float s = e.run8(row, colt + bj * HALF, rs, v);
                    if (EP::HAS_SSQ) { s += __shfl_xor(s, 16); s += __shfl_xor(s, 32); if (fq == 0) e.ssq(row, (u.pn * BM + bj * HALF + wc * 32) >> 5, s); }
                }
            }
    }
};

template <class Epi>
__device__ __forceinline__ void gemm_phase(PG8_LAS unsigned char* lds, const int tid, const Gemm g, const StaticOrder& S, const Epi& E) {
    const int wid = __builtin_amdgcn_readfirstlane(tid >> 6), lane = tid & 63, wr = wid >> 2, wc = wid & 3, fr = lane & 15, fq = lane >> 4;
    const int K = g.K, nt = K / BK, lda = g.lda;
    unsigned voffA[2], voffB[2];
#pragma unroll
    for (int i = 0; i < 2; ++i) { int R, C; stage_rc(tid * 16 + i * 8192, R, C); const int Rb = (R & ~31) + perm32(R & 31);
        voffA[i] = (unsigned)(R * lda + C) * 2u; voffB[i] = (unsigned)(Rb * K + C) * 2u; }
    const size_t kstep = (size_t)(BK * 2);
    const size_t hstepA = (size_t)HALF * lda * 2, hstepB = (size_t)HALF * K * 2;
    const size_t tstepA = 2 * hstepA, tstepB = 2 * hstepB;
    const unsigned ldsw = (unsigned)wid * 1024u;
    const int aoff = lds_byte(wr * 64 + fr, fq * 8), boff = lds_byte(wc * 32 + fr, fq * 8);
#define PG8_SA(b, h) (((b) * 2 + (h)) * HTB)
#define PG8_SB(b, h) ((4 + (b) * 2 + (h)) * HTB)
#define PG8_STAGE(bufoff, gbase, voff) do { _Pragma("unroll") for (int _i = 0; _i < 2; ++_i) \
        __builtin_amdgcn_global_load_lds((const unsigned*)((const char*)(gbase) + (voff)[_i]), (PG8_LAS unsigned*)(lds + (bufoff) + ldsw + _i * 8192), 16, 0, 0); } while (0)
#define PG8_LDA(dst, b, h) do { _Pragma("unroll") for (int m = 0; m < 4; ++m) _Pragma("unroll") for (int k = 0; k < 2; ++k) dst[m][k] = *(const PG8_LAS bf16x8*)(lds + PG8_SA(b, h) + aoff + m * 2048 + k * 1024); } while (0)
#define PG8_LDB(dst, b, h) do { _Pragma("unroll") for (int n = 0; n < 2; ++n) _Pragma("unroll") for (int k = 0; k < 2; ++k) dst[n][k] = *(const PG8_LAS bf16x8*)(lds + PG8_SB(b, h) + boff + n * 2048 + k * 1024); } while (0)
#define PG8_MMA(ai, bj, At, Bt) do { __builtin_amdgcn_s_setprio(1); _Pragma("unroll") for (int m = 0; m < 4; ++m) _Pragma("unroll") for (int n = 0; n < 2; ++n) _Pragma("unroll") for (int k = 0; k < 2; ++k) \
        acc[ai][bj][m][n] = __builtin_amdgcn_mfma_f32_16x16x32_bf16(Bt[n][k], At[m][k], acc[ai][bj][m][n], 0, 0, 0); __builtin_amdgcn_s_setprio(0); } while (0)
#define PG8_WAIT_V(n) asm volatile("s_waitcnt vmcnt(" #n ")" ::: "memory")
#define PG8_WAIT_L(n) asm volatile("s_waitcnt lgkmcnt(" #n ")" ::: "memory")
#define PG8_BAR __builtin_amdgcn_s_barrier()
#define PG8_SCHED __builtin_amdgcn_sched_barrier(0)
    Unit cur, nxt; int ui = 0;
    if (!S.next(0, cur)) return;
    f32x4 acc[2][2][4][2];
#pragma unroll
    for (int a = 0; a < 2; ++a)
#pragma unroll
        for (int b = 0; b < 2; ++b)
#pragma unroll
            for (int m = 0; m < 4; ++m)
#pragma unroll
                for (int n = 0; n < 2; ++n) acc[a][b][m][n] = (f32x4){0.f, 0.f, 0.f, 0.f};
    bf16x8 At[4][2], B0[2][2], B1[2][2];
    const char* cA = (const char*)g.A + (size_t)cur.pm * tstepA; const char* cB = (const char*)g.Bt + (size_t)cur.pn * tstepB;
    PG8_STAGE(PG8_SB(0, 0), cB, voffB); PG8_STAGE(PG8_SB(0, 1), cB + hstepB, voffB); PG8_STAGE(PG8_SA(0, 0), cA, voffA); PG8_STAGE(PG8_SA(0, 1), cA + hstepA, voffA);
    if (wr == 1) PG8_BAR;
    PG8_WAIT_V(2); PG8_BAR;
    PG8_STAGE(PG8_SB(1, 0), cB + kstep, voffB); PG8_STAGE(PG8_SA(1, 0), cA + kstep, voffA); PG8_STAGE(PG8_SB(1, 1), cB + hstepB + kstep, voffB);
    PG8_WAIT_V(6); PG8_BAR;
    for (;;) {
        const bool has_next = S.next(ui + 1, nxt);
        const char* nA = has_next ? (const char*)g.A + (size_t)nxt.pm * tstepA : cA; const char* nB = has_next ? (const char*)g.Bt + (size_t)nxt.pn * tstepB : cB;
#pragma unroll 1
        for (int t = 0; t < nt; t += 2) {
            const bool last = (t == nt - 2);
            const char* a1 = cA + (size_t)(t + 1) * kstep;
            const char* a2 = last ? nA : cA + (size_t)(t + 2) * kstep; const char* b2 = last ? nB : cB + (size_t)(t + 2) * kstep;
            const char* a3 = a2 + kstep; const char* b3 = b2 + kstep;
            PG8_LDB(B0, 0, 0); PG8_LDB(B1, 0, 1); PG8_SCHED; PG8_LDA(At, 0, 0); PG8_STAGE(PG8_SA(1, 1), a1 + hstepA, voffA);
            PG8_WAIT_V(8); PG8_WAIT_L(0); PG8_BAR; PG8_MMA(0, 0, At, B0); PG8_MMA(0, 1, At, B1); PG8_BAR; PG8_SCHED;
            PG8_LDA(At, 0, 1); PG8_STAGE(PG8_SB(0, 0), b2, voffB); PG8_STAGE(PG8_SB(0, 1), b2 + hstepB, voffB); PG8_STAGE(PG8_SA(0, 0), a2, voffA);
            PG8_WAIT_V(8); PG8_WAIT_L(0); PG8_BAR; PG8_MMA(1, 0, At, B0); PG8_MMA(1, 1, At, B1); PG8_BAR; PG8_SCHED;
            PG8_LDB(B0, 1, 0); PG8_LDB(B1, 1, 1); PG8_SCHED; PG8_LDA(At, 1, 0); PG8_STAGE(PG8_SA(0, 1), a2 + hstepA, voffA);
            PG8_WAIT_V(8); PG8_WAIT_L(0); PG8_BAR; PG8_MMA(0, 0, At, B0); PG8_MMA(0, 1, At, B1); PG8_BAR; PG8_SCHED;
            PG8_LDA(At, 1, 1); PG8_STAGE(PG8_SB(1, 0), b3, voffB); PG8_STAGE(PG8_SB(1, 1), b3 + hstepB, voffB); PG8_STAGE(PG8_SA(1, 0), a3, voffA);
            PG8_WAIT_V(8); PG8_WAIT_L(0); PG8_BAR; PG8_MMA(1, 0, At, B0); PG8_MMA(1, 1, At, B1); PG8_BAR; PG8_SCHED;
        }
        if (wr == 0) PG8_BAR;
        E(acc, cur, wr, wc, fr, fq);
        if (!has_next) break;
#pragma unroll
        for (int a = 0; a < 2; ++a)
#pragma unroll
            for (int b = 0; b < 2; ++b)
#pragma unroll
                for (int m = 0; m < 4; ++m)
#pragma unroll
                    for (int n = 0; n < 2; ++n) acc[a][b][m][n] = (f32x4){0.f, 0.f, 0.f, 0.f};
        cur = nxt; cA = nA; cB = nB; ++ui;
        if (wr == 1) PG8_BAR;
    }
    PG8_WAIT_V(0);
    PG8_BAR;
#undef PG8_SA
#undef PG8_SB
#undef PG8_STAGE
#undef PG8_LDA
#undef PG8_LDB
#undef PG8_MMA
#undef PG8_WAIT_V
#undef PG8_WAIT_L
#undef PG8_BAR
#undef PG8_SCHED
}
}
template <class EP> __device__ __forceinline__ void fast_gemm(const Frame& F, const bf16* A, int lda, const bf16* Bt, int K, int N, const EP& E) {
    pg8::Gemm g{A, lda, Bt, T, N, K}; pg8::StaticOrder S; S.init(T, N, F.G, (int)blockIdx.x);
    pg8::FastEpi<EP> FE{E};
    pg8::gemm_phase<pg8::FastEpi<EP>>(F.lds, F.tid, g, S, FE);
}
__device__ __forceinline__ void fast_attn_a(const Frame& F, int L) { naive_attn_a(F, L); }
__device__ __forceinline__ void fast_attn_b(const Frame& F, int L) { naive_attn_b(F, L); }

__device__ __forceinline__ void final_norm(const Frame& F) {
    const float* ssq = (const float*)(F.ws + WS_SSQ2); const float* nf = inp<15>(F);
    const int gw = F.vcu * NWAVES + F.wave, NGW = F.G * NWAVES;
    for (int m = gw; m < T; m += NGW) {
        float s = (F.lane < 32) ? ssq[(size_t)m * 32 + F.lane] : 0.f; s = wave_sum(s);
        const float r = rsqrtf(s * (1.0f / DM) + EPS);
        f32x4* o = (f32x4*)(F.out + (size_t)m * DM) + F.lane; const f32x4* g = (const f32x4*)nf + F.lane;
#pragma unroll
        for (int j = 0; j < 4; ++j) { f32x4 v = o[64 * j]; const f32x4 gg = g[64 * j]; v.x *= r * gg.x; v.y *= r * gg.y; v.z *= r * gg.z; v.w *= r * gg.w; o[64 * j] = v; }
    }
}

constexpr int N_PHASES = 12;
__global__ void __launch_bounds__(NTHREADS, 2) trunk_fwd(Args args) {
    extern __shared__ __attribute__((aligned(16))) unsigned char lds[];
    const int G = gridDim.x; int vcu; { const int bx = blockIdx.x; vcu = (G % 8 == 0) ? (bx % 8) * (G / 8) + bx / 8 : bx; }
    volatile LAS unsigned* MISC = (volatile LAS unsigned*)((LAS unsigned char*)lds + MISC_OFF);
    for (int u = threadIdx.x; u < (LDS_BYTES - LDSCTL_OFF) / 4; u += NTHREADS) ((LAS unsigned*)((LAS unsigned char*)lds + LDSCTL_OFF))[u] = 0u;
    __syncthreads();
    XcdBarrier bar; bar.bar = (unsigned*)(args.ws + WS_CTL) + CW_BAR; bar.x = 0; bar.st = nullptr;
    if (MK_N_LAUNCHES == 1) bar = xcd_barrier_post((unsigned*)(args.ws + WS_CTL) + CW_BAR, MISC + 8);

    for (int ph = args.ph_lo; ph < args.ph_hi; ++ph) {
        Frame F; F.a = &args; F.G = G; F.vcu = vcu;
        { int tid = threadIdx.x; asm volatile("" : "+v"(tid)); F.tid = tid; F.lane = tid & 63; F.wave = __builtin_amdgcn_readfirstlane(tid >> 6); }
        { unsigned char* w = args.ws; asm volatile("" : "+s"(w)); F.ws = w; }
        { float* o = args.out; asm volatile("" : "+s"(o)); F.out = o; }
        { unsigned lb = 0; asm volatile("" : "+s"(lb)); F.lds = (LAS unsigned char*)lds + lb; }
        bf16* Z = (bf16*)(F.ws + WS_Z); bf16* U = (bf16*)(F.ws + WS_U); bf16* PE = (bf16*)(F.ws + WS_Z);
        float* SSQ1 = (float*)(F.ws + WS_SSQ1); float* SSQ2 = (float*)(F.ws + WS_SSQ2); float* SSQQ = (float*)(F.ws + WS_SSQQ); float* SSQKV = (float*)(F.ws + WS_SSQKV);
        const f32x2* CS = (const f32x2*)(F.ws + WS_CS);
        if (ph == 0) p0_prologue(F);
        else if (ph == N_PHASES - 1) final_norm(F);
        else {
            const int L = (ph - 1) / 5; int kind = (ph - 1) % 5;
#ifdef MK_ONLY
            if (kind != MK_ONLY) kind = 99;
#endif
            bf16* HIN = (bf16*)(F.ws + ((L & 1) ? WS_BUFB : WS_BUFA));
            bf16* MIX = (bf16*)(F.ws + ((L & 1) ? WS_BUFA : WS_BUFB));
            if (kind == 0) {
                EpiP1 E{Z, SSQ2, SSQQ, SSQKV, CS};
                const bf16* Bt = (const bf16*)(F.ws + WS_WIN) + (size_t)L * DINP * DM;
                if (MK_NAIVE & 1) naive_gemm(F, HIN, DM, Bt, DM, DINP, E);
                else fast_gemm(F, HIN, DM, Bt, DM, DINP, E);
            } else if (kind == 1) {
                EpiUp E{U, SSQQ, SSQKV, CS};
                const bf16* Bt = (const bf16*)(F.ws + WS_WUP) + (size_t)L * DUP * KUP;
#if !defined(MK_SUB) || MK_SUB == 0
                if (MK_NAIVE & 1) naive_gemm(F, Z + ZC_CQ, DINP, Bt, KUP, DUP, E);
                else fast_gemm(F, Z + ZC_CQ, DINP, Bt, KUP, DUP, E);
#endif
                __syncthreads();
                relaunder(F);
#if !defined(MK_SUB) || MK_SUB == 1
                if (MK_NAIVE & 2) naive_attn_a(F, L); else fast_attn_a(F, L);
#endif
            } else if (kind == 2) {
                if (MK_NAIVE & 4) naive_attn_b(F, L); else fast_attn_b(F, L);
            } else if (kind == 3) {
                EpiPe E0{PE};
                const bf16* Bpe = (const bf16*)(F.ws + WS_WPE) + (size_t)L * DM * DPLE;
                const bf16* PBl = (const bf16*)(F.ws + WS_PB) + (size_t)L * T * DPLE;
#if !defined(MK_SUB) || MK_SUB == 0
                if (MK_NAIVE & 1) naive_gemm(F, PBl, DPLE, Bpe, DPLE, DM, E0);
                else fast_gemm(F, PBl, DPLE, Bpe, DPLE, DM, E0);
#endif
                __syncthreads();
                relaunder(F);
                bf16* HIN2 = (bf16*)(F.ws + ((L & 1) ? WS_BUFB : WS_BUFA)); bf16* MIX2 = (bf16*)(F.ws + ((L & 1) ? WS_BUFA : WS_BUFB));
                EpiOut E1{L == 0 ? inp<0>(F) : (const float*)F.out, F.out, HIN2, (float*)(F.ws + WS_SSQ1)};
                const bf16* Bo = (const bf16*)(F.ws + WS_WOUT) + (size_t)L * DM * DM;
#if !defined(MK_SUB) || MK_SUB == 1
                if (MK_NAIVE & 1) naive_gemm(F, MIX2, DM, Bo, DM, DM, E1);
                else fast_gemm(F, MIX2, DM, Bo, DM, DM, E1);
#endif
            } else if (kind == 4) {
                EpiGate E{F.out, MIX, PE, inp<14>(F) + (size_t)L * DM, SSQ1, SSQ2};
                const bf16* Bg = (const bf16*)(F.ws + WS_WPG) + (size_t)L * DM * DM;
                if (MK_NAIVE & 1) naive_gemm(F, HIN, DM, Bg, DM, DM, E);
                else fast_gemm(F, HIN, DM, Bg, DM, DM, E);
            }
        }
        if (ph + 1 < args.ph_hi) xcd_barrier(bar);
    }
}

extern "C" void kernel_launch(void* const* d_in, const int* in_sizes, int n_in, void* d_out, int out_size, void* d_ws, size_t ws_size, hipStream_t stream) {
    static int grid = 0;
    if (grid == 0) {
        if (n_in != 16 || in_sizes[0] != T * DM || out_size != T * DM || ws_size < WS_END) {
            fprintf(stderr, "kernel_launch: unexpected shapes (n_in %d, in0 %d, out %d, ws %zu); nothing launched\n", n_in, n_in > 0 ? in_sizes[0] : -1, out_size, ws_size); grid = -1; return; }
        int dev = 0, cus = 0, per_cu = 0;
        if (hipGetDevice(&dev) != hipSuccess || hipDeviceGetAttribute(&cus, hipDeviceAttributeMultiprocessorCount, dev) != hipSuccess) { grid = -1; return; }
        if (hipFuncSetAttribute((const void*)trunk_fwd, hipFuncAttributeMaxDynamicSharedMemorySize, LDS_BYTES) != hipSuccess) { fprintf(stderr, "kernel_launch: hipFuncSetAttribute failed\n"); grid = -1; return; }
        if (hipOccupancyMaxActiveBlocksPerMultiprocessor(&per_cu, (const void*)trunk_fwd, NTHREADS, LDS_BYTES) != hipSuccess || per_cu < 1)
            fprintf(stderr, "kernel_launch: note: occupancy query reports %d workgroups per CU\n", per_cu);
        (void)hipGetLastError();
        grid = cus;
    }
    if (grid < 0) return;
    if (hipMemsetAsync((char*)d_ws + WS_CTL, 0, CTL_ZERO_BYTES, stream) != hipSuccess) { fprintf(stderr, "kernel_launch: hipMemsetAsync failed\n"); return; }
    Args a{};
    for (int i = 0; i < 16; ++i) a.in[i] = d_in[i];
    a.out = (float*)d_out; a.ws = (unsigned char*)d_ws;
    for (int li = 0; li < MK_N_LAUNCHES; ++li) {
        a.ph_lo = (MK_N_LAUNCHES == 1) ? 0 : li; a.ph_hi = (MK_N_LAUNCHES == 1) ? N_PHASES : li + 1; a.li = li;
        hipLaunchKernelGGL(trunk_fwd, dim3(grid), dim3(NTHREADS), LDS_BYTES, stream, a);
        const hipError_t le = hipPeekAtLastError();
        if (le != hipSuccess) { fprintf(stderr, "kernel_launch: launch %d failed: %s\n", li, hipGetErrorName(le)); break; }
    }
}
```

```cpp
#include <hip/hip_runtime.h>
#include <cstdio>
#include <cstdint>

#ifndef MK_N_LAUNCHES
#define MK_N_LAUNCHES 1
#endif
#ifndef MK_NAIVE
#define MK_NAIVE 0x0
#endif

constexpr int NB = 16, SEQ = 2048, T = NB * SEQ, DM = 1024, DIN = 3008, DINP = 3072, DPLE = 256, DEPTH = 2;
constexpr int DUP = 1792, KUP = 384;
constexpr float EPS = 1e-6f;
constexpr float LOG2E = 1.4426950408889634f;
constexpr float QA_SCALE = 0.125f * LOG2E;
constexpr float QB_SCALE = 0.07216878364870322f * LOG2E;
constexpr int ZC_QA = 0, ZC_KA = 512, ZC_VA = 1024, ZC_GA = 1536, ZC_GB = 2048, ZC_CQ = 2560, ZC_CKV = 2816, ZC_KR = 2944, ZC_PAD = 3008;
constexpr int UC_QN = 0, UC_QR = 512, UC_KN = 768, UC_V = 1280;

constexpr size_t MiB = 1u << 20;
constexpr size_t WS_CTL = 0, CTL_ZERO_BYTES = 1 * MiB;
constexpr size_t WS_WIN = 1 * MiB;
constexpr size_t WS_WUP = 13 * MiB;
constexpr size_t WS_WOUT = 16 * MiB;
constexpr size_t WS_WPG = 20 * MiB;
constexpr size_t WS_WPE = 24 * MiB;
constexpr size_t WS_CS = 25 * MiB;
constexpr size_t WS_SSQ1 = 33 * MiB;
constexpr size_t WS_SSQ2 = 37 * MiB;
constexpr size_t WS_SSQQ = 41 * MiB;
constexpr size_t WS_SSQKV = 42 * MiB;
constexpr size_t WS_PB = 43 * MiB;
constexpr size_t WS_BUFA = 75 * MiB;
constexpr size_t WS_BUFB = 139 * MiB;
constexpr size_t WS_Z = 203 * MiB;
constexpr size_t WS_U = 395 * MiB;
constexpr size_t WS_END = 507 * MiB;

constexpr int NWAVES = 8, NTHREADS = 512;
constexpr int RING_BYTES = 131072, LDSCTL_OFF = RING_BYTES, MISC_OFF = LDSCTL_OFF + 320, LDS_BYTES = 147456;

#define GAS __attribute__((address_space(1)))
#define LAS __attribute__((address_space(3)))
typedef unsigned short bf16;
typedef unsigned v4u __attribute__((ext_vector_type(4)));
typedef unsigned v2u __attribute__((ext_vector_type(2)));
typedef float f32x4 __attribute__((ext_vector_type(4)));
typedef float f32x2 __attribute__((ext_vector_type(2)));
typedef float f32x16 __attribute__((ext_vector_type(16)));
typedef short bf16x8 __attribute__((ext_vector_type(8)));
typedef short s16x4 __attribute__((ext_vector_type(4)));
typedef __bf16 bf16x2_t __attribute__((ext_vector_type(2)));
typedef GAS unsigned gu32;
#define RLX_AGENT __ATOMIC_RELAXED, __HIP_MEMORY_SCOPE_AGENT

__device__ __forceinline__ float bf2f(unsigned b) { return __uint_as_float(b << 16); }
__device__ __forceinline__ unsigned f2bf(float f) { unsigned u = __float_as_uint(f); return (u + 0x7fffu + ((u >> 16) & 1u)) >> 16; }
__device__ __forceinline__ unsigned pk2(float lo, float hi) { f32x2 v = {lo, hi}; bf16x2_t b = __builtin_convertvector(v, bf16x2_t); return __builtin_bit_cast(unsigned, b); }
__device__ __forceinline__ float silu_f(float v) { return v / (1.0f + __expf(-v)); }
__device__ __forceinline__ float sigmoid_f(float v) { return 1.0f / (1.0f + __expf(-v)); }
__device__ __forceinline__ void unpack8(v4u w, float (&f)[8]) {
    f[0] = bf2f(w.x & 0xffffu); f[1] = bf2f(w.x >> 16); f[2] = bf2f(w.y & 0xffffu); f[3] = bf2f(w.y >> 16);
    f[4] = bf2f(w.z & 0xffffu); f[5] = bf2f(w.z >> 16); f[6] = bf2f(w.w & 0xffffu); f[7] = bf2f(w.w >> 16);
}
__device__ __forceinline__ v4u pack8(const float (&f)[8]) { v4u w; w.x = pk2(f[0], f[1]); w.y = pk2(f[2], f[3]); w.z = pk2(f[4], f[5]); w.w = pk2(f[6], f[7]); return w; }

__device__ const float INV_FREQ[32] = {
    1.000000000e+00f, 7.498942614e-01f, 5.623413324e-01f, 4.216965139e-01f, 3.162277639e-01f, 2.371373773e-01f, 1.778279394e-01f, 1.333521307e-01f,
    1.000000015e-01f, 7.498941571e-02f, 5.623413250e-02f, 4.216965288e-02f, 3.162277490e-02f, 2.371373773e-02f, 1.778279431e-02f, 1.333521493e-02f,
    9.999999776e-03f, 7.498941850e-03f, 5.623413250e-03f, 4.216964822e-03f, 3.162277630e-03f, 2.371373586e-03f, 1.778279431e-03f, 1.333521446e-03f,
    1.000000047e-03f, 7.498942432e-04f, 5.623413017e-04f, 4.216965172e-04f, 3.162277571e-04f, 2.371373703e-04f, 1.778279402e-04f, 1.333521504e-04f};

#define XB_TMO      128
#define XB_XCNT(j)  (256  + 64 * (j))
#define XB_XSUB(j)  (1280 + 64 * (j))
#define XB_XGEN(j)  (2304 + 64 * (j))
#define XB_TOP      3328
#define XB_TOPGEN   3392
#define XCD_BAR_WORDS 3456
#define XB_SPIN_CAP (1u << 22)
constexpr int CW_BAR = 4096;

__device__ __forceinline__ unsigned xb_ld(unsigned* p)              { return __hip_atomic_load(p, __ATOMIC_RELAXED, __HIP_MEMORY_SCOPE_AGENT); }
__device__ __forceinline__ unsigned xb_add(unsigned* p, unsigned v) { return __hip_atomic_fetch_add(p, v, __ATOMIC_RELAXED, __HIP_MEMORY_SCOPE_AGENT); }
__device__ __forceinline__ unsigned xb_xcc_id() { return (unsigned)__builtin_amdgcn_s_getreg((3 << 11) | 20) & 0xFu; }
#define XB_SPIN(cond, bar) do { unsigned _sp = 0; while (cond) { __builtin_amdgcn_s_sleep(1); \
    if ((++_sp & 255u) == 0u) { if (xb_ld(&(bar)[XB_TMO])) break; if (_sp > XB_SPIN_CAP) { atomicAdd(&(bar)[XB_TMO], 1u); break; } } } } while (0)
struct XcdBarrier { unsigned* bar; unsigned x; volatile LAS unsigned* st; };
__device__ __forceinline__ XcdBarrier xcd_barrier_post(unsigned* bar, volatile LAS unsigned* st) {
    XcdBarrier b; b.bar = bar; b.x = xb_xcc_id(); b.st = st;
    if (threadIdx.x == 0) (void)xb_add(&bar[XB_XCNT(b.x)], 1u);
    return b;
}
__device__ __forceinline__ void xcd_barrier_complete(unsigned* bar, unsigned x, unsigned& nloc, unsigned& nx) {
    const unsigned G = gridDim.x * gridDim.y * gridDim.z;
    unsigned sum, cnt, mine, sp = 0u;
    for (;;) {
        sum = 0u; cnt = 0u; mine = 0u;
#pragma unroll
        for (unsigned j = 0; j < 16; ++j) { const unsigned c = xb_ld(&bar[XB_XCNT(j)]); sum += c; cnt += (c > 0u) ? 1u : 0u; mine = (j == x) ? c : mine; }
        if (sum == G) break;
        __builtin_amdgcn_s_sleep(1);
        if ((++sp & 255u) == 0u) { if (xb_ld(&bar[XB_TMO])) break; if (sp > XB_SPIN_CAP) { atomicAdd(&bar[XB_TMO], 1u); break; } }
    }
    nloc = mine > 0u ? mine : 1u; nx = cnt > 0u ? cnt : 1u;
}
__device__ __forceinline__ void xcd_barrier(const XcdBarrier& b) {
    asm volatile("s_waitcnt vmcnt(0)" ::: "memory");
    __syncthreads();
    if (threadIdx.x == 0) {
        unsigned* bar = b.bar;
        __builtin_amdgcn_s_waitcnt(0);
        unsigned nloc = b.st[0], nx = b.st[1];
        if (nloc == 0u) { xcd_barrier_complete(bar, b.x, nloc, nx); b.st[0] = nloc; b.st[1] = nx; }
        const unsigned old = xb_add(&bar[XB_XSUB(b.x)], 1u);
        const unsigned gen = old / nloc;
        if (old + 1u == (gen + 1u) * nloc) {
            __builtin_amdgcn_fence(__ATOMIC_RELEASE, "agent");
            asm volatile("s_waitcnt vmcnt(0)" ::: "memory");
            const unsigned og = xb_add(&bar[XB_TOP], 1u);
            const unsigned tg = og / nx;
            if (og + 1u == (tg + 1u) * nx) xb_add(&bar[XB_TOPGEN], 1u);
            else XB_SPIN(xb_ld(&bar[XB_TOPGEN]) == tg, bar);
            __builtin_amdgcn_fence(__ATOMIC_ACQUIRE, "agent");
            xb_add(&bar[XB_XGEN(b.x)], 1u);
            asm volatile("s_waitcnt vmcnt(0)" ::: "memory");
        } else {
            XB_SPIN(xb_ld(&bar[XB_XGEN(b.x)]) == gen, bar);
            __builtin_amdgcn_fence(__ATOMIC_ACQUIRE, "agent");
            asm volatile("s_waitcnt vmcnt(0)" ::: "memory");
        }
    }
    __syncthreads();
}

struct Args { const void* in[16]; float* out; unsigned char* ws; int ph_lo, ph_hi, li, pad; };
struct Frame {
    LAS unsigned char* lds;
    unsigned char* ws;
    const Args* a;
    int tid, lane, wave, vcu, G;
    float* out;
};
__device__ __forceinline__ void relaunder(Frame& F) {
    int tid = F.tid; asm volatile("" : "+v"(tid)); F.tid = tid; F.lane = tid & 63; F.wave = __builtin_amdgcn_readfirstlane(tid >> 6);
    unsigned char* w = F.ws; asm volatile("" : "+s"(w)); F.ws = w;
    float* o = F.out; asm volatile("" : "+s"(o)); F.out = o;
    unsigned lb = 0; asm volatile("" : "+s"(lb)); F.lds = F.lds + lb;
}
template <int I> __device__ __forceinline__ const float* inp(const Frame& F) { const void* p = F.a->in[I]; asm volatile("" : "+s"(p)); return (const float*)p; }
__device__ __forceinline__ float wave_sum(float v) {
#pragma unroll
    for (int o = 1; o < 64; o <<= 1) v += __shfl_xor(v, o);
    return v;
}
__device__ __forceinline__ float wave_max(float v) {
#pragma unroll
    for (int o = 1; o < 64; o <<= 1) v = fmaxf(v, __shfl_xor(v, o));
    return v;
}

struct WPtrs { const float *norm_mix, *w_in, *g_q, *w_uq, *g_kv, *w_ukv, *w_out, *norm_ple, *w_pe, *w_pg; };
__device__ __forceinline__ float wsrc(const WPtrs& F, int mat, int L, int n, int k) {
    if (mat == 0) {
        int sc;
        if (n < 2048) sc = n;
        else if (n < ZC_CQ) sc = 2496 + (n - ZC_GB);
        else if (n < ZC_CKV) sc = 2048 + (n - ZC_CQ);
        else if (n < ZC_KR) sc = 2304 + (n - ZC_CKV);
        else if (n < ZC_PAD) { const int j = n - ZC_KR; sc = 2432 + (j >> 1) + 32 * (j & 1); }
        else return 0.f;
        return F.w_in[((size_t)L * DM + k) * DIN + sc] * F.norm_mix[L * DM + k];
    } else if (mat == 1) {
        if (n < UC_KN) {
            if (k >= 256) return 0.f;
            int sc;
            if (n < UC_QR) sc = (n >> 7) * 192 + (n & 127);
            else { const int j = (n - UC_QR) & 63, hh = (n - UC_QR) >> 6; sc = hh * 192 + 128 + (j >> 1) + 32 * (j & 1); }
            return F.w_uq[((size_t)L * 256 + k) * 768 + sc] * F.g_q[L * 256 + k];
        } else {
            if (k < 256) return 0.f;
            const int kk = k - 256; int sc;
            if (n < UC_V) { const int m = n - UC_KN; sc = (m >> 7) * 256 + (m & 127); }
            else { const int m = n - UC_V; sc = (m >> 7) * 256 + 128 + (m & 127); }
            return F.w_ukv[((size_t)L * 128 + kk) * 1024 + sc] * F.g_kv[L * 128 + kk];
        }
    } else if (mat == 2) return F.w_out[((size_t)L * DM + k) * DM + n];
    else if (mat == 3) return F.w_pg[((size_t)L * DM + k) * DM + n] * F.norm_ple[L * DM + k];
    else return F.w_pe[((size_t)L * DPLE + k) * DM + n];
}
__device__ __forceinline__ void p0_prologue(const Frame& F) {
    const WPtrs W{inp<3>(F), inp<4>(F), inp<6>(F), inp<7>(F), inp<8>(F), inp<9>(F), inp<10>(F), inp<11>(F), inp<12>(F), inp<13>(F)};
    const float* xin = inp<0>(F); const float* pin = inp<1>(F); const int* positions = (const int*)inp<2>(F);
    {
        LAS float* scr = (LAS float*)F.lds;
        constexpr int NT0 = (DINP / 64) * (DM / 64), NT1 = (DUP / 64) * (KUP / 64), NT2 = 16 * 16, NT3 = 16 * 16, NT4 = 16 * 4;
        constexpr int NTL = NT0 + NT1 + NT2 + NT3 + NT4;
        for (int it = F.vcu; it < 2 * NTL; it += F.G) {
            const int L = it / NTL; int r = it % NTL; int mat, K, tn, tk; size_t base;
            if (r < NT0) { mat = 0; K = DM; base = WS_WIN + (size_t)L * DINP * DM * 2; }
            else if ((r -= NT0) < NT1) { mat = 1; K = KUP; base = WS_WUP + (size_t)L * DUP * KUP * 2; }
            else if ((r -= NT1) < NT2) { mat = 2; K = DM; base = WS_WOUT + (size_t)L * DM * DM * 2; }
            else if ((r -= NT2) < NT3) { mat = 3; K = DM; base = WS_WPG + (size_t)L * DM * DM * 2; }
            else { r -= NT3; mat = 4; K = DPLE; base = WS_WPE + (size_t)L * DM * DPLE * 2; }
            const int nkt = K / 64; tn = r / nkt; tk = r % nkt;
            const int n0 = tn * 64, k0 = tk * 64;
#pragma unroll
            for (int e = 0; e < 8; ++e) { const int idx = F.tid + 512 * e, kk = idx >> 6, nn = idx & 63; scr[kk * 65 + nn] = wsrc(W, mat, L, n0 + nn, k0 + kk); }
            __syncthreads();
            unsigned* dst = (unsigned*)(F.ws + base);
#pragma unroll
            for (int e = 0; e < 4; ++e) { const int idx = F.tid + 512 * e, nn = idx >> 5, kp = idx & 31;
                dst[((size_t)(n0 + nn) * K + k0) / 2 + kp] = pk2(scr[(2 * kp) * 65 + nn], scr[(2 * kp + 1) * 65 + nn]); }
            __syncthreads();
        }
    }
    const int gw = F.vcu * NWAVES + F.wave, NGW = F.G * NWAVES;
    {
        bf16* hb = (bf16*)(F.ws + WS_BUFA); float* ssq = (float*)(F.ws + WS_SSQ2);
        for (int m = gw; m < T; m += NGW) {
            const f32x4* xr = (const f32x4*)(xin + (size_t)m * DM) + F.lane;
            f32x4 v[4]; float s = 0.f;
#pragma unroll
            for (int j = 0; j < 4; ++j) { v[j] = xr[64 * j]; s += (v[j].x * v[j].x + v[j].y * v[j].y) + (v[j].z * v[j].z + v[j].w * v[j].w); }
            s = wave_sum(s);
            v2u* o8 = (v2u*)(hb + (size_t)m * DM) + F.lane;
#pragma unroll
            for (int j = 0; j < 4; ++j) { v2u w; w.x = pk2(v[j].x, v[j].y); w.y = pk2(v[j].z, v[j].w); o8[64 * j] = w; }
            if (F.lane < 32) ssq[(size_t)m * 32 + F.lane] = (F.lane == 0) ? s : 0.f;
        }
    }
    const int gt = F.vcu * NTHREADS + F.tid, NGT = F.G * NTHREADS;
    {
        v4u* pb = (v4u*)(F.ws + WS_PB);
        for (int i = gt; i < 2 * T * DPLE / 8; i += NGT) {
            const f32x4 a = ((const f32x4*)pin)[2 * i], b = ((const f32x4*)pin)[2 * i + 1];
            v4u w; w.x = pk2(a.x, a.y); w.y = pk2(a.z, a.w); w.z = pk2(b.x, b.y); w.w = pk2(b.z, b.w); pb[i] = w;
        }
    }
    {
        f32x2* cs = (f32x2*)(F.ws + WS_CS);
        for (int i = gt; i < T * 32; i += NGT) {
            const int t = i >> 5, fi = i & 31;
            const float angf = (float)positions[t] * INV_FREQ[fi];
            const double a = (double)angf;
            const double kq = __builtin_rint(a * 0.63661977236758134308);
            const double r = (a - kq * 1.57079632679489655800) - kq * 6.12323399573676603587e-17;
            const double r2 = r * r;
            const double sn = r * (1.0 + r2 * (-1.0 / 6 + r2 * (1.0 / 120 + r2 * (-1.0 / 5040 + r2 * (1.0 / 362880 + r2 * (-1.0 / 39916800))))));
            const double cn = 1.0 + r2 * (-0.5 + r2 * (1.0 / 24 + r2 * (-1.0 / 720 + r2 * (1.0 / 40320 + r2 * (-1.0 / 3628800 + r2 * (1.0 / 479001600))))));
            const int q = (int)((long long)kq & 3);
            const double c = (q == 0) ? cn : (q == 1) ? -sn : (q == 2) ? -cn : sn;
            const double s = (q == 0) ? sn : (q == 1) ? cn : (q == 2) ? -sn : -cn;
            cs[i] = (f32x2){(float)c, (float)s};
        }
    }
}

struct EpiP1 {
    static constexpr bool HAS_SSQ = true;
    bf16* Z; const float* ssq_h; float* ssq_q; float* ssq_kv; const f32x2* cs;
    __device__ __forceinline__ float rowsum_part(int row, int part, int) const { const f32x4* s = (const f32x4*)(ssq_h + (size_t)row * 32 + part * 8); const f32x4 a = s[0], b = s[1]; return ((a.x + a.y) + (a.z + a.w)) + ((b.x + b.y) + (b.z + b.w)); }
    __device__ __forceinline__ float rowscale_from(float tot, int) const { return rsqrtf(tot * (1.0f / DM) + EPS); }
    __device__ __forceinline__ float run8(int row, int col0, float rs, float (&v)[8]) const {
        float ss = 0.f;
#pragma unroll
        for (int j = 0; j < 8; ++j) v[j] *= rs;
        if (col0 < ZC_KA) {
#pragma unroll
            for (int j = 0; j < 8; ++j) v[j] *= QA_SCALE;
        } else if (col0 >= ZC_GA && col0 < ZC_CQ) {
#pragma unroll
            for (int j = 0; j < 8; ++j) v[j] = silu_f(v[j]);
        } else if (col0 >= ZC_KR && col0 < ZC_PAD) {
            const f32x4* c4 = (const f32x4*)(cs + (size_t)row * 32 + ((col0 - ZC_KR) >> 1));
            const f32x4 c01 = c4[0], c23 = c4[1];
            const float cc[4] = {c01.x, c01.z, c23.x, c23.z}, sn[4] = {c01.y, c01.w, c23.y, c23.w};
#pragma unroll
            for (int i = 0; i < 4; ++i) { const float x1 = v[2 * i], x2 = v[2 * i + 1]; v[2 * i] = x1 * cc[i] - x2 * sn[i]; v[2 * i + 1] = x2 * cc[i] + x1 * sn[i]; }
        }
        const v4u w = pack8(v);
        *(v4u*)(Z + (size_t)row * DINP + col0) = w;
        if (col0 >= ZC_CQ && col0 < ZC_KR) { float f[8]; unpack8(w, f);
#pragma unroll
            for (int j = 0; j < 8; ++j) ss += f[j] * f[j]; }
        return ss;
    }
    __device__ __forceinline__ void ssq(int row, int grp, float s) const {
        if (grp >= ZC_CQ / 32 && grp < ZC_CKV / 32) ssq_q[(size_t)row * 8 + (grp - ZC_CQ / 32)] = s;
        else if (grp >= ZC_CKV / 32 && grp < ZC_KR / 32) ssq_kv[(size_t)row * 4 + (grp - ZC_CKV / 32)] = s;
    }
};
struct EpiUp {
    static constexpr bool HAS_SSQ = false;
    bf16* U; const float* ssq_q; const float* ssq_kv; const f32x2* cs;
    __device__ __forceinline__ float rowsum_part(int row, int part, int col0) const {
        if (col0 < UC_KN) { const f32x2 a = *(const f32x2*)(ssq_q + (size_t)row * 8 + part * 2); return a.x + a.y; }
        return ssq_kv[(size_t)row * 4 + part];
    }
    __device__ __forceinline__ float rowscale_from(float tot, int col0) const { return (col0 < UC_KN) ? rsqrtf(tot * (1.0f / 256) + EPS) * QB_SCALE : rsqrtf(tot * (1.0f / 128) + EPS); }
    __device__ __forceinline__ float run8(int row, int col0, float rs, float (&v)[8]) const {
#pragma unroll
        for (int j = 0; j < 8; ++j) v[j] *= rs;
        if (col0 >= UC_QR && col0 < UC_KN) {
            const f32x4* c4 = (const f32x4*)(cs + (size_t)row * 32 + (((col0 - UC_QR) & 63) >> 1));
            const f32x4 c01 = c4[0], c23 = c4[1];
            const float cc[4] = {c01.x, c01.z, c23.x, c23.z}, sn[4] = {c01.y, c01.w, c23.y, c23.w};
#pragma unroll
            for (int i = 0; i < 4; ++i) { const float x1 = v[2 * i], x2 = v[2 * i + 1]; v[2 * i] = x1 * cc[i] - x2 * sn[i]; v[2 * i + 1] = x2 * cc[i] + x1 * sn[i]; }
        }
        *(v4u*)(U + (size_t)row * DUP + col0) = pack8(v);
        return 0.f;
    }
    __device__ __forceinline__ void ssq(int, int, float) const {}
};
struct EpiPe {
    static constexpr bool HAS_SSQ = false;
    bf16* PE;
    __device__ __forceinline__ float rowsum_part(int, int, int) const { return 0.f; }
    __device__ __forceinline__ float rowscale_from(float, int) const { return 1.f; }
    __device__ __forceinline__ float run8(int row, int col0, float, float (&v)[8]) const { *(v4u*)(PE + (size_t)row * DM + col0) = pack8(v); return 0.f; }
    __device__ __forceinline__ void ssq(int, int, float) const {}
};
struct EpiOut {
    static constexpr bool HAS_SSQ = true;
    const float* res; float* out; bf16* hb; float* ssq_o;
    __device__ __forceinline__ float rowsum_part(int, int, int) const { return 0.f; }
    __device__ __forceinline__ float rowscale_from(float, int) const { return 1.f; }
    __device__ __forceinline__ float run8(int row, int col0, float, float (&v)[8]) const {
        const size_t off = (size_t)row * DM + col0;
        const f32x4 a = *(const f32x4*)(res + off), b = *(const f32x4*)(res + off + 4);
        v[0] += a.x; v[1] += a.y; v[2] += a.z; v[3] += a.w; v[4] += b.x; v[5] += b.y; v[6] += b.z; v[7] += b.w;
        *(f32x4*)(out + off) = (f32x4){v[0], v[1], v[2], v[3]}; *(f32x4*)(out + off + 4) = (f32x4){v[4], v[5], v[6], v[7]};
        *(v4u*)(hb + off) = pack8(v);
        float ss = 0.f;
#pragma unroll
        for (int j = 0; j < 8; ++j) ss += v[j] * v[j];
        return ss;
    }
    __device__ __forceinline__ void ssq(int row, int grp, float s) const { ssq_o[(size_t)row * 32 + grp] = s; }
};
struct EpiGate {
    static constexpr bool HAS_SSQ = true;
    float* out; bf16* hb; const bf16* PE; const float* bias; const float* ssq_i; float* ssq_o;
    __device__ __forceinline__ float rowsum_part(int row, int part, int) const { const f32x4* s = (const f32x4*)(ssq_i + (size_t)row * 32 + part * 8); const f32x4 a = s[0], b = s[1]; return ((a.x + a.y) + (a.z + a.w)) + ((b.x + b.y) + (b.z + b.w)); }
    __device__ __forceinline__ float rowscale_from(float tot, int) const { return rsqrtf(tot * (1.0f / DM) + EPS); }
    __device__ __forceinline__ float run8(int row, int col0, float rs, float (&v)[8]) const {
        const size_t off = (size_t)row * DM + col0;
        const f32x4 a = *(const f32x4*)(out + off), b = *(const f32x4*)(out + off + 4);
        const f32x4 ba = *(const f32x4*)(bias + col0), bb = *(const f32x4*)(bias + col0 + 4);
        float pe[8]; unpack8(*(const v4u*)(PE + off), pe);
        const float h[8] = {a.x, a.y, a.z, a.w, b.x, b.y, b.z, b.w}, bs[8] = {ba.x, ba.y, ba.z, ba.w, bb.x, bb.y, bb.z, bb.w};
        float ss = 0.f;
#pragma unroll
        for (int j = 0; j < 8; ++j) { v[j] = h[j] + pe[j] * sigmoid_f(v[j] * rs + bs[j]); ss += v[j] * v[j]; }
        *(f32x4*)(out + off) = (f32x4){v[0], v[1], v[2], v[3]}; *(f32x4*)(out + off + 4) = (f32x4){v[4], v[5], v[6], v[7]};
        *(v4u*)(hb + off) = pack8(v);
        return ss;
    }
    __device__ __forceinline__ void ssq(int row, int grp, float s) const { ssq_o[(size_t)row * 32 + grp] = s; }
};

template <class EP> __device__ __forceinline__ void naive_gemm(const Frame& F, const bf16* A, int lda, const bf16* Bt, int K, int N, const EP& E) {
    const int gt = F.vcu * NTHREADS + F.tid, NGT = F.G * NTHREADS;
    const int ng = N / 32;
    for (int it = gt; it < T * ng; it += NGT) {
        const int row = it % T, cg = it / T, col0 = cg * 32;
        float acc[32];
#pragma unroll
        for (int j = 0; j < 32; ++j) acc[j] = 0.f;
        const bf16* ap = A + (size_t)row * lda; const bf16* bp = Bt + (size_t)col0 * K;
        for (int k0 = 0; k0 < K; k0 += 8) {
            float a[8]; unpack8(*(const v4u*)(ap + k0), a);
#pragma unroll
            for (int j = 0; j < 32; ++j) { float b[8]; unpack8(*(const v4u*)(bp + (size_t)j * K + k0), b);
#pragma unroll
                for (int e = 0; e < 8; ++e) acc[j] += a[e] * b[e]; }
        }
        float tot = 0.f;
#pragma unroll
        for (int part = 0; part < 4; ++part) tot += E.rowsum_part(row, part, col0);
        const float rs = E.rowscale_from(tot, col0);
        float ss = 0.f;
#pragma unroll
        for (int g = 0; g < 4; ++g) { float v[8];
#pragma unroll
            for (int j = 0; j < 8; ++j) v[j] = acc[g * 8 + j];
            ss += E.run8(row, col0 + g * 8, rs, v); }
        if (EP::HAS_SSQ) E.ssq(row, cg, ss);
    }
}
__device__ __forceinline__ void naive_attn_a(const Frame& F, int L) {
    const bf16* Z = (const bf16*)(F.ws + WS_Z); bf16* MIX = (bf16*)(F.ws + ((L & 1) ? WS_BUFA : WS_BUFB));
    LAS float* sc = (LAS float*)F.lds + F.wave * 640;
    const float* rb = inp<5>(F) + (size_t)L * 8 * 257;
    const int gw = F.vcu * NWAVES + F.wave, NGW = F.G * NWAVES;
    for (int it = gw; it < T * 8; it += NGW) {
        const int row = it >> 3, h = it & 7, b = row >> 11, sq = row & 2047, cq = sq >> 6, ql = sq & 63;
        float q[64];
#pragma unroll
        for (int c = 0; c < 8; ++c) { float f[8]; unpack8(*(const v4u*)(Z + (size_t)row * DINP + ZC_QA + 64 * h + 8 * c), f);
#pragma unroll
            for (int e = 0; e < 8; ++e) q[8 * c + e] = f[e]; }
        float s[9]; float mx = -1e30f;
#pragma unroll
        for (int bi = 0; bi < 9; ++bi) {
            const int j = cq - 8 + bi; s[bi] = -1e30f;
            if (j >= 0) {
                const bf16* kp = Z + (size_t)(b * SEQ + 64 * j + F.lane) * DINP + ZC_KA + 64 * h; float d = 0.f;
#pragma unroll
                for (int c = 0; c < 8; ++c) { float f[8]; unpack8(*(const v4u*)(kp + 8 * c), f);
#pragma unroll
                    for (int e = 0; e < 8; ++e) d += q[8 * c + e] * f[e]; }
                int rel = (ql + 512) - (64 * bi + F.lane); rel = rel > 128 ? 128 : rel;
                s[bi] = d + rb[h * 257 + rel + 128] * LOG2E; mx = fmaxf(mx, s[bi]);
            }
        }
        mx = wave_max(mx); float l = 0.f;
#pragma unroll
        for (int bi = 0; bi < 9; ++bi) { const float pv = (cq - 8 + bi >= 0) ? exp2f(s[bi] - mx) : 0.f; l += pv; sc[64 * bi + F.lane] = pv; }
        l = wave_sum(l);
        asm volatile("s_waitcnt lgkmcnt(0)" ::: "memory");
        float o = 0.f;
        for (int bi = 0; bi < 9; ++bi) { const int j = cq - 8 + bi; if (j < 0) continue;
            const bf16* vp = Z + (size_t)(b * SEQ + 64 * j) * DINP + ZC_VA + 64 * h + F.lane;
            for (int kl = 0; kl < 64; ++kl) o += sc[64 * bi + kl] * bf2f(vp[(size_t)kl * DINP]); }
        const float g = bf2f(Z[(size_t)row * DINP + ZC_GA + 64 * h + F.lane]);
        MIX[(size_t)row * DM + 64 * h + F.lane] = (bf16)f2bf(o / l * g);
        asm volatile("s_waitcnt lgkmcnt(0)" ::: "memory");
    }
}
__device__ __forceinline__ void naive_attn_b(const Frame& F, int L) {
    const bf16* Z = (const bf16*)(F.ws + WS_Z); const bf16* U = (const bf16*)(F.ws + WS_U); bf16* MIX = (bf16*)(F.ws + ((L & 1) ? WS_BUFA : WS_BUFB));
    LAS float* sc = (LAS float*)F.lds + F.wave * 2048;
    const int gw = F.vcu * NWAVES + F.wave, NGW = F.G * NWAVES;
    for (int it = gw; it < T * 4; it += NGW) {
        const int row = it >> 2, h = it & 3, b = row >> 11, sq = row & 2047, cq = sq >> 6;
        const int nk = (cq + 1) * 64;
        const bf16* qn = U + (size_t)row * DUP + UC_QN + 128 * h; const bf16* qr = U + (size_t)row * DUP + UC_QR + 64 * h;
        float mx = -1e30f;
        for (int k0 = 0; k0 < nk; k0 += 64) {
            const int key = b * SEQ + k0 + F.lane;
            const bf16* kn = U + (size_t)key * DUP + UC_KN + 128 * h; const bf16* kr = Z + (size_t)key * DINP + ZC_KR;
            float d = 0.f;
            for (int c = 0; c < 16; ++c) { float a[8], f[8]; unpack8(*(const v4u*)(qn + 8 * c), a); unpack8(*(const v4u*)(kn + 8 * c), f);
#pragma unroll
                for (int e = 0; e < 8; ++e) d += a[e] * f[e]; }
            for (int c = 0; c < 8; ++c) { float a[8], f[8]; unpack8(*(const v4u*)(qr + 8 * c), a); unpack8(*(const v4u*)(kr + 8 * c), f);
#pragma unroll
                for (int e = 0; e < 8; ++e) d += a[e] * f[e]; }
            sc[k0 + F.lane] = d; mx = fmaxf(mx, d);
        }
        mx = wave_max(mx); float l = 0.f;
        for (int k0 = 0; k0 < nk; k0 += 64) { const float pv = exp2f(sc[k0 + F.lane] - mx); l += pv; sc[k0 + F.lane] = pv; }
        l = wave_sum(l);
        asm volatile("s_waitcnt lgkmcnt(0)" ::: "memory");
        float o0 = 0.f, o1 = 0.f;
        const bf16* vp = U + (size_t)(b * SEQ) * DUP + UC_V + 128 * h + F.lane;
        for (int k = 0; k < nk; ++k) { const float pv = sc[k]; o0 += pv * bf2f(vp[(size_t)k * DUP]); o1 += pv * bf2f(vp[(size_t)k * DUP + 64]); }
        const float g0 = bf2f(Z[(size_t)row * DINP + ZC_GB + 128 * h + F.lane]), g1 = bf2f(Z[(size_t)row * DINP + ZC_GB + 128 * h + 64 + F.lane]);
        MIX[(size_t)row * DM + 512 + 128 * h + F.lane] = (bf16)f2bf(o0 / l * g0);
        MIX[(size_t)row * DM + 512 + 128 * h + 64 + F.lane] = (bf16)f2bf(o1 / l * g1);
        asm volatile("s_waitcnt lgkmcnt(0)" ::: "memory");
    }
}

namespace pg8 {
#define PG8_LAS __attribute__((address_space(3)))
constexpr int BM = 256, BK = 64, HALF = 128, HTB = HALF * BK * 2, STAGE_BYTES = 8 * HTB, NXCD = 8, WGM = 8;
__host__ __device__ __forceinline__ int lds_byte(int r, int c) { const int st = (r >> 4) * 2 + (c >> 5), rr = r & 15, cc = c & 31, ob = rr * 64 + cc * 2; return st * 1024 + (ob ^ (((ob >> 9) & 1) << 5)); }
__host__ __device__ __forceinline__ void stage_rc(int b, int& R, int& C) { const int st = b / 1024, sb = b % 1024, swz = sb ^ (((sb >> 9) & 1) << 5); R = (st >> 1) * 16 + swz / 64; C = (st & 1) * 32 + (swz % 64) / 2; }
__host__ __device__ __forceinline__ int perm32(int rho) { const int n = rho >> 4, i = rho & 15; return 8 * (i >> 2) + 4 * n + (i & 3); }
struct Unit { int pm, pn; };
struct Gemm { const bf16* A; int lda; const bf16* Bt; int M, N, K; };
struct StaticOrder {
    int nM, nN, nwg, G, c;
    __device__ void init(int M, int N, int G_, int c_) { nM = M / BM; nN = N / BM; nwg = nM * nN; G = G_; c = c_; }
    __device__ bool next(int i, Unit& u) const {
        const long L = (long)i * G + c; if (L >= nwg) return false;
        int wgid = (int)L; { const int q = nwg / NXCD, r = nwg % NXCD, xcd = wgid % NXCD, off = wgid / NXCD; wgid = (xcd < r ? xcd * (q + 1) : r * (q + 1) + (xcd - r) * q) + off; }
        const int nig = WGM * nN, gid = wgid / nig, fm = gid * WGM, gsz = (nM - fm) < WGM ? (nM - fm) : WGM;
        u.pm = fm + ((wgid % nig) % gsz); u.pn = (wgid % nig) / gsz; return true;
    }
};
template <class EP> struct FastEpi {
    EP e;
    __device__ __forceinline__ void operator()(const f32x4 (&acc)[2][2][4][2], const Unit& u, int wr, int wc, int fr, int fq) const {
        const int colt = u.pn * BM + wc * 32 + 8 * fq;
#pragma unroll
        for (int ai = 0; ai < 2; ++ai)
#pragma unroll
            for (int m = 0; m < 4; ++m) {
                const int row = u.pm * BM + ai * HALF + wr * 64 + m * 16 + fr;
                float part = e.rowsum_part(row, fq, u.pn * BM); part += __shfl_xor(part, 16); part += __shfl_xor(part, 32);
                const float rs = e.rowscale_from(part, u.pn * BM);
#pragma unroll
                for (int bj = 0; bj < 2; ++bj) {
                    float v[8] = {acc[ai][bj][m][0][0], acc[ai][bj][m][0][1], acc[ai][bj][m][0][2], acc[ai][bj][m][0][3], acc[ai][bj][m][1][0], acc[ai][bj][m][1][1], acc[ai][bj][m][1][2], acc[ai][bj][m][1][3]};
                    float s = e.run8(row, colt + bj * HALF, rs, v);
                    if (EP::HAS_SSQ) { s += __shfl_xor(s, 16); s += __shfl_xor(s, 32); if (fq == 0) e.ssq(row, (u.pn * BM + bj * HALF + wc * 32) >> 5, s); }
                }
            }
    }
};

template <class Epi>
__device__ __forceinline__ void gemm_phase(PG8_LAS unsigned char* lds, const int tid, const Gemm g, const StaticOrder& S, const Epi& E) {
    const int wid = __builtin_amdgcn_readfirstlane(tid >> 6), lane = tid & 63, wr = wid >> 2, wc = wid & 3, fr = lane & 15, fq = lane >> 4;
    const int K = g.K, nt = K / BK, lda = g.lda;
    unsigned voffA[2], voffB[2];
#pragma unroll
    for (int i = 0; i < 2; ++i) { int R, C; stage_rc(tid * 16 + i * 8192, R, C); const int Rb = (R & ~31) + perm32(R & 31);
        voffA[i] = (unsigned)(R * lda + C) * 2u; voffB[i] = (unsigned)(Rb * K + C) * 2u; }
    const size_t kstep = (size_t)(BK * 2);
    const size_t hstepA = (size_t)HALF * lda * 2, hstepB = (size_t)HALF * K * 2;
    const size_t tstepA = 2 * hstepA, tstepB = 2 * hstepB;
    const unsigned ldsw = (unsigned)wid * 1024u;
    const int aoff = lds_byte(wr * 64 + fr, fq * 8), boff = lds_byte(wc * 32 + fr, fq * 8);
#define PG8_SA(b, h) (((b) * 2 + (h)) * HTB)
#define PG8_SB(b, h) ((4 + (b) * 2 + (h)) * HTB)
#define PG8_STAGE(bufoff, gbase, voff) do { _Pragma("unroll") for (int _i = 0; _i < 2; ++_i) \
        __builtin_amdgcn_global_load_lds((const unsigned*)((const char*)(gbase) + (voff)[_i]), (PG8_LAS unsigned*)(lds + (bufoff) + ldsw + _i * 8192), 16, 0, 0); } while (0)
#define PG8_LDA(dst, b, h) do { _Pragma("unroll") for (int m = 0; m < 4; ++m) _Pragma("unroll") for (int k = 0; k < 2; ++k) dst[m][k] = *(const PG8_LAS bf16x8*)(lds + PG8_SA(b, h) + aoff + m * 2048 + k * 1024); } while (0)
#define PG8_LDB(dst, b, h) do { _Pragma("unroll") for (int n = 0; n < 2; ++n) _Pragma("unroll") for (int k = 0; k < 2; ++k) dst[n][k] = *(const PG8_LAS bf16x8*)(lds + PG8_SB(b, h) + boff + n * 2048 + k * 1024); } while (0)
#define PG8_MMA(ai, bj, At, Bt) do { __builtin_amdgcn_s_setprio(1); _Pragma("unroll") for (int m = 0; m < 4; ++m) _Pragma("unroll") for (int n = 0; n < 2; ++n) _Pragma("unroll") for (int k = 0; k < 2; ++k) \
        acc[ai][bj][m][n] = __builtin_amdgcn_mfma_f32_16x16x32_bf16(Bt[n][k], At[m][k], acc[ai][bj][m][n], 0, 0, 0); __builtin_amdgcn_s_setprio(0); } while (0)
#define PG8_WAIT_V(n) asm volatile("s_waitcnt vmcnt(" #n ")" ::: "memory")
#define PG8_WAIT_L(n) asm volatile("s_waitcnt lgkmcnt(" #n ")" ::: "memory")
#define PG8_BAR __builtin_amdgcn_s_barrier()
#define PG8_SCHED __builtin_amdgcn_sched_barrier(0)
    Unit cur, nxt; int ui = 0;
    if (!S.next(0, cur)) return;
    f32x4 acc[2][2][4][2];
#pragma unroll
    for (int a = 0; a < 2; ++a)
#pragma unroll
        for (int b = 0; b < 2; ++b)
#pragma unroll
            for (int m = 0; m < 4; ++m)
#pragma unroll
                for (int n = 0; n < 2; ++n) acc[a][b][m][n] = (f32x4){0.f, 0.f, 0.f, 0.f};
    bf16x8 At[4][2], B0[2][2], B1[2][2];
    const char* cA = (const char*)g.A + (size_t)cur.pm * tstepA; const char* cB = (const char*)g.Bt + (size_t)cur.pn * tstepB;
    PG8_STAGE(PG8_SB(0, 0), cB, voffB); PG8_STAGE(PG8_SB(0, 1), cB + hstepB, voffB); PG8_STAGE(PG8_SA(0, 0), cA, voffA); PG8_STAGE(PG8_SA(0, 1), cA + hstepA, voffA);
    if (wr == 1) PG8_BAR;
    PG8_WAIT_V(2); PG8_BAR;
    PG8_STAGE(PG8_SB(1, 0), cB + kstep, voffB); PG8_STAGE(PG8_SA(1, 0), cA + kstep, voffA); PG8_STAGE(PG8_SB(1, 1), cB + hstepB + kstep, voffB);
    PG8_WAIT_V(6); PG8_BAR;
    for (;;) {
        const bool has_next = S.next(ui + 1, nxt);
        const char* nA = has_next ? (const char*)g.A + (size_t)nxt.pm * tstepA : cA; const char* nB = has_next ? (const char*)g.Bt + (size_t)nxt.pn * tstepB : cB;
#pragma unroll 1
        for (int t = 0; t < nt; t += 2) {
            const bool last = (t == nt - 2);
            const char* a1 = cA + (size_t)(t + 1) * kstep;
            const char* a2 = last ? nA : cA + (size_t)(t + 2) * kstep; const char* b2 = last ? nB : cB + (size_t)(t + 2) * kstep;
            const char* a3 = a2 + kstep; const char* b3 = b2 + kstep;
            PG8_LDB(B0, 0, 0); PG8_LDB(B1, 0, 1); PG8_SCHED; PG8_LDA(At, 0, 0); PG8_STAGE(PG8_SA(1, 1), a1 + hstepA, voffA);
            PG8_WAIT_V(8); PG8_WAIT_L(0); PG8_BAR; PG8_MMA(0, 0, At, B0); PG8_MMA(0, 1, At, B1); PG8_BAR; PG8_SCHED;
            PG8_LDA(At, 0, 1); PG8_STAGE(PG8_SB(0, 0), b2, voffB); PG8_STAGE(PG8_SB(0, 1), b2 + hstepB, voffB); PG8_STAGE(PG8_SA(0, 0), a2, voffA);
            PG8_WAIT_V(8); PG8_WAIT_L(0); PG8_BAR; PG8_MMA(1, 0, At, B0); PG8_MMA(1, 1, At, B1); PG8_BAR; PG8_SCHED;
            PG8_LDB(B0, 1, 0); PG8_LDB(B1, 1, 1); PG8_SCHED; PG8_LDA(At, 1, 0); PG8_STAGE(PG8_SA(0, 1), a2 + hstepA, voffA);
            PG8_WAIT_V(8); PG8_WAIT_L(0); PG8_BAR; PG8_MMA(0, 0, At, B0); PG8_MMA(0, 1, At, B1); PG8_BAR; PG8_SCHED;
            PG8_LDA(At, 1, 1); PG8_STAGE(PG8_SB(1, 0), b3, voffB); PG8_STAGE(PG8_SB(1, 1), b3 + hstepB, voffB); PG8_STAGE(PG8_SA(1, 0), a3, voffA);
            PG8_WAIT_V(8); PG8_WAIT_L(0); PG8_BAR; PG8_MMA(1, 0, At, B0); PG8_MMA(1, 1, At, B1); PG8_BAR; PG8_SCHED;
        }
        if (wr == 0) PG8_BAR;
        E(acc, cur, wr, wc, fr, fq);
        if (!has_next) break;
#pragma unroll
        for (int a = 0; a < 2; ++a)
#pragma unroll
            for (int b = 0; b < 2; ++b)
#pragma unroll
                for (int m = 0; m < 4; ++m)
#pragma unroll
                    for (int n = 0; n < 2; ++n) acc[a][b][m][n] = (f32x4){0.f, 0.f, 0.f, 0.f};
        cur = nxt; cA = nA; cB = nB; ++ui;
        if (wr == 1) PG8_BAR;
    }
    PG8_WAIT_V(0);
    PG8_BAR;
#undef PG8_SA
#undef PG8_SB
#undef PG8_STAGE
#undef PG8_LDA
#undef PG8_LDB
#undef PG8_MMA
#undef PG8_WAIT_V
#undef PG8_WAIT_L
#undef PG8_BAR
#undef PG8_SCHED
}
}
template <class EP> __device__ __forceinline__ void fast_gemm(const Frame& F, const bf16* A, int lda, const bf16* Bt, int K, int N, const EP& E) {
    pg8::Gemm g{A, lda, Bt, T, N, K}; pg8::StaticOrder S; S.init(T, N, F.G, (int)blockIdx.x);
    pg8::FastEpi<EP> FE{E};
    pg8::gemm_phase<pg8::FastEpi<EP>>(F.lds, F.tid, g, S, FE);
}
namespace fa {
typedef __attribute__((address_space(3))) const char* lds_cptr;
typedef short v4i16_t __attribute__((ext_vector_type(4)));
__device__ __forceinline__ s16x4 vtr(lds_cptr p) { return __builtin_bit_cast(s16x4, __builtin_amdgcn_ds_read_tr16_b64_v4i16((LAS v4i16_t*)p)); }
__device__ __forceinline__ float half_max(float v) { auto rr = __builtin_amdgcn_permlane32_swap(__float_as_uint(v), __float_as_uint(v), false, false); return fmaxf(__uint_as_float(rr[0]), __uint_as_float(rr[1])); }
__device__ __forceinline__ float half_sum(float v) { auto rr = __builtin_amdgcn_permlane32_swap(__float_as_uint(v), __float_as_uint(v), false, false); return __uint_as_float(rr[0]) + __uint_as_float(rr[1]); }
__device__ __forceinline__ bf16x8 packp(const f32x16& p, int b) { v4u w; w.x = pk2(p[b], p[b + 1]); w.y = pk2(p[b + 2], p[b + 3]); w.z = pk2(p[b + 4], p[b + 5]); w.w = pk2(p[b + 6], p[b + 7]); return __builtin_bit_cast(bf16x8, w); }

template <int NS, int ND, int KPITCH>
__device__ __forceinline__ void tile_compute(const bf16x8 (&qf)[NS], f32x16 (&o)[ND], float& m, float& l, lds_cptr Ks, lds_cptr Vs, f32x16 p0, f32x16 p1, int r32, int hi, int vlane) {
    lds_cptr kb = Ks + r32 * KPITCH + hi * 16;
#pragma unroll
    for (int s = 0; s < NS; ++s) {
        const bf16x8 k0 = *(const LAS bf16x8*)(kb + s * 32);
        const bf16x8 k1 = *(const LAS bf16x8*)(kb + 32 * KPITCH + s * 32);
        p0 = __builtin_amdgcn_mfma_f32_32x32x16_bf16(k0, qf[s], p0, 0, 0, 0);
        p1 = __builtin_amdgcn_mfma_f32_32x32x16_bf16(k1, qf[s], p1, 0, 0, 0);
    }
    float mx = fmaxf(p0[0], p1[0]);
#pragma unroll
    for (int r = 1; r < 16; ++r) mx = fmaxf(mx, fmaxf(p0[r], p1[r]));
    mx = half_max(mx);
    const float mn = fmaxf(m, mx);
    const float alpha = __builtin_amdgcn_exp2f(m - mn);
    m = mn;
    float rs = 0.f;
#pragma unroll
    for (int r = 0; r < 16; ++r) { p0[r] = __builtin_amdgcn_exp2f(p0[r] - mn); p1[r] = __builtin_amdgcn_exp2f(p1[r] - mn); rs += p0[r] + p1[r]; }
    l = l * alpha + rs;
#pragma unroll
    for (int d = 0; d < ND; ++d)
#pragma unroll
        for (int r = 0; r < 16; ++r) o[d][r] *= alpha;
    bf16x8 pf[4]; pf[0] = packp(p0, 0); pf[1] = packp(p0, 8); pf[2] = packp(p1, 0); pf[3] = packp(p1, 8);
    lds_cptr vb = Vs + vlane;
#pragma unroll
    for (int d = 0; d < ND; ++d)
#pragma unroll
        for (int s = 0; s < 4; ++s) {
            const s16x4 lo = vtr(vb + d * 4096 + s * 1024), hh = vtr(vb + d * 4096 + s * 1024 + 512);
            const bf16x8 vf = (bf16x8){lo[0], lo[1], lo[2], lo[3], hh[0], hh[1], hh[2], hh[3]};
            o[d] = __builtin_amdgcn_mfma_f32_32x32x16_bf16(vf, pf[s], o[d], 0, 0, 0);
        }
}
template <int ND>
__device__ __forceinline__ void store_o(const f32x16 (&o)[ND], float l, const bf16* gate_row, bf16* mix_row, int hi) {
    const float inv = 1.0f / half_sum(l);
#pragma unroll
    for (int d = 0; d < ND; ++d)
#pragma unroll
        for (int g4 = 0; g4 < 4; ++g4) {
            const int c = 32 * d + 8 * g4 + 4 * hi;
            const v2u gw = *(const v2u*)(gate_row + c);
            const float g0 = bf2f(gw.x & 0xffffu), g1 = bf2f(gw.x >> 16), g2 = bf2f(gw.y & 0xffffu), g3 = bf2f(gw.y >> 16);
            v2u w; w.x = pk2(o[d][4 * g4] * inv * g0, o[d][4 * g4 + 1] * inv * g1); w.y = pk2(o[d][4 * g4 + 2] * inv * g2, o[d][4 * g4 + 3] * inv * g3);
            *(v2u*)(mix_row + c) = w;
        }
}
}

__device__ __forceinline__ void fast_attn_a(const Frame& F, int L) {
    constexpr int KP = 144, KH = 64 * KP  , VH = 8192, STG = 2 * KH + 2 * VH  , TAB = 2 * STG;
    const bf16* Z = (const bf16*)(F.ws + WS_Z); bf16* MIX = (bf16*)(F.ws + ((L & 1) ? WS_BUFA : WS_BUFB));
    const float* rbias = inp<5>(F) + (size_t)L * 8 * 257;
    const int tid = F.tid, lane = F.lane, wave = F.wave, r32 = lane & 31, hi = lane >> 5;
    const int hsel = wave >> 2, rb = wave & 3;
    LAS float* tab = (LAS float*)(F.lds + TAB);
    const int vlane = (4 * hi + ((lane & 15) >> 2)) * 64 + ((lane >> 4) & 1) * 32 + (lane & 3) * 8;
    const int sc = tid & 15, sk = tid >> 4, shd = sc >> 3, scc = sc & 7;
    const int kdst0 = shd * KH + sk * KP + scc * 16, kdst1 = kdst0 + 32 * KP;
    const int vdst0 = 2 * KH + shd * VH + (scc >> 2) * 4096 + (sk >> 3) * 512 + (sk & 7) * 64 + (scc & 3) * 16, vdst1 = vdst0 + 4 * 512;
    const int nun = (F.G == 256) ? 4 : (1024 + F.G - 1 - F.vcu) / F.G;
    for (int ui = 0; ui < nun; ++ui) {
        int uid;
        if (F.G == 256) { const int s = F.vcu & 3; const int blk = (ui == 0) ? s : (ui == 1) ? 7 - s : (ui == 2) ? 8 + s : 15 - s; uid = (F.vcu >> 2) * 16 + blk; }
        else uid = F.vcu + ui * F.G;
        const int blk = uid & 15, hp = (uid >> 4) & 3, b = uid >> 6;
        const int R0 = b * SEQ + blk * 128, h = 2 * hp + hsel;
        const int qrow = R0 + 32 * rb + r32, cq = 2 * blk + (rb >> 1), ql = 32 * (rb & 1) + r32;
        const int jlo = (2 * blk - 8 > 0) ? 2 * blk - 8 : 0, jhi = 2 * blk + 1;
        for (int i = tid; i < 2 * 257; i += NTHREADS) { const int hh = i / 257, e = i - hh * 257; tab[hh * 260 + e] = rbias[(2 * hp + hh) * 257 + e] * LOG2E; }
        bf16x8 qf[4];
#pragma unroll
        for (int s = 0; s < 4; ++s) qf[s] = *(const bf16x8*)(Z + (size_t)qrow * DINP + ZC_QA + 64 * h + 16 * s + 8 * hi);
        const bf16* ksrc = Z + (size_t)(b * SEQ + sk) * DINP + ZC_KA + 128 * hp + 8 * sc;
        v4u st[4];
        { const bf16* p = ksrc + (size_t)(64 * jlo) * DINP; st[0] = *(const v4u*)p; st[1] = *(const v4u*)(p + (size_t)32 * DINP); st[2] = *(const v4u*)(p + 512); st[3] = *(const v4u*)(p + (size_t)32 * DINP + 512); }
        { LAS unsigned char* sb = F.lds; *(LAS v4u*)(sb + kdst0) = st[0]; *(LAS v4u*)(sb + kdst1) = st[1]; *(LAS v4u*)(sb + vdst0) = st[2]; *(LAS v4u*)(sb + vdst1) = st[3]; }
        __syncthreads();
        f32x16 o[2]; o[0] = (f32x16){}; o[1] = (f32x16){};
        float m = -1e30f, l = 0.f;
        const LAS float* tb = tab + hsel * 260;
        for (int j = jlo; j <= jhi; ++j) {
            const int cur = (j - jlo) & 1;
            if (j < jhi) { const bf16* p = ksrc + (size_t)(64 * (j + 1)) * DINP; st[0] = *(const v4u*)p; st[1] = *(const v4u*)(p + (size_t)32 * DINP); st[2] = *(const v4u*)(p + 512); st[3] = *(const v4u*)(p + (size_t)32 * DINP + 512); }
            const int dj = cq - j;
            if (dj >= 0 && dj <= 8) {
                f32x16 p0, p1;
                if (dj >= 3) { const float c = tb[256];
#pragma unroll
                    for (int r = 0; r < 16; ++r) { p0[r] = c; p1[r] = c; } }
                else {
#pragma unroll
                    for (int r = 0; r < 16; ++r) { const int kvl = (r & 3) + 8 * (r >> 2) + 4 * hi; int d0 = ql + 64 * dj - kvl, d1 = d0 - 32;
                        d0 = d0 > 128 ? 128 : d0; d1 = d1 > 128 ? 128 : d1; p0[r] = tb[d0 + 128]; p1[r] = tb[d1 + 128]; }
                }
                fa::lds_cptr sb = (fa::lds_cptr)(F.lds + cur * STG);
                fa::tile_compute<4, 2, KP>(qf, o, m, l, sb + hsel * KH, sb + 2 * KH + hsel * VH, p0, p1, r32, hi, vlane);
            }
            if (j < jhi) { LAS unsigned char* sb = F.lds + (cur ^ 1) * STG; *(LAS v4u*)(sb + kdst0) = st[0]; *(LAS v4u*)(sb + kdst1) = st[1]; *(LAS v4u*)(sb + vdst0) = st[2]; *(LAS v4u*)(sb + vdst1) = st[3]; }
            __syncthreads();
        }
        fa::store_o<2>(o, l, Z + (size_t)qrow * DINP + ZC_GA + 64 * h, MIX + (size_t)qrow * DM + 64 * h, hi);
    }
}

__device__ __forceinline__ void fast_attn_b(const Frame& F, int L) {
    constexpr int KP = 400, KB = 64 * KP  , STG = KB + 16384  ;
    const bf16* Z = (const bf16*)(F.ws + WS_Z); const bf16* U = (const bf16*)(F.ws + WS_U); bf16* MIX = (bf16*)(F.ws + ((L & 1) ? WS_BUFA : WS_BUFB));
    const int tid = F.tid, lane = F.lane, wave = F.wave, r32 = lane & 31, hi = lane >> 5;
    const int vlane = (4 * hi + ((lane & 15) >> 2)) * 64 + ((lane >> 4) & 1) * 32 + (lane & 3) * 8;
    const int skey = tid >> 3, c8 = tid & 7;
    const int kdst = skey * KP + c8 * 16;
    const int vdst = KB + (c8 >> 2) * 4096 + (skey >> 3) * 512 + (skey & 7) * 64 + (c8 & 3) * 16;
    const int nun = (F.G == 256) ? 2 : (512 + F.G - 1 - F.vcu) / F.G;
    for (int ui = 0; ui < nun; ++ui) {
        int uid;
        if (F.G == 256) { const int s = F.vcu & 3; uid = (F.vcu >> 2) * 8 + ((ui == 0) ? 7 - s : s); }
        else uid = F.vcu + ui * F.G;
        const int qb = uid & 7, h = (uid >> 3) & 3, b = uid >> 5;
        const int R0 = b * SEQ + qb * 256, qrow = R0 + 32 * wave + r32, cq = 4 * qb + (wave >> 1), jhi = 4 * qb + 3;
        bf16x8 qf[12];
#pragma unroll
        for (int s = 0; s < 8; ++s) qf[s] = *(const bf16x8*)(U + (size_t)qrow * DUP + UC_QN + 128 * h + 16 * s + 8 * hi);
#pragma unroll
        for (int s = 0; s < 4; ++s) qf[8 + s] = *(const bf16x8*)(U + (size_t)qrow * DUP + UC_QR + 64 * h + 16 * s + 8 * hi);
        const bf16* kn = U + (size_t)(b * SEQ + skey) * DUP + UC_KN + 128 * h + 8 * c8;
        const bf16* kr = Z + (size_t)(b * SEQ + skey) * DINP + ZC_KR + 8 * c8;
        const bf16* vs = U + (size_t)(b * SEQ + skey) * DUP + UC_V + 128 * h + 8 * c8;
        v4u st[5];
        st[0] = *(const v4u*)kn; st[1] = *(const v4u*)(kn + 64); st[2] = *(const v4u*)kr; st[3] = *(const v4u*)vs; st[4] = *(const v4u*)(vs + 64);
        { LAS unsigned char* sb = F.lds;
          *(LAS v4u*)(sb + kdst) = st[0]; *(LAS v4u*)(sb + kdst + 128) = st[1]; *(LAS v4u*)(sb + kdst + 256) = st[2]; *(LAS v4u*)(sb + vdst) = st[3]; *(LAS v4u*)(sb + vdst + 8192) = st[4]; }
        __syncthreads();
        f32x16 o[4]; o[0] = (f32x16){}; o[1] = (f32x16){}; o[2] = (f32x16){}; o[3] = (f32x16){};
        float m = -1e30f, l = 0.f;
        for (int j = 0; j <= jhi; ++j) {
            const int cur = j & 1;
            if (j < jhi) { const size_t ou = (size_t)(64 * (j + 1)) * DUP, oz = (size_t)(64 * (j + 1)) * DINP;
                st[0] = *(const v4u*)(kn + ou); st[1] = *(const v4u*)(kn + ou + 64); st[2] = *(const v4u*)(kr + oz); st[3] = *(const v4u*)(vs + ou); st[4] = *(const v4u*)(vs + ou + 64); }
            if (j <= cq) {
                f32x16 p0 = (f32x16){}, p1 = (f32x16){};
                fa::lds_cptr sb = (fa::lds_cptr)(F.lds + cur * STG);
                fa::tile_compute<12, 4, KP>(qf, o, m, l, sb, sb + KB, p0, p1, r32, hi, vlane);
            }
            if (j < jhi) { LAS unsigned char* sb = F.lds + (cur ^ 1) * STG;
                *(LAS v4u*)(sb + kdst) = st[0]; *(LAS v4u*)(sb + kdst + 128) = st[1]; *(LAS v4u*)(sb + kdst + 256) = st[2]; *(LAS v4u*)(sb + vdst) = st[3]; *(LAS v4u*)(sb + vdst + 8192) = st[4]; }
            __syncthreads();
        }
        fa::store_o<4>(o, l, Z + (size_t)qrow * DINP + ZC_GB + 128 * h, MIX + (size_t)qrow * DM + 512 + 128 * h, hi);
    }
}

__device__ __forceinline__ void final_norm(const Frame& F) {
    const float* ssq = (const float*)(F.ws + WS_SSQ2); const float* nf = inp<15>(F);
    const int gw = F.vcu * NWAVES + F.wave, NGW = F.G * NWAVES;
    for (int m = gw; m < T; m += NGW) {
        float s = (F.lane < 32) ? ssq[(size_t)m * 32 + F.lane] : 0.f; s = wave_sum(s);
        const float r = rsqrtf(s * (1.0f / DM) + EPS);
        f32x4* o = (f32x4*)(F.out + (size_t)m * DM) + F.lane; const f32x4* g = (const f32x4*)nf + F.lane;
#pragma unroll
        for (int j = 0; j < 4; ++j) { f32x4 v = o[64 * j]; const f32x4 gg = g[64 * j]; v.x *= r * gg.x; v.y *= r * gg.y; v.z *= r * gg.z; v.w *= r * gg.w; o[64 * j] = v; }
    }
}

constexpr int N_PHASES = 12;
__global__ void __launch_bounds__(NTHREADS, 2) trunk_fwd(Args args) {
    extern __shared__ __attribute__((aligned(16))) unsigned char lds[];
    const int G = gridDim.x; int vcu; { const int bx = blockIdx.x; vcu = (G % 8 == 0) ? (bx % 8) * (G / 8) + bx / 8 : bx; }
    volatile LAS unsigned* MISC = (volatile LAS unsigned*)((LAS unsigned char*)lds + MISC_OFF);
    for (int u = threadIdx.x; u < (LDS_BYTES - LDSCTL_OFF) / 4; u += NTHREADS) ((LAS unsigned*)((LAS unsigned char*)lds + LDSCTL_OFF))[u] = 0u;
    __syncthreads();
    XcdBarrier bar; bar.bar = (unsigned*)(args.ws + WS_CTL) + CW_BAR; bar.x = 0; bar.st = nullptr;
    if (MK_N_LAUNCHES == 1) bar = xcd_barrier_post((unsigned*)(args.ws + WS_CTL) + CW_BAR, MISC + 8);

    for (int ph = args.ph_lo; ph < args.ph_hi; ++ph) {
        Frame F; F.a = &args; F.G = G; F.vcu = vcu;
        { int tid = threadIdx.x; asm volatile("" : "+v"(tid)); F.tid = tid; F.lane = tid & 63; F.wave = __builtin_amdgcn_readfirstlane(tid >> 6); }
        { unsigned char* w = args.ws; asm volatile("" : "+s"(w)); F.ws = w; }
        { float* o = args.out; asm volatile("" : "+s"(o)); F.out = o; }
        { unsigned lb = 0; asm volatile("" : "+s"(lb)); F.lds = (LAS unsigned char*)lds + lb; }
        bf16* Z = (bf16*)(F.ws + WS_Z); bf16* U = (bf16*)(F.ws + WS_U); bf16* PE = (bf16*)(F.ws + WS_Z);
        float* SSQ1 = (float*)(F.ws + WS_SSQ1); float* SSQ2 = (float*)(F.ws + WS_SSQ2); float* SSQQ = (float*)(F.ws + WS_SSQQ); float* SSQKV = (float*)(F.ws + WS_SSQKV);
        const f32x2* CS = (const f32x2*)(F.ws + WS_CS);
        if (ph == 0) p0_prologue(F);
        else if (ph == N_PHASES - 1) final_norm(F);
        else {
            const int L = (ph - 1) / 5; int kind = (ph - 1) % 5;
#ifdef MK_ONLY
            if (kind != MK_ONLY) kind = 99;
#endif
            bf16* HIN = (bf16*)(F.ws + ((L & 1) ? WS_BUFB : WS_BUFA));
            bf16* MIX = (bf16*)(F.ws + ((L & 1) ? WS_BUFA : WS_BUFB));
            if (kind == 0) {
                EpiP1 E{Z, SSQ2, SSQQ, SSQKV, CS};
                const bf16* Bt = (const bf16*)(F.ws + WS_WIN) + (size_t)L * DINP * DM;
                if (MK_NAIVE & 1) naive_gemm(F, HIN, DM, Bt, DM, DINP, E);
                else fast_gemm(F, HIN, DM, Bt, DM, DINP, E);
            } else if (kind == 1) {
                EpiUp E{U, SSQQ, SSQKV, CS};
                const bf16* Bt = (const bf16*)(F.ws + WS_WUP) + (size_t)L * DUP * KUP;
#if !defined(MK_SUB) || MK_SUB == 0
                if (MK_NAIVE & 1) naive_gemm(F, Z + ZC_CQ, DINP, Bt, KUP, DUP, E);
                else fast_gemm(F, Z + ZC_CQ, DINP, Bt, KUP, DUP, E);
#endif
                __syncthreads();
                relaunder(F);
#if !defined(MK_SUB) || MK_SUB == 1
                if (MK_NAIVE & 2) naive_attn_a(F, L); else fast_attn_a(F, L);
#endif
            } else if (kind == 2) {
                if (MK_NAIVE & 4) naive_attn_b(F, L); else fast_attn_b(F, L);
            } else if (kind == 3) {
                EpiPe E0{PE};
                const bf16* Bpe = (const bf16*)(F.ws + WS_WPE) + (size_t)L * DM * DPLE;
                const bf16* PBl = (const bf16*)(F.ws + WS_PB) + (size_t)L * T * DPLE;
#if !defined(MK_SUB) || MK_SUB == 0
                if (MK_NAIVE & 1) naive_gemm(F, PBl, DPLE, Bpe, DPLE, DM, E0);
                else fast_gemm(F, PBl, DPLE, Bpe, DPLE, DM, E0);
#endif
                __syncthreads();
                relaunder(F);
                bf16* HIN2 = (bf16*)(F.ws + ((L & 1) ? WS_BUFB : WS_BUFA)); bf16* MIX2 = (bf16*)(F.ws + ((L & 1) ? WS_BUFA : WS_BUFB));
                EpiOut E1{L == 0 ? inp<0>(F) : (const float*)F.out, F.out, HIN2, (float*)(F.ws + WS_SSQ1)};
                const bf16* Bo = (const bf16*)(F.ws + WS_WOUT) + (size_t)L * DM * DM;
#if !defined(MK_SUB) || MK_SUB == 1
                if (MK_NAIVE & 1) naive_gemm(F, MIX2, DM, Bo, DM, DM, E1);
                else fast_gemm(F, MIX2, DM, Bo, DM, DM, E1);
#endif
            } else if (kind == 4) {
                EpiGate E{F.out, MIX, PE, inp<14>(F) + (size_t)L * DM, SSQ1, SSQ2};
                const bf16* Bg = (const bf16*)(F.ws + WS_WPG) + (size_t)L * DM * DM;
                if (MK_NAIVE & 1) naive_gemm(F, HIN, DM, Bg, DM, DM, E);
                else fast_gemm(F, HIN, DM, Bg, DM, DM, E);
            }
        }
        if (ph + 1 < args.ph_hi) xcd_barrier(bar);
    }
}

extern "C" void kernel_launch(void* const* d_in, const int* in_sizes, int n_in, void* d_out, int out_size, void* d_ws, size_t ws_size, hipStream_t stream) {
    static int grid = 0;
    if (grid == 0) {
        if (n_in != 16 || in_sizes[0] != T * DM || out_size != T * DM || ws_size < WS_END) {
            fprintf(stderr, "kernel_launch: unexpected shapes (n_in %d, in0 %d, out %d, ws %zu); nothing launched\n", n_in, n_in > 0 ? in_sizes[0] : -1, out_size, ws_size); grid = -1; return; }
        int dev = 0, cus = 0, per_cu = 0;
        if (hipGetDevice(&dev) != hipSuccess || hipDeviceGetAttribute(&cus, hipDeviceAttributeMultiprocessorCount, dev) != hipSuccess) { grid = -1; return; }
        if (hipFuncSetAttribute((const void*)trunk_fwd, hipFuncAttributeMaxDynamicSharedMemorySize, LDS_BYTES) != hipSuccess) { fprintf(stderr, "kernel_launch: hipFuncSetAttribute failed\n"); grid = -1; return; }
        if (hipOccupancyMaxActiveBlocksPerMultiprocessor(&per_cu, (const void*)trunk_fwd, NTHREADS, LDS_BYTES) != hipSuccess || per_cu < 1)
            fprintf(stderr, "kernel_launch: note: occupancy query reports %d workgroups per CU\n", per_cu);
        (void)hipGetLastError();
        grid = cus;
    }
    if (grid < 0) return;
    if (hipMemsetAsync((char*)d_ws + WS_CTL, 0, CTL_ZERO_BYTES, stream) != hipSuccess) { fprintf(stderr, "kernel_launch: hipMemsetAsync failed\n"); return; }
    Args a{};
    for (int i = 0; i < 16; ++i) a.in[i] = d_in[i];
    a.out = (float*)d_out; a.ws = (unsigned char*)d_ws;
    for (int li = 0; li < MK_N_LAUNCHES; ++li) {
        a.ph_lo = (MK_N_LAUNCHES == 1) ? 0 : li; a.ph_hi = (MK_N_LAUNCHES == 1) ? N_PHASES : li + 1; a.li = li;
        hipLaunchKernelGGL(trunk_fwd, dim3(grid), dim3(NTHREADS), LDS_BYTES, stream, a);
        const hipError_t le = hipPeekAtLastError();
        if (le != hipSuccess) { fprintf(stderr, "kernel_launch: launch %d failed: %s\n", li, hipGetErrorName(le)); break; }
    }
}
```

```cpp
#include <hip/hip_runtime.h>
#include <cstdio>
#include <cstdint>

#ifndef MK_N_LAUNCHES
#define MK_N_LAUNCHES 1
#endif
#ifndef MK_NAIVE
#define MK_NAIVE 0x0
#endif

#ifndef MK_STAG_US
#define MK_STAG_US 0
#endif
#ifndef MK_FUSE_FINAL
#define MK_FUSE_FINAL 1
#endif
#ifndef MK_PRIO
#define MK_PRIO 1
#endif
#ifndef MK_KPF
#define MK_KPF 4
#endif
#ifndef MK_LO
#define MK_LO 0
#endif
#ifndef MK_NOHOIST
#define MK_NOHOIST 0
#endif
#ifndef MK_PROBE
#define MK_PROBE 0
#endif
#ifndef MK_DUP
#define MK_DUP 0
#endif
__device__ __forceinline__ int opaque_i(int v) { asm volatile("" : "+s"(v)); return v; }
#if MK_DUP
#define REP(k) _Pragma("nounroll") for (int rep_ = 0, nrep_ = (((MK_DUP >> (k)) & 1) ? opaque_i(2) : 1); rep_ < nrep_; ++rep_, relaunder(F))
#define REP6 _Pragma("nounroll") for (int rep_ = 0, nrep_ = (((MK_DUP >> 6) & 1) ? opaque_i(1 + (L == 0)) : 1); rep_ < nrep_; ++rep_, relaunder(F))
#else
#define REP(k)
#define REP6
#endif
constexpr int NB = 16, SEQ = 2048, T = NB * SEQ, DM = 1024, DIN = 3008, DINP = 3072, DPLE = 256, DEPTH = 2;
#ifndef MK_ABSORB
#define MK_ABSORB 1
#endif
constexpr int DUP = MK_ABSORB ? 768 : 1792, KUP = MK_ABSORB ? 256 : 384;
constexpr float EPS = 1e-6f;
constexpr float LOG2E = 1.4426950408889634f;
constexpr float QA_SCALE = 0.125f * LOG2E;
constexpr float QB_SCALE = 0.07216878364870322f * LOG2E;
constexpr int ZC_QA = 0, ZC_KA = 512, ZC_VA = 1024, ZC_GA = 1536, ZC_GB = 2048, ZC_CQ = 2560, ZC_CKV = 2816, ZC_KR = 2944, ZC_PAD = 3008;
constexpr int UC_QN = 0, UC_QR = 512, UC_KN = 768, UC_V = 1280;

constexpr size_t MiB = 1u << 20;
constexpr size_t WS_CTL = 0, CTL_ZERO_BYTES = 128 * 1024;
constexpr size_t WS_WIN = 1 * MiB;
constexpr size_t WS_WUP = 13 * MiB;
constexpr size_t WS_WOUT = 16 * MiB;
constexpr size_t WS_WPG = 20 * MiB;
constexpr size_t WS_WPE = 24 * MiB;
constexpr size_t WS_CS = 25 * MiB;
constexpr size_t WS_SSQ1 = 33 * MiB;
constexpr size_t WS_SSQ2 = 37 * MiB;
constexpr size_t WS_SSQQ = 41 * MiB;
constexpr size_t WS_SSQKV = 42 * MiB;
constexpr size_t WS_PB = 43 * MiB;
constexpr size_t WS_BUFA = 75 * MiB;
constexpr size_t WS_BUFB = 139 * MiB;
constexpr size_t WS_Z = 203 * MiB;
constexpr size_t WS_U = 395 * MiB;
constexpr size_t WS_END = 507 * MiB;
constexpr size_t WS_LO1 = WS_Z + 64 * MiB;
constexpr size_t WS_CKVN = WS_U + 48 * MiB;
constexpr size_t WS_WVT = WS_WUP + 2 * MiB;

constexpr int NWAVES = 8, NTHREADS = 512;
constexpr int RING_BYTES = 131072, LDSCTL_OFF = RING_BYTES, MISC_OFF = LDSCTL_OFF + 320, LDS_BYTES = 147456;

#define GAS __attribute__((address_space(1)))
#define LAS __attribute__((address_space(3)))
typedef unsigned short bf16;
typedef unsigned v4u __attribute__((ext_vector_type(4)));
typedef unsigned v2u __attribute__((ext_vector_type(2)));
typedef float f32x4 __attribute__((ext_vector_type(4)));
typedef float f32x2 __attribute__((ext_vector_type(2)));
typedef float f32x16 __attribute__((ext_vector_type(16)));
typedef short bf16x8 __attribute__((ext_vector_type(8)));
typedef short s16x4 __attribute__((ext_vector_type(4)));
typedef __bf16 bf16x2_t __attribute__((ext_vector_type(2)));
typedef GAS unsigned gu32;
#define RLX_AGENT __ATOMIC_RELAXED, __HIP_MEMORY_SCOPE_AGENT

constexpr float LOG2E_ = 1.4426950408889634f;
__device__ __forceinline__ float bf2f(unsigned b) { return __uint_as_float(b << 16); }
__device__ __forceinline__ unsigned f2bf(float f) { unsigned u = __float_as_uint(f); return (u + 0x7fffu + ((u >> 16) & 1u)) >> 16; }
__device__ __forceinline__ unsigned pk2(float lo, float hi) { f32x2 v = {lo, hi}; bf16x2_t b = __builtin_convertvector(v, bf16x2_t); return __builtin_bit_cast(unsigned, b); }
__device__ __forceinline__ float sigmoid_f(float v) { return __builtin_amdgcn_rcpf(1.0f + __builtin_amdgcn_exp2f(v * -LOG2E_)); }
__device__ __forceinline__ float silu_f(float v) { return v * sigmoid_f(v); }
__device__ __forceinline__ void unpack8(v4u w, float (&f)[8]) {
    f[0] = bf2f(w.x & 0xffffu); f[1] = bf2f(w.x >> 16); f[2] = bf2f(w.y & 0xffffu); f[3] = bf2f(w.y >> 16);
    f[4] = bf2f(w.z & 0xffffu); f[5] = bf2f(w.z >> 16); f[6] = bf2f(w.w & 0xffffu); f[7] = bf2f(w.w >> 16);
}
__device__ __forceinline__ v4u pack8(const float (&f)[8]) { v4u w; w.x = pk2(f[0], f[1]); w.y = pk2(f[2], f[3]); w.z = pk2(f[4], f[5]); w.w = pk2(f[6], f[7]); return w; }

__device__ __forceinline__ void join8(v4u hi, v4u lo, float (&f)[8]) { float a[8], b[8]; unpack8(hi, a); unpack8(lo, b);
#pragma unroll
    for (int j = 0; j < 8; ++j) f[j] = MK_LO ? a[j] + b[j] : a[j]; }
__device__ __forceinline__ void split8(const float (&f)[8], v4u& hi, v4u& lo) { hi = pack8(f); float a[8], d[8]; unpack8(hi, a);
#pragma unroll
    for (int j = 0; j < 8; ++j) d[j] = f[j] - a[j];
    lo = pack8(d); }
__device__ const float INV_FREQ[32] = {
    1.000000000e+00f, 7.498942614e-01f, 5.623413324e-01f, 4.216965139e-01f, 3.162277639e-01f, 2.371373773e-01f, 1.778279394e-01f, 1.333521307e-01f,
    1.000000015e-01f, 7.498941571e-02f, 5.623413250e-02f, 4.216965288e-02f, 3.162277490e-02f, 2.371373773e-02f, 1.778279431e-02f, 1.333521493e-02f,
    9.999999776e-03f, 7.498941850e-03f, 5.623413250e-03f, 4.216964822e-03f, 3.162277630e-03f, 2.371373586e-03f, 1.778279431e-03f, 1.333521446e-03f,
    1.000000047e-03f, 7.498942432e-04f, 5.623413017e-04f, 4.216965172e-04f, 3.162277571e-04f, 2.371373703e-04f, 1.778279402e-04f, 1.333521504e-04f};

#define XB_TMO      128
#define XB_XCNT(j)  (256  + 64 * (j))
#define XB_XSUB(j)  (1280 + 64 * (j))
#define XB_XGEN(j)  (2304 + 64 * (j))
#define XB_TOP      3328
#define XB_TOPGEN   3392
#define XCD_BAR_WORDS 3456
#define XB_SPIN_CAP (1u << 22)
constexpr int CW_BAR = 4096;

__device__ __forceinline__ unsigned xb_ld(unsigned* p)              { return __hip_atomic_load(p, __ATOMIC_RELAXED, __HIP_MEMORY_SCOPE_AGENT); }
__device__ __forceinline__ unsigned xb_add(unsigned* p, unsigned v) { return __hip_atomic_fetch_add(p, v, __ATOMIC_RELAXED, __HIP_MEMORY_SCOPE_AGENT); }
__device__ __forceinline__ unsigned xb_xcc_id() { return (unsigned)__builtin_amdgcn_s_getreg((3 << 11) | 20) & 0xFu; }
#define XB_SPIN(cond, bar) do { unsigned _sp = 0; while (cond) { __builtin_amdgcn_s_sleep(1); \
    if ((++_sp & 255u) == 0u) { if (xb_ld(&(bar)[XB_TMO])) break; if (_sp > XB_SPIN_CAP) { atomicAdd(&(bar)[XB_TMO], 1u); break; } } } } while (0)
struct XcdBarrier { unsigned* bar; unsigned x; volatile LAS unsigned* st; };
__device__ __forceinline__ XcdBarrier xcd_barrier_post(unsigned* bar, volatile LAS unsigned* st) {
    XcdBarrier b; b.bar = bar; b.x = xb_xcc_id(); b.st = st;
    if (threadIdx.x == 0) (void)xb_add(&bar[XB_XCNT(b.x)], 1u);
    return b;
}
__device__ __forceinline__ void xcd_barrier_complete(unsigned* bar, unsigned x_, unsigned& nloc, unsigned& nx) {
    const unsigned G = gridDim.x * gridDim.y * gridDim.z;
    unsigned x = x_; asm volatile("" : "+s"(x));
    unsigned sum, cnt, mine, sp = 0u;
    for (;;) {
        sum = 0u; cnt = 0u; mine = 0u;
#pragma unroll
        for (unsigned j = 0; j < 16; ++j) { const unsigned c = xb_ld(&bar[XB_XCNT(j)]); sum += c; cnt += (c > 0u) ? 1u : 0u; mine = (j == x) ? c : mine; }
        if (sum == G) break;
        __builtin_amdgcn_s_sleep(1);
        if ((++sp & 255u) == 0u) { if (xb_ld(&bar[XB_TMO])) break; if (sp > XB_SPIN_CAP) { atomicAdd(&bar[XB_TMO], 1u); break; } }
    }
    nloc = mine > 0u ? mine : 1u; nx = cnt > 0u ? cnt : 1u;
}
__device__ __forceinline__ void xcd_barrier(const XcdBarrier& b, const int tid) {
    asm volatile("s_waitcnt vmcnt(0)" ::: "memory");
    __syncthreads();
    if (tid == 0) {
        unsigned* bar = b.bar;
        __builtin_amdgcn_s_waitcnt(0);
        unsigned nloc = b.st[0], nx = b.st[1];
        if (nloc == 0u) { xcd_barrier_complete(bar, b.x, nloc, nx); b.st[0] = nloc; b.st[1] = nx; }
        const unsigned old = xb_add(&bar[XB_XSUB(b.x)], 1u);
        const unsigned gen = old / nloc;
        if (old + 1u == (gen + 1u) * nloc) {
            __builtin_amdgcn_fence(__ATOMIC_RELEASE, "agent");
            asm volatile("s_waitcnt vmcnt(0)" ::: "memory");
            const unsigned og = xb_add(&bar[XB_TOP], 1u);
            const unsigned tg = og / nx;
            if (og + 1u == (tg + 1u) * nx) xb_add(&bar[XB_TOPGEN], 1u);
            else XB_SPIN(xb_ld(&bar[XB_TOPGEN]) == tg, bar);
            __builtin_amdgcn_fence(__ATOMIC_ACQUIRE, "agent");
            xb_add(&bar[XB_XGEN(b.x)], 1u);
            asm volatile("s_waitcnt vmcnt(0)" ::: "memory");
        } else {
            XB_SPIN(xb_ld(&bar[XB_XGEN(b.x)]) == gen, bar);
            __builtin_amdgcn_fence(__ATOMIC_ACQUIRE, "agent");
            asm volatile("s_waitcnt vmcnt(0)" ::: "memory");
        }
    }
    __syncthreads();
}

struct Args { const void* in[16]; float* out; unsigned char* ws; int ph_lo, ph_hi, li, pad; };
struct Frame {
    LAS unsigned char* lds;
    unsigned char* ws;
    const Args* a;
    int tid, lane, wave, vcu, G, bx;
    float* out;
};
__device__ __forceinline__ void relaunder(Frame& F) {
    int tid = F.tid; asm volatile("" : "+v"(tid)); F.tid = tid; F.lane = tid & 63; F.wave = __builtin_amdgcn_readfirstlane(tid >> 6);
    GAS unsigned char* w = (GAS unsigned char*)F.ws; asm volatile("" : "+s"(w)); F.ws = (unsigned char*)w;
    GAS float* o = (GAS float*)F.out; asm volatile("" : "+s"(o)); F.out = (float*)o;
    unsigned lb = 0; asm volatile("" : "+s"(lb)); F.lds = F.lds + lb;
}
template <int I> __device__ __forceinline__ const float* inp(const Frame& F) { const GAS float* p = (const GAS float*)F.a->in[I]; asm volatile("" : "+s"(p)); return (const float*)p; }
__device__ __forceinline__ float wave_sum(float v) {
#pragma unroll
    for (int o = 1; o < 64; o <<= 1) v += __shfl_xor(v, o);
    return v;
}
__device__ __forceinline__ float wave_max(float v) {
#pragma unroll
    for (int o = 1; o < 64; o <<= 1) v = fmaxf(v, __shfl_xor(v, o));
    return v;
}

#ifndef MK_NEGM
#define MK_NEGM 1
#endif
#ifndef MK_SP
#define MK_SP 3
#endif
#ifndef MK_SPKPF
#define MK_SPKPF 4
#endif
#ifndef MK_WT
#define MK_WT 0
#endif
template <int BIT = 1> __device__ __forceinline__ void st16(void* base, size_t byte_off, const v4u& v) {
    if (MK_WT & BIT) { const __amdgpu_buffer_rsrc_t r = __builtin_amdgcn_make_buffer_rsrc(base, (short)0, 0x7fffffff, 0x00020000); __builtin_amdgcn_raw_buffer_store_b128(v, r, (int)(unsigned)byte_off, 0, 16); }
    else *(v4u*)((unsigned char*)base + byte_off) = v;
}
__device__ __forceinline__ void st8(void* base, size_t byte_off, const v2u& v) {
    if (MK_WT & 2) { const __amdgpu_buffer_rsrc_t r = __builtin_amdgcn_make_buffer_rsrc(base, (short)0, 0x7fffffff, 0x00020000); __builtin_amdgcn_raw_buffer_store_b64(v, r, (int)(unsigned)byte_off, 0, 16); }
    else *(v2u*)((unsigned char*)base + byte_off) = v;
}

struct WPtrs { const float *norm_mix, *w_in, *g_q, *w_uq, *g_kv, *w_ukv, *w_out, *norm_ple, *w_pe, *w_pg; };
__device__ __forceinline__ float wsrc(const WPtrs& F, int mat, int L, int n, int k) {
    if (mat == 0) {
        int sc;
        if (n < 2048) sc = n;
        else if (n < ZC_CQ) sc = 2496 + (n - ZC_GB);
        else if (n < ZC_CKV) sc = 2048 + (n - ZC_CQ);
        else if (n < ZC_KR) sc = 2304 + (n - ZC_CKV);
        else if (n < ZC_PAD) { const int j = n - ZC_KR; sc = 2432 + (j >> 1) + 32 * (j & 1); }
        else return 0.f;
        return F.w_in[((size_t)L * DM + k) * DIN + sc] * F.norm_mix[L * DM + k];
    } else if (mat == 1 && MK_ABSORB) {
        if (n < UC_QR) return 0.f;
        const int j = (n - UC_QR) & 63, hh = (n - UC_QR) >> 6;
        return F.w_uq[((size_t)L * 256 + k) * 768 + hh * 192 + 128 + (j >> 1) + 32 * (j & 1)] * F.g_q[L * 256 + k];
    } else if (mat == 1) {
        if (n < UC_KN) {
            if (k >= 256) return 0.f;
            int sc;
            if (n < UC_QR) sc = (n >> 7) * 192 + (n & 127);
            else { const int j = (n - UC_QR) & 63, hh = (n - UC_QR) >> 6; sc = hh * 192 + 128 + (j >> 1) + 32 * (j & 1); }
            return F.w_uq[((size_t)L * 256 + k) * 768 + sc] * F.g_q[L * 256 + k];
        } else {
            if (k < 256) return 0.f;
            const int kk = k - 256; int sc;
            if (n < UC_V) { const int m = n - UC_KN; sc = (m >> 7) * 256 + (m & 127); }
            else { const int m = n - UC_V; sc = (m >> 7) * 256 + 128 + (m & 127); }
            return F.w_ukv[((size_t)L * 128 + kk) * 1024 + sc] * F.g_kv[L * 128 + kk];
        }
    } else if (mat == 2) return F.w_out[((size_t)L * DM + k) * DM + n];
    else if (mat == 3) return F.w_pg[((size_t)L * DM + k) * DM + n] * F.norm_ple[L * DM + k];
    else return F.w_pe[((size_t)L * DPLE + k) * DM + n];
}
__device__ __forceinline__ void p0_prologue(const Frame& F) {
    const WPtrs W{inp<3>(F), inp<4>(F), inp<6>(F), inp<7>(F), inp<8>(F), inp<9>(F), inp<10>(F), inp<11>(F), inp<12>(F), inp<13>(F)};
    const float* xin = inp<0>(F); const float* pin = inp<1>(F); const int* positions = (const int*)inp<2>(F);
    const int gw = F.vcu * NWAVES + F.wave, NGW = F.G * NWAVES;
    {
        LAS float* scr = (LAS float*)F.lds + F.wave * (64 * 33);
        constexpr int UPN0 = MK_ABSORB ? UC_QR : 0;
        constexpr int NI0 = (DINP / 32) * (DM / 64), NI1 = ((DUP - UPN0) / 32) * (KUP / 64), NI2 = 32 * 16, NI3 = 32 * 16, NI4 = 32 * 4;
        constexpr int NIL = NI0 + NI1 + NI2 + NI3 + NI4;
        const int lane = F.lane;
        const bool split = (F.G == 256); const bool small_role = !split || F.wave < 2;
        const int gwa = split ? F.vcu * 2 + F.wave : gw, NGWA = split ? F.G * 2 : NGW;
        if (small_role)
        for (int it = gwa; it < 2 * NIL; it += NGWA) {
            const int L = it / NIL; int r = it % NIL; int mat, K; size_t base;
            if (r < NI0) { mat = 0; K = DM; base = WS_WIN + (size_t)L * DINP * DM * 2; }
            else if ((r -= NI0) < NI1) { mat = 1; K = KUP; base = WS_WUP + (size_t)L * DUP * KUP * 2; }
            else if ((r -= NI1) < NI2) { mat = 2; K = DM; base = WS_WOUT + (size_t)L * DM * DM * 2; }
            else if ((r -= NI2) < NI3) { mat = 3; K = DM; base = WS_WPG + (size_t)L * DM * DM * 2; }
            else { r -= NI3; mat = 4; K = DPLE; base = WS_WPE + (size_t)L * DM * DPLE * 2; }
            const int nkt = K / 64, tn = r / nkt, tk = r % nkt, n0 = tn * 32 + (mat == 1 ? UPN0 : 0), k0 = tk * 64;
            float wv[32];
#if MK_ABSORB
            {
                const int n = n0 + (lane & 31);
                const float* src; const float* scl = nullptr; int ld, col; float mul = 1.0f;
                if (mat == 0) { ld = DIN; src = W.w_in + (size_t)L * DM * DIN; scl = W.norm_mix + L * DM;
                    if (n < 2048) col = n;
                    else if (n < ZC_CQ) col = 2496 + (n - ZC_GB);
                    else if (n < ZC_CKV) col = 2048 + (n - ZC_CQ);
                    else if (n < ZC_KR) col = 2304 + (n - ZC_CKV);
                    else if (n < ZC_PAD) { const int j = n - ZC_KR; col = 2432 + (j >> 1) + 32 * (j & 1); }
                    else { col = 0; mul = 0.f; } }
                else if (mat == 1) { const int j = (n - UC_QR) & 63, hh = (n - UC_QR) >> 6; ld = 768; src = W.w_uq + (size_t)L * 256 * 768; scl = W.g_q + L * 256; col = hh * 192 + 128 + (j >> 1) + 32 * (j & 1); }
                else if (mat == 2) { ld = DM; src = W.w_out + (size_t)L * DM * DM; col = n; }
                else if (mat == 3) { ld = DM; src = W.w_pg + (size_t)L * DM * DM; scl = W.norm_ple + L * DM; col = n; }
                else { ld = DM; src = W.w_pe + (size_t)L * DPLE * DM; col = n; }
                const float* p = src + (size_t)(k0 + (lane >> 5)) * ld + col;
#pragma unroll
                for (int i = 0; i < 32; ++i) wv[i] = p[(size_t)(2 * i) * ld];
                if (scl != nullptr) {
                    float sv[32];
                    const float* q = scl + k0 + (lane >> 5);
#pragma unroll
                    for (int i = 0; i < 32; ++i) sv[i] = q[2 * i];
#pragma unroll
                    for (int i = 0; i < 32; ++i) wv[i] *= sv[i] * mul;
                }
            }
#else
#pragma unroll
            for (int i = 0; i < 32; ++i) wv[i] = wsrc(W, mat, L, n0 + (lane & 31), k0 + 2 * i + (lane >> 5));
#endif
#pragma unroll
            for (int i = 0; i < 32; ++i) scr[(2 * i + (lane >> 5)) * 33 + (lane & 31)] = wv[i];
            asm volatile("s_waitcnt lgkmcnt(0)" ::: "memory");
            bf16* dst = (bf16*)(F.ws + base);
            const int c = lane & 7;
#pragma unroll
            for (int j = 0; j < 4; ++j) { const int n = (lane >> 3) + 8 * j; const LAS float* sp = scr + (8 * c) * 33 + n;
                v4u o; o.x = pk2(sp[0 * 33], sp[1 * 33]); o.y = pk2(sp[2 * 33], sp[3 * 33]); o.z = pk2(sp[4 * 33], sp[5 * 33]); o.w = pk2(sp[6 * 33], sp[7 * 33]);
                *(v4u*)(dst + (size_t)(n0 + n) * K + k0 + 8 * c) = o; }
            asm volatile("s_waitcnt lgkmcnt(0)" ::: "memory");
        }
    }
    {
        bf16* hb = (bf16*)(F.ws + WS_BUFA); float* ssq = (float*)(F.ws + WS_SSQ2);
        const bool split = (F.G == 256);
        const int mstart = !split ? gw * 4 : (F.wave >= 2 ? (F.vcu * 6 + F.wave - 2) * 4 : 30720 + (F.vcu * 2 + F.wave) * 4);
        const int mstep = !split ? NGW * 4 : (F.wave >= 2 ? 1536 * 4 : T), mend = !split ? T : (F.wave >= 2 ? 30720 : T);
        for (int m0 = mstart; m0 < mend; m0 += mstep) {
            f32x4 v[4][4];
#pragma unroll
            for (int r = 0; r < 4; ++r) { const f32x4* xr = (const f32x4*)(xin + (size_t)(m0 + r) * DM) + F.lane;
#pragma unroll
                for (int j = 0; j < 4; ++j) v[r][j] = xr[64 * j]; }
#pragma unroll
            for (int r = 0; r < 4; ++r) {
                float sq = 0.f;
#pragma unroll
                for (int j = 0; j < 4; ++j) sq += (v[r][j].x * v[r][j].x + v[r][j].y * v[r][j].y) + (v[r][j].z * v[r][j].z + v[r][j].w * v[r][j].w);
                sq = wave_sum(sq);
                v2u* o8 = (v2u*)(hb + (size_t)(m0 + r) * DM) + F.lane;
#pragma unroll
                for (int j = 0; j < 4; ++j) { v2u w; w.x = pk2(v[r][j].x, v[r][j].y); w.y = pk2(v[r][j].z, v[r][j].w); o8[64 * j] = w; }
                if (F.lane < 32) ssq[(size_t)(m0 + r) * 32 + F.lane] = (F.lane == 0) ? sq : 0.f;
            }
        }
    }
    const int gt = F.vcu * NTHREADS + F.tid, NGT = F.G * NTHREADS;
    {
        v4u* pb = (v4u*)(F.ws + WS_PB);
        constexpr int NPI = 2 * T * DPLE / 8;
        for (int i0 = gt; i0 < NPI; i0 += 4 * NGT) {
            f32x4 a[4], b[4];
#pragma unroll
            for (int q = 0; q < 4; ++q) { const int i = i0 + q * NGT; if (i < NPI) { a[q] = ((const f32x4*)pin)[2 * i]; b[q] = ((const f32x4*)pin)[2 * i + 1]; } }
#pragma unroll
            for (int q = 0; q < 4; ++q) { const int i = i0 + q * NGT; if (i < NPI) { v4u w; w.x = pk2(a[q].x, a[q].y); w.y = pk2(a[q].z, a[q].w); w.z = pk2(b[q].x, b[q].y); w.w = pk2(b[q].z, b[q].w); pb[i] = w; } }
        }
    }
#if MK_ABSORB
    {
        {
            __syncthreads();
            LAS float* As = (LAS float*)F.lds;
            LAS float* Bs = As + 8 * 129;
            bf16* wup = (bf16*)(F.ws + WS_WUP);
            for (int it = F.vcu; it < 256; it += F.G) {
                const int L = it >> 7, hh = (it >> 5) & 3, k0 = (it & 31) * 8;
                {
                    float ta[2], tg[2], tb[32];
#pragma unroll
                    for (int i = 0; i < 2; ++i) { const int e = F.tid + i * NTHREADS, kk = e >> 7, d = e & 127; ta[i] = W.w_uq[((size_t)L * 256 + k0 + kk) * 768 + hh * 192 + d]; tg[i] = W.g_q[L * 256 + k0 + kk]; }
#pragma unroll
                    for (int i = 0; i < 32; ++i) { const int e = F.tid + i * NTHREADS, l = e >> 7, d = e & 127; tb[i] = W.w_ukv[((size_t)L * 128 + l) * 1024 + hh * 256 + d]; }
#pragma unroll
                    for (int i = 0; i < 2; ++i) { const int e = F.tid + i * NTHREADS, kk = e >> 7, d = e & 127; As[kk * 129 + d] = ta[i] * tg[i]; }
#pragma unroll
                    for (int i = 0; i < 32; ++i) { const int e = F.tid + i * NTHREADS, l = e >> 7, d = e & 127; Bs[l * 129 + d] = tb[i]; }
                }
                __syncthreads();
                const int kk = F.tid & 7, l0 = F.tid >> 3;
                float acc0 = 0.f, acc1 = 0.f;
                for (int d = 0; d < 128; ++d) { const float av = As[kk * 129 + d]; acc0 += av * Bs[l0 * 129 + d]; acc1 += av * Bs[(l0 + 64) * 129 + d]; }
                wup[((size_t)L * DUP + hh * 128 + l0) * KUP + k0 + kk] = (bf16)f2bf(acc0);
                wup[((size_t)L * DUP + hh * 128 + l0 + 64) * KUP + k0 + kk] = (bf16)f2bf(acc1);
                __syncthreads();
            }
        }
        bf16* wvt = (bf16*)(F.ws + WS_WVT);
        for (int i = gt; i < 2 * 65536; i += NGT) {
            const int j = i & 7, r32 = (i >> 3) & 31, hi = (i >> 8) & 1, sx = (i >> 9) & 1, d = (i >> 10) & 3, blk = (i >> 12) & 3, hh = (i >> 14) & 3, L = i >> 16;
            const int lat = 32 * d + 16 * sx + 8 * (j >> 2) + 4 * hi + (j & 3);
            wvt[i] = (bf16)f2bf(W.w_ukv[((size_t)L * 128 + lat) * 1024 + hh * 256 + 128 + 32 * blk + r32]);
        }
    }
#endif
    {
        f32x2* cs = (f32x2*)(F.ws + WS_CS);
        const bool split = (F.G == 256);
        const int gtd = split ? (F.vcu * 2 + F.wave) * 64 + F.lane : gt, NGTD = split ? F.G * 2 * 64 : NGT;
        if (!split || F.wave < 2)
        for (int i = gtd; i < T * 32; i += NGTD) {
            const int t = i >> 5, fi = i & 31;
            const float angf = (float)positions[t] * INV_FREQ[fi];
            const double a = (double)angf;
            const double kq = __builtin_rint(a * 0.63661977236758134308);
            const double r = (a - kq * 1.57079632679489655800) - kq * 6.12323399573676603587e-17;
            const double r2 = r * r;
            const double sn = r * (1.0 + r2 * (-1.0 / 6 + r2 * (1.0 / 120 + r2 * (-1.0 / 5040 + r2 * (1.0 / 362880 + r2 * (-1.0 / 39916800))))));
            const double cn = 1.0 + r2 * (-0.5 + r2 * (1.0 / 24 + r2 * (-1.0 / 720 + r2 * (1.0 / 40320 + r2 * (-1.0 / 3628800 + r2 * (1.0 / 479001600))))));
            const int q = (int)((long long)kq & 3);
            const double c = (q == 0) ? cn : (q == 1) ? -sn : (q == 2) ? -cn : sn;
            const double s = (q == 0) ? sn : (q == 1) ? cn : (q == 2) ? -sn : -cn;
            cs[i] = (f32x2){(float)c, (float)s};
        }
    }
}

__device__ __forceinline__ void ckvn_pass(const Frame& F, int L) {
    const bf16* Z = (const bf16*)(F.ws + WS_Z); bf16* CK = (bf16*)(F.ws + WS_CKVN); const float* ssq = (const float*)(F.ws + WS_SSQKV); const float* gk = inp<8>(F) + L * 128;
    const int gt = F.vcu * NTHREADS + F.tid, NGT = F.G * NTHREADS;
    for (int i0 = gt; i0 < T * 16; i0 += 4 * NGT) {
        f32x4 sq[4], g0[4], g1[4]; v4u zz[4];
#pragma unroll
        for (int q = 0; q < 4; ++q) { const int i = (i0 + q * NGT < T * 16) ? i0 + q * NGT : i0; const int row = i >> 4, c = i & 15;
            sq[q] = *(const f32x4*)(ssq + (size_t)row * 4); zz[q] = *(const v4u*)(Z + (size_t)row * DINP + ZC_CKV + 8 * c);
            g0[q] = *(const f32x4*)(gk + 8 * c); g1[q] = *(const f32x4*)(gk + 8 * c + 4); }
#pragma unroll
        for (int q = 0; q < 4; ++q) { const int i = i0 + q * NGT; if (i < T * 16) { const int row = i >> 4, c = i & 15;
            const float r = rsqrtf(((sq[q].x + sq[q].y) + (sq[q].z + sq[q].w)) * (1.0f / 128) + EPS);
            float v[8]; unpack8(zz[q], v);
            v[0] *= r * g0[q].x; v[1] *= r * g0[q].y; v[2] *= r * g0[q].z; v[3] *= r * g0[q].w; v[4] *= r * g1[q].x; v[5] *= r * g1[q].y; v[6] *= r * g1[q].z; v[7] *= r * g1[q].w;
            st16<4>(CK, ((size_t)row * 128 + 8 * c) * 2, pack8(v)); } }
    }
}

struct EpiP1 {
    static constexpr bool HAS_SSQ = true; static constexpr int NB = 4;
    bf16* Z; const float* ssq_h; float* ssq_q; float* ssq_kv; const f32x2* cs;
    __device__ __forceinline__ float rowsum_part(int row, int part, int) const { const f32x4* s = (const f32x4*)(ssq_h + (size_t)row * 32 + part * 8); const f32x4 a = s[0], b = s[1]; return ((a.x + a.y) + (a.z + a.w)) + ((b.x + b.y) + (b.z + b.w)); }
    __device__ __forceinline__ float rowscale_from(float tot, int) const { return rsqrtf(tot * (1.0f / DM) + EPS); }
    struct Pre {}; struct ColPre {};
    __device__ __forceinline__ ColPre colpre(int) const { return ColPre{}; }
    __device__ __forceinline__ Pre pre8(int, int) const { return Pre{}; }
    __device__ __forceinline__ float run8(int row, int col0, float rs, float (&v)[8], const Pre&, const ColPre&) const {
        float ss = 0.f;
#pragma unroll
        for (int j = 0; j < 8; ++j) v[j] *= rs;
        if (col0 < ZC_KA) {
#pragma unroll
            for (int j = 0; j < 8; ++j) v[j] *= QA_SCALE;
        } else if (col0 >= ZC_GA && col0 < ZC_CQ) {
#pragma unroll
            for (int j = 0; j < 8; ++j) v[j] = silu_f(v[j]);
        } else if (col0 >= ZC_KR && col0 < ZC_PAD) {
            const f32x4* c4 = (const f32x4*)(cs + (size_t)row * 32 + ((col0 - ZC_KR) >> 1));
            const f32x4 c01 = c4[0], c23 = c4[1];
            const float cc[4] = {c01.x, c01.z, c23.x, c23.z}, sn[4] = {c01.y, c01.w, c23.y, c23.w};
#pragma unroll
            for (int i = 0; i < 4; ++i) { const float x1 = v[2 * i], x2 = v[2 * i + 1]; v[2 * i] = x1 * cc[i] - x2 * sn[i]; v[2 * i + 1] = x2 * cc[i] + x1 * sn[i]; }
        }
        const v4u w = pack8(v);
        st16(Z, ((size_t)row * DINP + col0) * 2, w);
        if (col0 >= ZC_CQ && col0 < ZC_KR) { float f[8]; unpack8(w, f);
#pragma unroll
            for (int j = 0; j < 8; ++j) ss += f[j] * f[j]; }
        return ss;
    }
    __device__ __forceinline__ void ssq(int row, int grp, float s) const {
        if (grp >= ZC_CQ / 32 && grp < ZC_CKV / 32) ssq_q[(size_t)row * 8 + (grp - ZC_CQ / 32)] = s;
        else if (grp >= ZC_CKV / 32 && grp < ZC_KR / 32) ssq_kv[(size_t)row * 4 + (grp - ZC_CKV / 32)] = s;
    }
};
struct EpiUp {
    static constexpr bool HAS_SSQ = false; static constexpr int NB = 4;
    bf16* U; const float* ssq_q; const float* ssq_kv; const f32x2* cs;
    __device__ __forceinline__ float rowsum_part(int row, int part, int col0) const {
        if (col0 < UC_KN) { const f32x2 a = *(const f32x2*)(ssq_q + (size_t)row * 8 + part * 2); return a.x + a.y; }
        return ssq_kv[(size_t)row * 4 + part];
    }
    __device__ __forceinline__ float rowscale_from(float tot, int col0) const { return (col0 < UC_KN) ? rsqrtf(tot * (1.0f / 256) + EPS) * QB_SCALE : rsqrtf(tot * (1.0f / 128) + EPS); }
    struct Pre {}; struct ColPre {};
    __device__ __forceinline__ ColPre colpre(int) const { return ColPre{}; }
    __device__ __forceinline__ Pre pre8(int, int) const { return Pre{}; }
    __device__ __forceinline__ float run8(int row, int col0, float rs, float (&v)[8], const Pre&, const ColPre&) const {
#pragma unroll
        for (int j = 0; j < 8; ++j) v[j] *= rs;
        if (col0 >= UC_QR && col0 < UC_KN) {
            const f32x4* c4 = (const f32x4*)(cs + (size_t)row * 32 + (((col0 - UC_QR) & 63) >> 1));
            const f32x4 c01 = c4[0], c23 = c4[1];
            const float cc[4] = {c01.x, c01.z, c23.x, c23.z}, sn[4] = {c01.y, c01.w, c23.y, c23.w};
#pragma unroll
            for (int i = 0; i < 4; ++i) { const float x1 = v[2 * i], x2 = v[2 * i + 1]; v[2 * i] = x1 * cc[i] - x2 * sn[i]; v[2 * i + 1] = x2 * cc[i] + x1 * sn[i]; }
        }
        st16(U, ((size_t)row * DUP + col0) * 2, pack8(v));
        return 0.f;
    }
    __device__ __forceinline__ void ssq(int, int, float) const {}
};
struct EpiPe {
    static constexpr bool HAS_SSQ = false; static constexpr int NB = 4;
    bf16* PE;
    __device__ __forceinline__ float rowsum_part(int, int, int) const { return 0.f; }
    __device__ __forceinline__ float rowscale_from(float, int) const { return 1.f; }
    struct Pre {}; struct ColPre {};
    __device__ __forceinline__ ColPre colpre(int) const { return ColPre{}; }
    __device__ __forceinline__ Pre pre8(int, int) const { return Pre{}; }
    __device__ __forceinline__ float run8(int row, int col0, float, float (&v)[8], const Pre&, const ColPre&) const { st16(PE, ((size_t)row * DM + col0) * 2, pack8(v)); return 0.f; }
    __device__ __forceinline__ void ssq(int, int, float) const {}
};
struct EpiOut {
    static constexpr bool HAS_SSQ = true; static constexpr int NB = MK_LO ? 2 : 4;
    const float* res32; const bf16* rhi; const bf16* rlo; bf16* hb; bf16* lo; float* ssq_o;
    __device__ __forceinline__ float rowsum_part(int, int, int) const { return 0.f; }
    __device__ __forceinline__ float rowscale_from(float, int) const { return 1.f; }
    struct Pre { v4u a, b; }; struct ColPre {};
    __device__ __forceinline__ ColPre colpre(int) const { return ColPre{}; }
    __device__ __forceinline__ Pre pre8(int row, int col0) const { const size_t off = (size_t)row * DM + col0;
        if (res32) return Pre{*(const v4u*)(res32 + off), *(const v4u*)(res32 + off + 4)};
        return Pre{*(const v4u*)(rhi + off), MK_LO ? *(const v4u*)(rlo + off) : (v4u){0u, 0u, 0u, 0u}}; }
    __device__ __forceinline__ float run8(int row, int col0, float, float (&v)[8], const Pre& pr, const ColPre&) const {
        const size_t off = (size_t)row * DM + col0;
        float r[8];
        if (res32) { r[0] = __uint_as_float(pr.a.x); r[1] = __uint_as_float(pr.a.y); r[2] = __uint_as_float(pr.a.z); r[3] = __uint_as_float(pr.a.w);
                     r[4] = __uint_as_float(pr.b.x); r[5] = __uint_as_float(pr.b.y); r[6] = __uint_as_float(pr.b.z); r[7] = __uint_as_float(pr.b.w); }
        else join8(pr.a, pr.b, r);
        float ss = 0.f;
#pragma unroll
        for (int j = 0; j < 8; ++j) { v[j] += r[j]; ss += v[j] * v[j]; }
        v4u h, l; split8(v, h, l);
        st16(hb, off * 2, h); if (MK_LO) *(v4u*)(lo + off) = l;
        return ss;
    }
    __device__ __forceinline__ void ssq(int row, int grp, float s) const { ssq_o[(size_t)row * 32 + grp] = s; }
};
struct EpiGate {
    static constexpr bool HAS_SSQ = true; static constexpr int NB = MK_LO ? 1 : 2;
    const bf16* hi_in; const bf16* lo_in; float* outw; bf16* hb; bf16* lo; const bf16* PE; const float* bias; const float* ssq_i; float* ssq_o;
    __device__ __forceinline__ float rowsum_part(int row, int part, int) const { const f32x4* s = (const f32x4*)(ssq_i + (size_t)row * 32 + part * 8); const f32x4 a = s[0], b = s[1]; return ((a.x + a.y) + (a.z + a.w)) + ((b.x + b.y) + (b.z + b.w)); }
    __device__ __forceinline__ float rowscale_from(float tot, int) const { return rsqrtf(tot * (1.0f / DM) + EPS); }
    struct Pre { v4u hi, lo, pe; }; struct ColPre { f32x4 ba, bb; };
    __device__ __forceinline__ ColPre colpre(int col0) const { return ColPre{*(const f32x4*)(bias + col0), *(const f32x4*)(bias + col0 + 4)}; }
    __device__ __forceinline__ Pre pre8(int row, int col0) const { const size_t off = (size_t)row * DM + col0; return Pre{*(const v4u*)(hi_in + off), MK_LO ? *(const v4u*)(lo_in + off) : (v4u){0u, 0u, 0u, 0u}, *(const v4u*)(PE + off)}; }
    __device__ __forceinline__ float run8(int row, int col0, float rs, float (&v)[8], const Pre& pr, const ColPre& cp) const {
        const size_t off = (size_t)row * DM + col0;
        float h[8]; join8(pr.hi, pr.lo, h);
        float pe[8]; unpack8(pr.pe, pe);
        const float bs[8] = {cp.ba.x, cp.ba.y, cp.ba.z, cp.ba.w, cp.bb.x, cp.bb.y, cp.bb.z, cp.bb.w};
        float ss = 0.f;
#pragma unroll
        for (int j = 0; j < 8; ++j) { v[j] = h[j] + pe[j] * sigmoid_f(v[j] * rs + bs[j]); ss += v[j] * v[j]; }
        if (outw) { *(f32x4*)(outw + off) = (f32x4){v[0], v[1], v[2], v[3]}; *(f32x4*)(outw + off + 4) = (f32x4){v[4], v[5], v[6], v[7]}; }
        else { v4u hh, ll; split8(v, hh, ll); st16(hb, off * 2, hh); if (MK_LO) *(v4u*)(lo + off) = ll; }
        return ss;
    }
    __device__ __forceinline__ void ssq(int row, int grp, float s) const { ssq_o[(size_t)row * 32 + grp] = s; }
};
template <class EP> __device__ __forceinline__ void naive_gemm(const Frame& F, const bf16* A, int lda, const bf16* Bt, int K, int N, const EP& E) {
    const int gt = F.vcu * NTHREADS + F.tid, NGT = F.G * NTHREADS;
    const int ng = N / 32;
    for (int it = gt; it < T * ng; it += NGT) {
        const int row = it % T, cg = it / T, col0 = cg * 32;
        float acc[32];
#pragma unroll
        for (int j = 0; j < 32; ++j) acc[j] = 0.f;
        const bf16* ap = A + (size_t)row * lda; const bf16* bp = Bt + (size_t)col0 * K;
        for (int k0 = 0; k0 < K; k0 += 8) {
            float a[8]; unpack8(*(const v4u*)(ap + k0), a);
#pragma unroll
            for (int j = 0; j < 32; ++j) { float b[8]; unpack8(*(const v4u*)(bp + (size_t)j * K + k0), b);
#pragma unroll
                for (int e = 0; e < 8; ++e) acc[j] += a[e] * b[e]; }
        }
        float tot = 0.f;
#pragma unroll
        for (int part = 0; part < 4; ++part) tot += E.rowsum_part(row, part, col0);
        const float rs = E.rowscale_from(tot, col0);
        float ss = 0.f;
#pragma unroll
        for (int g = 0; g < 4; ++g) { float v[8];
#pragma unroll
            for (int j = 0; j < 8; ++j) v[j] = acc[g * 8 + j];
            ss += E.run8(row, col0 + g * 8, rs, v, E.pre8(row, col0 + g * 8), E.colpre(col0 + g * 8)); }
        if (EP::HAS_SSQ) E.ssq(row, cg, ss);
    }
}
__device__ __forceinline__ void naive_attn_a(const Frame& F, int L) {
    const bf16* Z = (const bf16*)(F.ws + WS_Z); bf16* MIX = (bf16*)(F.ws + ((L & 1) ? WS_BUFA : WS_BUFB));
    LAS float* sc = (LAS float*)F.lds + F.wave * 640;
    const float* rb = inp<5>(F) + (size_t)L * 8 * 257;
    const int gw = F.vcu * NWAVES + F.wave, NGW = F.G * NWAVES;
    for (int it = gw; it < T * 8; it += NGW) {
        const int row = it >> 3, h = it & 7, b = row >> 11, sq = row & 2047, cq = sq >> 6, ql = sq & 63;
        float q[64];
#pragma unroll
        for (int c = 0; c < 8; ++c) { float f[8]; unpack8(*(const v4u*)(Z + (size_t)row * DINP + ZC_QA + 64 * h + 8 * c), f);
#pragma unroll
            for (int e = 0; e < 8; ++e) q[8 * c + e] = f[e]; }
        float s[9]; float mx = -1e30f;
#pragma unroll
        for (int bi = 0; bi < 9; ++bi) {
            const int j = cq - 8 + bi; s[bi] = -1e30f;
            if (j >= 0) {
                const bf16* kp = Z + (size_t)(b * SEQ + 64 * j + F.lane) * DINP + ZC_KA + 64 * h; float d = 0.f;
#pragma unroll
                for (int c = 0; c < 8; ++c) { float f[8]; unpack8(*(const v4u*)(kp + 8 * c), f);
#pragma unroll
                    for (int e = 0; e < 8; ++e) d += q[8 * c + e] * f[e]; }
                int rel = (ql + 512) - (64 * bi + F.lane); rel = rel > 128 ? 128 : rel;
                s[bi] = d + rb[h * 257 + rel + 128] * LOG2E; mx = fmaxf(mx, s[bi]);
            }
        }
        mx = wave_max(mx); float l = 0.f;
#pragma unroll
        for (int bi = 0; bi < 9; ++bi) { const float pv = (cq - 8 + bi >= 0) ? exp2f(s[bi] - mx) : 0.f; l += pv; sc[64 * bi + F.lane] = pv; }
        l = wave_sum(l);
        asm volatile("s_waitcnt lgkmcnt(0)" ::: "memory");
        float o = 0.f;
        for (int bi = 0; bi < 9; ++bi) { const int j = cq - 8 + bi; if (j < 0) continue;
            const bf16* vp = Z + (size_t)(b * SEQ + 64 * j) * DINP + ZC_VA + 64 * h + F.lane;
            for (int kl = 0; kl < 64; ++kl) o += sc[64 * bi + kl] * bf2f(vp[(size_t)kl * DINP]); }
        const float g = bf2f(Z[(size_t)row * DINP + ZC_GA + 64 * h + F.lane]);
        MIX[(size_t)row * DM + 64 * h + F.lane] = (bf16)f2bf(o / l * g);
        asm volatile("s_waitcnt lgkmcnt(0)" ::: "memory");
    }
}
__device__ __forceinline__ void naive_attn_b(const Frame& F, int L) {
    const bf16* Z = (const bf16*)(F.ws + WS_Z); const bf16* U = (const bf16*)(F.ws + WS_U); bf16* MIX = (bf16*)(F.ws + ((L & 1) ? WS_BUFA : WS_BUFB));
    LAS float* sc = (LAS float*)F.lds + F.wave * 2048;
    const int gw = F.vcu * NWAVES + F.wave, NGW = F.G * NWAVES;
    for (int it = gw; it < T * 4; it += NGW) {
        const int row = it >> 2, h = it & 3, b = row >> 11, sq = row & 2047, cq = sq >> 6;
        const int nk = (cq + 1) * 64;
        const bf16* qn = U + (size_t)row * DUP + UC_QN + 128 * h; const bf16* qr = U + (size_t)row * DUP + UC_QR + 64 * h;
        float mx = -1e30f;
        for (int k0 = 0; k0 < nk; k0 += 64) {
            const int key = b * SEQ + k0 + F.lane;
            const bf16* kn = U + (size_t)key * DUP + UC_KN + 128 * h; const bf16* kr = Z + (size_t)key * DINP + ZC_KR;
            float d = 0.f;
            for (int c = 0; c < 16; ++c) { float a[8], f[8]; unpack8(*(const v4u*)(qn + 8 * c), a); unpack8(*(const v4u*)(kn + 8 * c), f);
#pragma unroll
                for (int e = 0; e < 8; ++e) d += a[e] * f[e]; }
            for (int c = 0; c < 8; ++c) { float a[8], f[8]; unpack8(*(const v4u*)(qr + 8 * c), a); unpack8(*(const v4u*)(kr + 8 * c), f);
#pragma unroll
                for (int e = 0; e < 8; ++e) d += a[e] * f[e]; }
            sc[k0 + F.lane] = d; mx = fmaxf(mx, d);
        }
        mx = wave_max(mx); float l = 0.f;
        for (int k0 = 0; k0 < nk; k0 += 64) { const float pv = exp2f(sc[k0 + F.lane] - mx); l += pv; sc[k0 + F.lane] = pv; }
        l = wave_sum(l);
        asm volatile("s_waitcnt lgkmcnt(0)" ::: "memory");
        float o0 = 0.f, o1 = 0.f;
        const bf16* vp = U + (size_t)(b * SEQ) * DUP + UC_V + 128 * h + F.lane;
        for (int k = 0; k < nk; ++k) { const float pv = sc[k]; o0 += pv * bf2f(vp[(size_t)k * DUP]); o1 += pv * bf2f(vp[(size_t)k * DUP + 64]); }
        const float g0 = bf2f(Z[(size_t)row * DINP + ZC_GB + 128 * h + F.lane]), g1 = bf2f(Z[(size_t)row * DINP + ZC_GB + 128 * h + 64 + F.lane]);
        MIX[(size_t)row * DM + 512 + 128 * h + F.lane] = (bf16)f2bf(o0 / l * g0);
        MIX[(size_t)row * DM + 512 + 128 * h + 64 + F.lane] = (bf16)f2bf(o1 / l * g1);
        asm volatile("s_waitcnt lgkmcnt(0)" ::: "memory");
    }
}

#if MK_ABSORB
__device__ __forceinline__ void naive_attn_b_abs(const Frame& F, int L) {
    const bf16* Z = (const bf16*)(F.ws + WS_Z); const bf16* U = (const bf16*)(F.ws + WS_U); const bf16* CK = (const bf16*)(F.ws + WS_CKVN); bf16* MIX = (bf16*)(F.ws + ((L & 1) ? WS_BUFA : WS_BUFB));
    const float* wukv = inp<9>(F) + (size_t)L * 128 * 1024;
    LAS float* sc = (LAS float*)F.lds + F.wave * 2304;
    const int gw = F.vcu * NWAVES + F.wave, NGW = F.G * NWAVES;
    for (int it = gw; it < T * 4; it += NGW) {
        const int row = it >> 2, h = it & 3, b = row >> 11, sq = row & 2047, cq = sq >> 6;
        const int nk = (cq + 1) * 64;
        const bf16* ql = U + (size_t)row * DUP + UC_QN + 128 * h; const bf16* qr = U + (size_t)row * DUP + UC_QR + 64 * h;
        float mx = -1e30f;
        for (int k0 = 0; k0 < nk; k0 += 64) {
            const int key = b * SEQ + k0 + F.lane;
            const bf16* kn = CK + (size_t)key * 128; const bf16* kr = Z + (size_t)key * DINP + ZC_KR;
            float d = 0.f;
            for (int c = 0; c < 16; ++c) { float a[8], f[8]; unpack8(*(const v4u*)(ql + 8 * c), a); unpack8(*(const v4u*)(kn + 8 * c), f);
#pragma unroll
                for (int e = 0; e < 8; ++e) d += a[e] * f[e]; }
            for (int c = 0; c < 8; ++c) { float a[8], f[8]; unpack8(*(const v4u*)(qr + 8 * c), a); unpack8(*(const v4u*)(kr + 8 * c), f);
#pragma unroll
                for (int e = 0; e < 8; ++e) d += a[e] * f[e]; }
            sc[k0 + F.lane] = d; mx = fmaxf(mx, d);
        }
        mx = wave_max(mx); float l = 0.f;
        for (int k0 = 0; k0 < nk; k0 += 64) { const float pv = exp2f(sc[k0 + F.lane] - mx); l += pv; sc[k0 + F.lane] = pv; }
        l = wave_sum(l);
        asm volatile("s_waitcnt lgkmcnt(0)" ::: "memory");
        float o0 = 0.f, o1 = 0.f;
        const bf16* vp = CK + (size_t)(b * SEQ) * 128 + F.lane;
        for (int k = 0; k < nk; ++k) { const float pv = sc[k]; o0 += pv * bf2f(vp[(size_t)k * 128]); o1 += pv * bf2f(vp[(size_t)k * 128 + 64]); }
        asm volatile("s_waitcnt lgkmcnt(0)" ::: "memory");
        sc[2048 + F.lane] = bf2f(f2bf(o0 / l)); sc[2048 + 64 + F.lane] = bf2f(f2bf(o1 / l));
        asm volatile("s_waitcnt lgkmcnt(0)" ::: "memory");
        float y0 = 0.f, y1 = 0.f;
        for (int lat = 0; lat < 128; ++lat) { const float ol = sc[2048 + lat]; const float* wr = wukv + (size_t)lat * 1024 + h * 256 + 128;
            y0 += ol * bf2f(f2bf(wr[F.lane])); y1 += ol * bf2f(f2bf(wr[64 + F.lane])); }
        const float g0 = bf2f(Z[(size_t)row * DINP + ZC_GB + 128 * h + F.lane]), g1 = bf2f(Z[(size_t)row * DINP + ZC_GB + 128 * h + 64 + F.lane]);
        MIX[(size_t)row * DM + 512 + 128 * h + F.lane] = (bf16)f2bf(y0 * g0);
        MIX[(size_t)row * DM + 512 + 128 * h + 64 + F.lane] = (bf16)f2bf(y1 * g1);
        asm volatile("s_waitcnt lgkmcnt(0)" ::: "memory");
    }
}
#endif
namespace pg8 {
#define PG8_LAS __attribute__((address_space(3)))
constexpr int BM = 256, BK = 64, HALF = 128, HTB = HALF * BK * 2, STAGE_BYTES = 8 * HTB, NXCD = 8, WGM = 8;
__host__ __device__ __forceinline__ int lds_byte(int r, int c) { const int st = (r >> 4) * 2 + (c >> 5), rr = r & 15, cc = c & 31, ob = rr * 64 + cc * 2; return st * 1024 + (ob ^ (((ob >> 9) & 1) << 5)); }
__host__ __device__ __forceinline__ void stage_rc(int b, int& R, int& C) { const int st = b / 1024, sb = b % 1024, swz = sb ^ (((sb >> 9) & 1) << 5); R = (st >> 1) * 16 + swz / 64; C = (st & 1) * 32 + (swz % 64) / 2; }
__host__ __device__ __forceinline__ int perm32(int rho) { const int n = rho >> 4, i = rho & 15; return 8 * (i >> 2) + 4 * n + (i & 3); }
struct Unit { int pm, pn; };
struct Gemm { const bf16* A; int lda; const bf16* Bt; int M, N, K; int ks_pn, ks_nt0; };
struct StaticOrder {
    int nM, nN, nwg, G, c;
    __device__ void init(int M, int N, int G_, int c_) { nM = M / BM; nN = N / BM; nwg = nM * nN; G = G_; c = c_; }
    __device__ bool next(int i, Unit& u) const {
        const long L = (long)i * G + c; if (L >= nwg) return false;
        int wgid = (int)L; { const int q = nwg / NXCD, r = nwg % NXCD, xcd = wgid % NXCD, off = wgid / NXCD; wgid = (xcd < r ? xcd * (q + 1) : r * (q + 1) + (xcd - r) * q) + off; }
        const int nig = WGM * nN, gid = wgid / nig, fm = gid * WGM, gsz = (nM - fm) < WGM ? (nM - fm) : WGM;
        u.pm = fm + ((wgid % nig) % gsz); u.pn = (wgid % nig) / gsz; return true;
    }
};
template <class EP> struct FastEpi {
    EP e;
    __device__ __forceinline__ void operator()(const f32x4 (&acc)[2][2][4][2], const Unit& u_, int wr, int wc, int fr, int fq) const {
        constexpr int NB = EP::NB;
        Unit u; u.pm = opaque_i(u_.pm); u.pn = opaque_i(u_.pn);
        const int colt = u.pn * BM + wc * 32 + 8 * fq;
        typename EP::ColPre cp[2] = {e.colpre(colt), e.colpre(colt + HALF)};
#pragma unroll
        for (int ai = 0; ai < 2; ++ai)
#pragma unroll
            for (int mp = 0; mp < 4 / NB; ++mp) {
                float part[NB]; typename EP::Pre pre[NB][2];
#pragma unroll
                for (int mm = 0; mm < NB; ++mm) {
                    const int row = u.pm * BM + ai * HALF + wr * 64 + (NB * mp + mm) * 16 + fr;
                    part[mm] = e.rowsum_part(row, fq, u.pn * BM);
#pragma unroll
                    for (int bj = 0; bj < 2; ++bj) pre[mm][bj] = e.pre8(row, colt + bj * HALF);
                }
#pragma unroll
                for (int mm = 0; mm < NB; ++mm) {
                    const int m = NB * mp + mm, row = u.pm * BM + ai * HALF + wr * 64 + m * 16 + fr;
                    float pt = part[mm]; pt += __shfl_xor(pt, 16); pt += __shfl_xor(pt, 32);
                    const float rs = e.rowscale_from(pt, u.pn * BM);
#pragma unroll
                    for (int bj = 0; bj < 2; ++bj) {
                        float v[8] = {acc[ai][bj][m][0][0], acc[ai][bj][m][0][1], acc[ai][bj][m][0][2], acc[ai][bj][m][0][3], acc[ai][bj][m][1][0], acc[ai][bj][m][1][1], acc[ai][bj][m][1][2], acc[ai][bj][m][1][3]};
                        float s = e.run8(row, colt + bj * HALF, rs, v, pre[mm][bj], cp[bj]);
                        if (EP::HAS_SSQ) { s += __shfl_xor(s, 16); s += __shfl_xor(s, 32); if (fq == 0) e.ssq(row, (u.pn * BM + bj * HALF + wc * 32) >> 5, s); }
                    }
                }
            }
    }
};

struct FinalEpi {
    float* out; unsigned char* ws; const float* bias; const float* gfin;
    __device__ __forceinline__ void operator()(f32x4 (&acc)[2][2][4][2], const Unit& u, int wr, int wc, int fr, int fq) const {
        asm volatile("" : "+v"(fr), "+v"(fq));
        const bf16* hin = (const bf16*)(ws + (((DEPTH - 1) & 1) ? WS_BUFB : WS_BUFA)); const bf16* lin = (const bf16*)(ws + WS_LO1); const bf16* PE = (const bf16*)(ws + WS_Z); const float* ssq_i = (const float*)(ws + WS_SSQ1); float* ssq_x = (float*)(ws + WS_SSQ2);
        unsigned* cnt = (unsigned*)(ws + WS_CTL) + 16384;
        const int colt = u.pn * BM + wc * 32 + 8 * fq;
#pragma unroll
        for (int ai = 0; ai < 2; ++ai)
#pragma unroll
            for (int m = 0; m < 4; ++m) {
                const int row = u.pm * BM + ai * HALF + wr * 64 + m * 16 + fr;
                const f32x4* sp = (const f32x4*)(ssq_i + (size_t)row * 32 + fq * 8); const f32x4 s0 = sp[0], s1 = sp[1];
                float pt = ((s0.x + s0.y) + (s0.z + s0.w)) + ((s1.x + s1.y) + (s1.z + s1.w)); pt += __shfl_xor(pt, 16); pt += __shfl_xor(pt, 32);
                const float rs = rsqrtf(pt * (1.0f / DM) + EPS);
#pragma unroll
                for (int bj = 0; bj < 2; ++bj) {
                    const size_t off = (size_t)row * DM + colt + bj * HALF;
                    const v4u hhi = *(const v4u*)(hin + off), hlo = MK_LO ? *(const v4u*)(lin + off) : (v4u){0u, 0u, 0u, 0u}; const v4u pe = *(const v4u*)(PE + off);
                    const f32x4 b0 = *(const f32x4*)(bias + colt + bj * HALF), b1 = *(const f32x4*)(bias + colt + bj * HALF + 4);
                    float hj[8]; join8(hhi, hlo, hj);
                    const f32x4 ha = (f32x4){hj[0], hj[1], hj[2], hj[3]}, hb_ = (f32x4){hj[4], hj[5], hj[6], hj[7]};
                    float pv[8]; unpack8(pe, pv);
                    f32x4 v0 = acc[ai][bj][m][0], v1 = acc[ai][bj][m][1];
                    v0.x = ha.x + pv[0] * sigmoid_f(v0.x * rs + b0.x); v0.y = ha.y + pv[1] * sigmoid_f(v0.y * rs + b0.y);
                    v0.z = ha.z + pv[2] * sigmoid_f(v0.z * rs + b0.z); v0.w = ha.w + pv[3] * sigmoid_f(v0.w * rs + b0.w);
                    v1.x = hb_.x + pv[4] * sigmoid_f(v1.x * rs + b1.x); v1.y = hb_.y + pv[5] * sigmoid_f(v1.y * rs + b1.y);
                    v1.z = hb_.z + pv[6] * sigmoid_f(v1.z * rs + b1.z); v1.w = hb_.w + pv[7] * sigmoid_f(v1.w * rs + b1.w);
                    acc[ai][bj][m][0] = v0; acc[ai][bj][m][1] = v1;
                    float ss = ((v0.x * v0.x + v0.y * v0.y) + (v0.z * v0.z + v0.w * v0.w)) + ((v1.x * v1.x + v1.y * v1.y) + (v1.z * v1.z + v1.w * v1.w));
                    ss += __shfl_xor(ss, 16); ss += __shfl_xor(ss, 32);
                    if (fq == 0) __hip_atomic_store(ssq_x + (size_t)row * 32 + ((u.pn * BM + bj * HALF + wc * 32) >> 5), ss, __ATOMIC_RELAXED, __HIP_MEMORY_SCOPE_AGENT);
                    asm volatile("" ::: "memory");
                }
                asm volatile("" ::: "memory");
            }
        asm volatile("s_waitcnt vmcnt(0)" ::: "memory");
        __builtin_amdgcn_s_barrier(); asm volatile("" ::: "memory");
        if (wr == 0 && wc == 0) {
            unsigned* c = cnt + 64 * u.pm;
            if (fr == 0 && fq == 0) __hip_atomic_fetch_add(c, 1u, __ATOMIC_RELAXED, __HIP_MEMORY_SCOPE_AGENT);
            unsigned sp_ = 0;
            while ((unsigned)__builtin_amdgcn_readfirstlane((int)__hip_atomic_load(c, __ATOMIC_RELAXED, __HIP_MEMORY_SCOPE_AGENT)) < 4u) { __builtin_amdgcn_s_sleep(2); if (++sp_ > (1u << 20)) break; }
            __builtin_amdgcn_fence(__ATOMIC_ACQUIRE, "agent");
            asm volatile("s_waitcnt vmcnt(0)" ::: "memory");
        }
        __builtin_amdgcn_s_barrier(); asm volatile("" ::: "memory");
#pragma unroll
        for (int ai = 0; ai < 2; ++ai)
#pragma unroll
            for (int m = 0; m < 4; ++m) {
                const int row = u.pm * BM + ai * HALF + wr * 64 + m * 16 + fr;
                const f32x4* sp = (const f32x4*)(ssq_x + (size_t)row * 32 + fq * 8); const f32x4 s0 = sp[0], s1 = sp[1];
                float pt = ((s0.x + s0.y) + (s0.z + s0.w)) + ((s1.x + s1.y) + (s1.z + s1.w)); pt += __shfl_xor(pt, 16); pt += __shfl_xor(pt, 32);
                const float r = rsqrtf(pt * (1.0f / DM) + EPS);
#pragma unroll
                for (int bj = 0; bj < 2; ++bj) { const size_t off = (size_t)row * DM + colt + bj * HALF;
                    const f32x4 g0 = *(const f32x4*)(gfin + colt + bj * HALF), g1 = *(const f32x4*)(gfin + colt + bj * HALF + 4);
                    *(f32x4*)(out + off) = acc[ai][bj][m][0] * r * g0; *(f32x4*)(out + off + 4) = acc[ai][bj][m][1] * r * g1; }
                if (m & 1) asm volatile("" ::: "memory");
            }
    }
};

template <class Epi>
__device__ __forceinline__ void gemm_phase(PG8_LAS unsigned char* lds, const int tid, const Gemm g, const StaticOrder& S, const Epi& E) {
    const int wid = __builtin_amdgcn_readfirstlane(tid >> 6), lane = tid & 63, wr = wid >> 2, wc = wid & 3, fr = lane & 15, fq = lane >> 4;
    const int K = g.K, ntK = K / BK, lda = g.lda;
#define PG8_NT(u) (((u).pn < g.ks_pn) ? g.ks_nt0 : ntK - g.ks_nt0)
#define PG8_KOFF(u) (((u).pn < g.ks_pn) ? (size_t)0 : (size_t)g.ks_nt0 * kstep)
    unsigned voffA[2], voffB[2];
#pragma unroll
    for (int i = 0; i < 2; ++i) { int R, C; stage_rc(tid * 16 + i * 8192, R, C); const int Rb = (R & ~31) + perm32(R & 31);
        voffA[i] = (unsigned)(R * lda + C) * 2u; voffB[i] = (unsigned)(Rb * K + C) * 2u; }
    const size_t kstep = (size_t)(BK * 2);
    const size_t hstepA = (size_t)HALF * lda * 2, hstepB = (size_t)HALF * K * 2;
    const size_t tstepA = 2 * hstepA, tstepB = 2 * hstepB;
    const unsigned ldsw = (unsigned)wid * 1024u;
    const int aoff = lds_byte(wr * 64 + fr, fq * 8), boff = lds_byte(wc * 32 + fr, fq * 8);
#define PG8_SA(b, h) (((b) * 2 + (h)) * HTB)
#define PG8_SB(b, h) ((4 + (b) * 2 + (h)) * HTB)
#define PG8_STAGE(bufoff, gbase, voff) do { _Pragma("unroll") for (int _i = 0; _i < 2; ++_i) \
        __builtin_amdgcn_global_load_lds((const unsigned*)((const char*)(gbase) + (voff)[_i]), (PG8_LAS unsigned*)(lds + (bufoff) + ldsw + _i * 8192), 16, 0, 0); } while (0)
#define PG8_LDA(dst, b, h) do { _Pragma("unroll") for (int m = 0; m < 4; ++m) _Pragma("unroll") for (int k = 0; k < 2; ++k) dst[m][k] = *(const PG8_LAS bf16x8*)(lds + PG8_SA(b, h) + aoff + m * 2048 + k * 1024); } while (0)
#define PG8_LDB(dst, b, h) do { _Pragma("unroll") for (int n = 0; n < 2; ++n) _Pragma("unroll") for (int k = 0; k < 2; ++k) dst[n][k] = *(const PG8_LAS bf16x8*)(lds + PG8_SB(b, h) + boff + n * 2048 + k * 1024); } while (0)
#define PG8_MMA(ai, bj, At, Bt) do { __builtin_amdgcn_s_setprio(1); _Pragma("unroll") for (int m = 0; m < 4; ++m) _Pragma("unroll") for (int n = 0; n < 2; ++n) _Pragma("unroll") for (int k = 0; k < 2; ++k) \
        acc[ai][bj][m][n] = __builtin_amdgcn_mfma_f32_16x16x32_bf16(Bt[n][k], At[m][k], acc[ai][bj][m][n], 0, 0, 0); __builtin_amdgcn_s_setprio(0); } while (0)
#define PG8_WAIT_V(n) asm volatile("s_waitcnt vmcnt(" #n ")" ::: "memory")
#define PG8_WAIT_L(n) asm volatile("s_waitcnt lgkmcnt(" #n ")" ::: "memory")
#define PG8_BAR __builtin_amdgcn_s_barrier()
#define PG8_SCHED __builtin_amdgcn_sched_barrier(0)
    Unit cur, nxt; int ui = 0;
    if (!S.next(0, cur)) return;
    f32x4 acc[2][2][4][2];
#pragma unroll
    for (int a = 0; a < 2; ++a)
#pragma unroll
        for (int b = 0; b < 2; ++b)
#pragma unroll
            for (int m = 0; m < 4; ++m)
#pragma unroll
                for (int n = 0; n < 2; ++n) acc[a][b][m][n] = (f32x4){0.f, 0.f, 0.f, 0.f};
    bf16x8 At[4][2], B0[2][2], B1[2][2];
    const char* cA = (const char*)g.A + (size_t)cur.pm * tstepA + PG8_KOFF(cur); const char* cB = (const char*)g.Bt + (size_t)cur.pn * tstepB + PG8_KOFF(cur);
    int nt = PG8_NT(cur);
    PG8_STAGE(PG8_SB(0, 0), cB, voffB); PG8_STAGE(PG8_SB(0, 1), cB + hstepB, voffB); PG8_STAGE(PG8_SA(0, 0), cA, voffA); PG8_STAGE(PG8_SA(0, 1), cA + hstepA, voffA);
    if (wr == 1) PG8_BAR;
    PG8_WAIT_V(2); PG8_BAR;
    PG8_STAGE(PG8_SB(1, 0), cB + kstep, voffB); PG8_STAGE(PG8_SA(1, 0), cA + kstep, voffA); PG8_STAGE(PG8_SB(1, 1), cB + hstepB + kstep, voffB);
    PG8_WAIT_V(6); PG8_BAR;
    for (;;) {
        const bool has_next = S.next(ui + 1, nxt);
        const char* nA = has_next ? (const char*)g.A + (size_t)nxt.pm * tstepA + PG8_KOFF(nxt) : cA; const char* nB = has_next ? (const char*)g.Bt + (size_t)nxt.pn * tstepB + PG8_KOFF(nxt) : cB;
#pragma unroll 1
        for (int t = 0; t < nt; t += 2) {
            const bool last = (t == nt - 2);
            const char* a1 = cA + (size_t)(t + 1) * kstep;
            const char* a2 = last ? nA : cA + (size_t)(t + 2) * kstep; const char* b2 = last ? nB : cB + (size_t)(t + 2) * kstep;
            const char* a3 = a2 + kstep; const char* b3 = b2 + kstep;
            PG8_LDB(B0, 0, 0); PG8_LDB(B1, 0, 1); PG8_SCHED; PG8_LDA(At, 0, 0); PG8_STAGE(PG8_SA(1, 1), a1 + hstepA, voffA);
            PG8_WAIT_V(8); PG8_WAIT_L(0); PG8_BAR; PG8_MMA(0, 0, At, B0); PG8_MMA(0, 1, At, B1); PG8_BAR; PG8_SCHED;
            PG8_LDA(At, 0, 1); PG8_STAGE(PG8_SB(0, 0), b2, voffB); PG8_STAGE(PG8_SB(0, 1), b2 + hstepB, voffB); PG8_STAGE(PG8_SA(0, 0), a2, voffA);
            PG8_WAIT_V(8); PG8_WAIT_L(0); PG8_BAR; PG8_MMA(1, 0, At, B0); PG8_MMA(1, 1, At, B1); PG8_BAR; PG8_SCHED;
            PG8_LDB(B0, 1, 0); PG8_LDB(B1, 1, 1); PG8_SCHED; PG8_LDA(At, 1, 0); PG8_STAGE(PG8_SA(0, 1), a2 + hstepA, voffA);
            PG8_WAIT_V(8); PG8_WAIT_L(0); PG8_BAR; PG8_MMA(0, 0, At, B0); PG8_MMA(0, 1, At, B1); PG8_BAR; PG8_SCHED;
            PG8_LDA(At, 1, 1); PG8_STAGE(PG8_SB(1, 0), b3, voffB); PG8_STAGE(PG8_SB(1, 1), b3 + hstepB, voffB); PG8_STAGE(PG8_SA(1, 0), a3, voffA);
            PG8_WAIT_V(8); PG8_WAIT_L(0); PG8_BAR; PG8_MMA(1, 0, At, B0); PG8_MMA(1, 1, At, B1); PG8_BAR; PG8_SCHED;
        }
        if (wr == 0) PG8_BAR;
        E(acc, cur, wr, wc, fr, fq);
        if (!has_next) break;
#pragma unroll
        for (int a = 0; a < 2; ++a)
#pragma unroll
            for (int b = 0; b < 2; ++b)
#pragma unroll
                for (int m = 0; m < 4; ++m)
#pragma unroll
                    for (int n = 0; n < 2; ++n) acc[a][b][m][n] = (f32x4){0.f, 0.f, 0.f, 0.f};
        cur = nxt; cA = nA; cB = nB; ++ui; nt = PG8_NT(cur);
        if (wr == 1) PG8_BAR;
    }
    PG8_WAIT_V(0);
    PG8_BAR;
#undef PG8_NT
#undef PG8_KOFF
#undef PG8_SA
#undef PG8_SB
#undef PG8_STAGE
#undef PG8_LDA
#undef PG8_LDB
#undef PG8_MMA
#undef PG8_WAIT_V
#undef PG8_WAIT_L
#undef PG8_BAR
#undef PG8_SCHED
}
}
template <class EP> __device__ __forceinline__ void fast_gemm(const Frame& F, const bf16* A, int lda, const bf16* Bt, int K, int N, const EP& E, int ks_pn = 0, int ks_nt0 = 0, int deal = -1) {
    pg8::Gemm g{A, lda, Bt, T, N, K, ks_pn, ks_nt0}; pg8::StaticOrder S; S.init(T, N, F.G, deal >= 0 ? deal : F.bx);
    pg8::FastEpi<EP> FE{E};
    pg8::gemm_phase<pg8::FastEpi<EP>>(F.lds, F.tid, g, S, FE);
}
namespace fa {
typedef __attribute__((address_space(3))) const char* lds_cptr;
typedef short v4i16_t __attribute__((ext_vector_type(4)));
__device__ __forceinline__ s16x4 vtr(lds_cptr p) { return __builtin_bit_cast(s16x4, __builtin_amdgcn_ds_read_tr16_b64_v4i16((LAS v4i16_t*)p)); }
__device__ __forceinline__ float half_max(float v) { auto rr = __builtin_amdgcn_permlane32_swap(__float_as_uint(v), __float_as_uint(v), false, false); return fmaxf(__uint_as_float(rr[0]), __uint_as_float(rr[1])); }
__device__ __forceinline__ float half_sum(float v) { auto rr = __builtin_amdgcn_permlane32_swap(__float_as_uint(v), __float_as_uint(v), false, false); return __uint_as_float(rr[0]) + __uint_as_float(rr[1]); }
__device__ __forceinline__ bf16x8 packp(const f32x16& p, int b) { v4u w; w.x = pk2(p[b], p[b + 1]); w.y = pk2(p[b + 2], p[b + 3]); w.z = pk2(p[b + 4], p[b + 5]); w.w = pk2(p[b + 6], p[b + 7]); return __builtin_bit_cast(bf16x8, w); }

struct NoHook { __device__ __forceinline__ void operator()() const {} };
template <int NS, int KPITCH, int NG = 0, class Hook = NoHook>
__device__ __forceinline__ void qk_half(f32x16& p, const bf16x8 (&qf)[NS - NG], const bf16* qg, lds_cptr kb  , const Hook& hook = Hook()) {
    constexpr int PF = MK_KPF, RING = PF + 1;
    bf16x8 kr[RING];
    bf16x8 qr[NG > 0 ? NG : 1];
#pragma unroll
    for (int s = 0; s < NG; ++s) qr[s] = *(const bf16x8*)(qg + 16 * s);
    hook();
#pragma unroll
    for (int s = 0; s < PF; ++s) kr[s] = *(const LAS bf16x8*)(kb + s * 32);
#pragma unroll
    for (int s = 0; s < NS; ++s) {
        if (s + PF < NS) kr[(s + PF) % RING] = *(const LAS bf16x8*)(kb + (s + PF) * 32);
        p = __builtin_amdgcn_mfma_f32_32x32x16_bf16(kr[s % RING], (s < NS - NG) ? qf[s < NS - NG ? s : 0] : qr[s >= NS - NG ? s - (NS - NG) : 0], p, 0, 0, 0);
        __builtin_amdgcn_sched_barrier(0);
    }
}
__device__ __forceinline__ bf16x8 vfrag(lds_cptr vb, int i) {
    const int off = (i >> 1) * 4096 + (i & 1) * 1024;
    const s16x4 lo = vtr(vb + off), hh = vtr(vb + off + 512);
    return (bf16x8){lo[0], lo[1], lo[2], lo[3], hh[0], hh[1], hh[2], hh[3]};
}
template <int ND>
__device__ __forceinline__ void pv_plain(f32x16 (&o)[ND], const bf16x8 (&pf)[2], lds_cptr vb) {
    constexpr int NM = ND * 2;
    bf16x8 vr[3]; vr[0] = vfrag(vb, 0); vr[1] = vfrag(vb, 1);
#pragma unroll
    for (int i = 0; i < NM; ++i) {
        if (i + 2 < NM) vr[(i + 2) % 3] = vfrag(vb, i + 2);
        o[i >> 1] = __builtin_amdgcn_mfma_f32_32x32x16_bf16(vr[i % 3], pf[i & 1], o[i >> 1], 0, 0, 0);
        __builtin_amdgcn_sched_barrier(0);
    }
}
template <int NS, int ND, int KPITCH, class LK>
__device__ __forceinline__ void half_step_nm(f32x16& p, const bf16x8 (&qf)[NS], f32x16 (&o)[ND], float& m, float& l, bf16x8 (&pf)[2], bool& pend, bool& fresh, f32x16& cinit, const float cbias, const bool cst, const LK& lookup, lds_cptr kb, lds_cptr vprev) {
    constexpr int NM = ND * 2;
    {
        bf16x8 kr[NS];
#pragma unroll
        for (int s = 0; s < NS; ++s) kr[s] = *(const LAS bf16x8*)(kb + s * 32);
        if (cst) p = __builtin_amdgcn_mfma_f32_32x32x16_bf16(kr[0], qf[0], cinit, 0, 0, 0);
        else { f32x16 t; lookup(t); p = __builtin_amdgcn_mfma_f32_32x32x16_bf16(kr[0], qf[0], t, 0, 0, 0); }
        __builtin_amdgcn_sched_barrier(0);
#pragma unroll
        for (int s = 1; s < NS; ++s) { p = __builtin_amdgcn_mfma_f32_32x32x16_bf16(kr[s], qf[s], p, 0, 0, 0); __builtin_amdgcn_sched_barrier(0); }
    }
    float mx = p[0];
#pragma unroll
    for (int r = 1; r < 16; ++r) mx = fmaxf(mx, p[r]);
    mx = half_max(mx);
    if (fresh || !__all(mx <= 6.0f)) {
        if (pend) { pv_plain<ND>(o, pf, vprev); pend = false; }
        const float delta = fresh ? mx : fmaxf(mx, 0.f);
        const float alpha = fresh ? 1.0f : __builtin_amdgcn_exp2f(-delta);
        m += delta; l *= alpha;
#pragma unroll
        for (int d = 0; d < ND; ++d)
#pragma unroll
            for (int r = 0; r < 16; ++r) o[d][r] *= alpha;
        const float cm = cbias - m;
#pragma unroll
        for (int r = 0; r < 16; ++r) { p[r] -= delta; cinit[r] = cm; }
        fresh = false;
    }
    bf16x8 pfn[2];
    float rs = 0.f;
    if (pend) {
        constexpr int EPM = 16 / NM;
        bf16x8 vr[3]; vr[0] = vfrag(vprev, 0); vr[1] = vfrag(vprev, 1);
#pragma unroll
        for (int i = 0; i < NM; ++i) {
            if (i + 2 < NM) vr[(i + 2) % 3] = vfrag(vprev, i + 2);
            o[i >> 1] = __builtin_amdgcn_mfma_f32_32x32x16_bf16(vr[i % 3], pf[i & 1], o[i >> 1], 0, 0, 0);
#pragma unroll
            for (int e = 0; e < EPM; ++e) { const int idx = i * EPM + e; p[idx] = __builtin_amdgcn_exp2f(p[idx]); rs += p[idx]; }
            if (((i + 1) * EPM) % 8 == 0) { const int k = ((i + 1) * EPM) / 8 - 1; pfn[k] = packp(p, 8 * k); }
            __builtin_amdgcn_sched_barrier(0);
        }
    } else {
#pragma unroll
        for (int r = 0; r < 16; ++r) { p[r] = __builtin_amdgcn_exp2f(p[r]); rs += p[r]; }
        pfn[0] = packp(p, 0); pfn[1] = packp(p, 8);
    }
    l += rs;
    pf[0] = pfn[0]; pf[1] = pfn[1];
    pend = true;
}
__device__ __forceinline__ float max3f(float a, float b, float c) { float r; asm("v_max3_f32 %0, %1, %2, %3" : "=v"(r) : "v"(a), "v"(b), "v"(c)); return r; }
struct NoLookup { __device__ __forceinline__ void operator()(f32x16&) const {} };
template <int NS, int ND, int KPITCH, bool LKUP, bool NEGM, class LK>
__device__ __forceinline__ void half_step_sp(f32x16& pn, f32x16& pp, const bf16x8 (&qf)[NS], f32x16 (&o)[ND], float& m, float& l, bool& fresh, f32x16& cinit, const float cbias, const bool cst, const LK& lookup, lds_cptr kb, lds_cptr vprev) {
    constexpr int NM = ND * 2;
    constexpr int PF = (NS > 4) ? MK_SPKPF : NS, RING = (NS > 4) ? PF + 1 : NS;
    constexpr int EG = (NS >= 8) ? 2 : 16 / NS;
    unsigned pw[8];
    {
        bf16x8 kr[RING];
#pragma unroll
        for (int s = 0; s < PF; ++s) kr[s] = *(const LAS bf16x8*)(kb + s * 32);
#pragma unroll
        for (int s = 0; s < NS; ++s) {
            if (s + PF < NS) kr[(s + PF) % RING] = *(const LAS bf16x8*)(kb + (s + PF) * 32);
            if (s == 0) {
                if (!NEGM) pn = __builtin_amdgcn_mfma_f32_32x32x16_bf16(kr[0], qf[0], (f32x16){}, 0, 0, 0);
                else if (!LKUP || cst) pn = __builtin_amdgcn_mfma_f32_32x32x16_bf16(kr[0], qf[0], cinit, 0, 0, 0);
                else { f32x16 t; lookup(t); bf16x8 k0 = kr[0], q0 = qf[0]; asm volatile("" : "+v"(k0), "+v"(q0));
                    pn = __builtin_amdgcn_mfma_f32_32x32x16_bf16(k0, q0, t, 0, 0, 0); }
            } else pn = __builtin_amdgcn_mfma_f32_32x32x16_bf16(kr[s % RING], qf[s], pn, 0, 0, 0);
            if (s * EG < 16) {
#pragma unroll
                for (int e = 0; e < EG; ++e) { const int i = s * EG + e; float x = __builtin_amdgcn_exp2f(NEGM ? pp[i] : pp[i] - m); asm volatile("" : "+v"(x)); pp[i] = x; }
#pragma unroll
                for (int e = 0; e < EG; e += 2) { const int i = s * EG + e; unsigned w = pk2(pp[i], pp[i + 1]); asm volatile("" : "+v"(w)); pw[i >> 1] = w; }
            }
            __builtin_amdgcn_sched_barrier(0);
        }
    }
    const bf16x8 pf0 = __builtin_bit_cast(bf16x8, (v4u){pw[0], pw[1], pw[2], pw[3]}), pf1 = __builtin_bit_cast(bf16x8, (v4u){pw[4], pw[5], pw[6], pw[7]});
    float rs = 0.f, mx = pn[0];
    {
        constexpr int AG = 16 / NM;
        bf16x8 vr[3]; vr[0] = vfrag(vprev, 0); vr[1] = vfrag(vprev, 1);
#pragma unroll
        for (int i = 0; i < NM; ++i) {
            if (i + 2 < NM) vr[(i + 2) % 3] = vfrag(vprev, i + 2);
            o[i >> 1] = __builtin_amdgcn_mfma_f32_32x32x16_bf16(vr[i % 3], (i & 1) ? pf1 : pf0, o[i >> 1], 0, 0, 0);
#pragma unroll
            for (int e = 0; e < AG; ++e) rs += pp[i * AG + e];
            asm volatile("" : "+v"(rs));
#pragma unroll
            for (int e = 0; e < AG; e += 2) mx = max3f(mx, pn[i * AG + e], pn[i * AG + e + 1]);
            asm volatile("" : "+v"(mx));
            __builtin_amdgcn_sched_barrier(0);
        }
    }
    l += rs;
    mx = half_max(mx);
    if (!NEGM) {
        if (!__all(mx <= m + 6.0f)) {
            const float mn = fmaxf(m, mx);
            const float alpha = __builtin_amdgcn_exp2f(m - mn);
            m = mn; l *= alpha;
#pragma unroll
            for (int d = 0; d < ND; ++d)
#pragma unroll
                for (int r = 0; r < 16; ++r) o[d][r] *= alpha;
        }
    } else if (fresh || !__all(mx <= 6.0f)) {
        const float delta = fresh ? mx : fmaxf(mx, 0.f);
        const float alpha = fresh ? 1.0f : __builtin_amdgcn_exp2f(-delta);
        m += delta; l *= alpha;
#pragma unroll
        for (int d = 0; d < ND; ++d)
#pragma unroll
            for (int r = 0; r < 16; ++r) o[d][r] *= alpha;
        const float cm = cbias - m;
#pragma unroll
        for (int r = 0; r < 16; ++r) { pn[r] -= delta; cinit[r] = cm; }
        fresh = false;
    }
}
template <int ND>
__device__ __forceinline__ void flush_sp(f32x16& pp, f32x16 (&o)[ND], float& l, lds_cptr vprev, const float msub = 0.f) {
    float rs = 0.f;
#pragma unroll
    for (int r = 0; r < 16; ++r) { pp[r] = __builtin_amdgcn_exp2f(pp[r] - msub); rs += pp[r]; }
    bf16x8 pf[2]; pf[0] = packp(pp, 0); pf[1] = packp(pp, 8);
    pv_plain<ND>(o, pf, vprev);
    l += rs;
}
template <int NS, int ND, int KPITCH, int NG = 0, bool ILV = false, class Hook = NoHook>
__device__ __forceinline__ void half_step(f32x16& p, const bf16x8 (&qf)[NS - NG], const bf16* qg, f32x16 (&o)[ND], float& m, float& l, bf16x8 (&pf)[2], bool& pend, lds_cptr kb, lds_cptr vprev, const Hook& hook = Hook()) {
    constexpr int NM = ND * 2;
    bf16x8 vall[ILV ? NM : 1];
    if (ILV) { if (opaque_i(pend)) {
#pragma unroll
        for (int i = 0; i < NM; ++i) vall[ILV ? i : 0] = vfrag(vprev, i); } }
    qk_half<NS, KPITCH, NG, Hook>(p, qf, qg, kb, hook);
    float mx = p[0];
#pragma unroll
    for (int r = 1; r < 16; ++r) mx = fmaxf(mx, p[r]);
    mx = half_max(mx);
    if (!__all(mx <= m + 6.0f)) {
        if (pend) { pv_plain<ND>(o, pf, vprev); pend = false; }
        const float mn = fmaxf(m, mx);
        const float alpha = __builtin_amdgcn_exp2f(m - mn);
        m = mn; l *= alpha;
#pragma unroll
        for (int d = 0; d < ND; ++d)
#pragma unroll
            for (int r = 0; r < 16; ++r) o[d][r] *= alpha;
    }
    bf16x8 pfn[2];
    float rs = 0.f;
    if (ILV) {
        constexpr int EPM = 16 / NM;
#pragma unroll
        for (int i = 0; i < NM; ++i) {
            if (opaque_i(pend)) o[i >> 1] = __builtin_amdgcn_mfma_f32_32x32x16_bf16(vall[ILV ? i : 0], pf[i & 1], o[i >> 1], 0, 0, 0);
#pragma unroll
            for (int e = 0; e < EPM; ++e) { const int idx = i * EPM + e; float x = p[idx];
                asm volatile("" : "+v"(x));
                x = __builtin_amdgcn_exp2f(x - m);
                asm volatile("" : "+v"(x));
                p[idx] = x; rs += x; }
            if (((i + 1) * EPM) % 8 == 0) { const int k = ((i + 1) * EPM) / 8 - 1; pfn[k] = packp(p, 8 * k); }
            __builtin_amdgcn_sched_barrier(0);
        }
    } else if (pend) {
        constexpr int EPM = 16 / NM;
        bf16x8 vr[3]; vr[0] = vfrag(vprev, 0); vr[1] = vfrag(vprev, 1);
#pragma unroll
        for (int i = 0; i < NM; ++i) {
            if (i + 2 < NM) vr[(i + 2) % 3] = vfrag(vprev, i + 2);
            o[i >> 1] = __builtin_amdgcn_mfma_f32_32x32x16_bf16(vr[i % 3], pf[i & 1], o[i >> 1], 0, 0, 0);
#pragma unroll
            for (int e = 0; e < EPM; ++e) { const int idx = i * EPM + e; p[idx] = __builtin_amdgcn_exp2f(p[idx] - m); rs += p[idx]; }
            if (((i + 1) * EPM) % 8 == 0) { const int k = ((i + 1) * EPM) / 8 - 1; pfn[k] = packp(p, 8 * k); }
            __builtin_amdgcn_sched_barrier(0);
        }
    } else {
        float m2 = m;
#if MK_NOHOIST
        asm volatile("" : "+v"(m2));
#endif
#pragma unroll
        for (int r = 0; r < 16; ++r) { p[r] = __builtin_amdgcn_exp2f(p[r] - m2); rs += p[r]; }
        pfn[0] = packp(p, 0); pfn[1] = packp(p, 8);
    }
    l += rs;
    pf[0] = pfn[0]; pf[1] = pfn[1];
    pend = true;
}
template <int ND>
__device__ __forceinline__ void load_gates(v2u (&gw)[ND * 4], const bf16* gate_row, int hi) {
#pragma unroll
    for (int i = 0; i < ND * 4; ++i) gw[i] = *(const v2u*)(gate_row + 32 * (i >> 2) + 8 * (i & 3) + 4 * hi);
    __builtin_amdgcn_sched_barrier(0);
}
template <int ND> __device__ __forceinline__ void store_o_g(const f32x16 (&o)[ND], const float inv, const v2u (&gw)[ND * 4], bf16* mix, size_t mix_row, int hi);
template <int ND>
__device__ __forceinline__ void store_o(const f32x16 (&o)[ND], float l, const bf16* gate_row, bf16* mix, size_t mix_row, int hi) {
    const float inv = 1.0f / half_sum(l);
    v2u gw[ND * 4];
    load_gates<ND>(gw, gate_row, hi);
    store_o_g<ND>(o, inv, gw, mix, mix_row, hi);
}
template <int ND>
__device__ __forceinline__ void store_o_g(const f32x16 (&o)[ND], const float inv, const v2u (&gw)[ND * 4], bf16* mix, size_t mix_row, int hi) {
#pragma unroll
    for (int d = 0; d < ND; ++d)
#pragma unroll
        for (int g4 = 0; g4 < 4; ++g4) {
            const int c = 32 * d + 8 * g4 + 4 * hi;
            const v2u g = gw[d * 4 + g4];
            const float g0 = bf2f(g.x & 0xffffu), g1 = bf2f(g.x >> 16), g2 = bf2f(g.y & 0xffffu), g3 = bf2f(g.y >> 16);
            v2u w; w.x = pk2(o[d][4 * g4] * inv * g0, o[d][4 * g4 + 1] * inv * g1); w.y = pk2(o[d][4 * g4 + 2] * inv * g2, o[d][4 * g4 + 3] * inv * g3);
            st8(mix, (mix_row + c) * 2, w);
        }
}
}


__device__ __forceinline__ void fast_attn_a(const Frame& F, int L) {
    constexpr int KP = 144, KH = 64 * KP  , VH = 8192, STG = 2 * KH + 2 * VH  , TAB = 3 * STG;
    const bf16* Z = (const bf16*)(F.ws + WS_Z); bf16* MIX = (bf16*)(F.ws + ((L & 1) ? WS_BUFA : WS_BUFB));
    const float* rbias = inp<5>(F) + (size_t)L * 8 * 257;
    const int tid = F.tid, lane = F.lane, wave = F.wave, r32 = lane & 31, hi = lane >> 5;
    const int hsel = (wave >> 1) & 1, rb = (wave & 1) | ((wave >> 2) << 1);
    LAS float* tab = (LAS float*)(F.lds + TAB);
    const int vlane = (4 * hi + ((lane & 15) >> 2)) * 64 + ((lane >> 4) & 1) * 32 + (lane & 3) * 8;
    const int sc = tid & 15, sk = tid >> 4, shd = sc >> 3, scc = sc & 7;
    const int kdst0 = shd * KH + sk * KP + scc * 16, kdst1 = kdst0 + 32 * KP;
    const int vdst0 = 2 * KH + shd * VH + (scc >> 2) * 4096 + (sk >> 3) * 512 + (sk & 7) * 64 + (scc & 3) * 16, vdst1 = vdst0 + 4 * 512;
    const int nun = (F.G == 256) ? 4 : (1024 + F.G - 1 - F.vcu) / F.G;
    auto unit_id = [&](int ui) -> int {
        if (F.G == 256) { const int s = F.vcu & 3; const int blk = s + 4 * ui; return (F.vcu >> 2) * 16 + blk; }
        return F.vcu + ui * F.G; };
    v4u sA[4], sB[4]; bf16x8 qfn[4];
#define FAA_LOAD(S, KS, jj) do { const bf16* p_ = (KS) + (size_t)(64 * (jj)) * DINP; S[0] = *(const v4u*)p_; S[1] = *(const v4u*)(p_ + (size_t)32 * DINP); S[2] = *(const v4u*)(p_ + 512); S[3] = *(const v4u*)(p_ + (size_t)32 * DINP + 512); } while (0)
#define FAA_WRITE(S, stage) do { LAS unsigned char* sw_ = F.lds + (stage) * STG; *(LAS v4u*)(sw_ + kdst0) = S[0]; *(LAS v4u*)(sw_ + kdst1) = S[1]; *(LAS v4u*)(sw_ + vdst0) = S[2]; *(LAS v4u*)(sw_ + vdst1) = S[3]; } while (0)
#define FAA_PREFETCH(uidv) do { const int blk_ = (uidv) & 15, hp_ = ((uidv) >> 4) & 3, b_ = (uidv) >> 6; const int jlo_ = (2 * blk_ - 8 > 0) ? 2 * blk_ - 8 : 0; \
        const bf16* qp_ = Z + (size_t)(b_ * SEQ + blk_ * 128 + 32 * rb + r32) * DINP + ZC_QA + 64 * (2 * hp_ + hsel) + 8 * hi; \
        _Pragma("unroll") for (int s_ = 0; s_ < 4; ++s_) qfn[s_] = *(const bf16x8*)(qp_ + 16 * s_); \
        const bf16* ks_ = Z + (size_t)(b_ * SEQ + sk) * DINP + ZC_KA + 128 * hp_ + 8 * sc; FAA_LOAD(sB, ks_, jlo_); FAA_LOAD(sA, ks_, jlo_ + 1); } while (0)
    if (nun <= 0) return;
    int tab_hp = -1;
    FAA_PREFETCH(unit_id(0));
    for (int ui = 0; ui < nun; ++ui) {
        const int uid = unit_id(ui);
        const int blk = uid & 15, hp = (uid >> 4) & 3, b = uid >> 6;
        const int R0 = b * SEQ + blk * 128, h = 2 * hp + hsel;
        const int qrow = R0 + 32 * rb + r32, cq = 2 * blk + (rb >> 1), ql = 32 * (rb & 1) + r32;
        const int jlo = (2 * blk - 8 > 0) ? 2 * blk - 8 : 0, jhi = 2 * blk + 1;
        if (hp != tab_hp) { tab_hp = hp;
            for (int i = tid; i < 2 * 320; i += NTHREADS) { const int hh = i / 320, e = i - hh * 320; tab[hh * 324 + e] = rbias[(2 * hp + hh) * 257 + (e < 256 ? e : 256)] * LOG2E; } }
        bf16x8 qf[4];
#pragma unroll
        for (int s = 0; s < 4; ++s) qf[s] = qfn[s];
        const bf16* ksrc = Z + (size_t)(b * SEQ + sk) * DINP + ZC_KA + 128 * hp + 8 * sc;
        FAA_WRITE(sB, 0);
        __syncthreads();
        f32x16 o[2]; o[0] = (f32x16){}; o[1] = (f32x16){};
        float m = MK_NEGM ? 0.f : -1e30f, l = 0.f;
        const LAS float* tb = tab + hsel * 324;
        bf16x8 pf[2];
        bool pend = false;
#if MK_NEGM
        bool fresh = true;
        const float cb = tb[256];
        f32x16 cinit;
#pragma unroll
        for (int r = 0; r < 16; ++r) cinit[r] = cb;
#endif
#if MK_SP & 1
        f32x16 P0, P1; bool have = false;
#pragma unroll
        for (int r = 0; r < 16; ++r) P1[r] = -1e30f;
#endif
        int cur = 0, prv = 0;
        auto step = [&](const int j, v4u (&X)[4], v4u (&Y)[4]) {
            const int nxt = (cur == 2) ? 0 : cur + 1;
            FAA_LOAD(Y, ksrc, (j + 2 <= jhi) ? j + 2 : jhi);
            const int dj = cq - j; const bool valid = (dj >= 0 && dj <= 8);
            fa::lds_cptr sb = (fa::lds_cptr)(F.lds + cur * STG);
            fa::lds_cptr vprev = (fa::lds_cptr)(F.lds + prv * STG) + 2 * KH + hsel * VH + vlane;
            if (valid) {
                fa::lds_cptr kb = sb + hsel * KH + r32 * KP + hi * 16, vcur = sb + 2 * KH + hsel * VH + vlane;
#if MK_SP & 1
                const bool cst = dj >= 3;
                const int dq = ql + 64 * dj;
                const LAS float* lp = tb + (dq - 4 * hi - 27 + 128);
                auto lk0 = [&](f32x16& t) {
#pragma unroll
                    for (int r = 0; r < 16; ++r) t[r] = lp[27 - ((r & 3) + 8 * (r >> 2))] - m; };
                auto lk1 = [&](f32x16& t) {
#pragma unroll
                    for (int r = 0; r < 16; ++r) t[r] = (lp - 32)[27 - ((r & 3) + 8 * (r >> 2))] - m; };
                fa::half_step_sp<4, 2, KP, true, true>(P0, P1, qf, o, m, l, fresh, cinit, cb, cst, lk0, kb, vprev + 2048);
                fa::half_step_sp<4, 2, KP, true, true>(P1, P0, qf, o, m, l, fresh, cinit, cb, cst, lk1, kb + 32 * KP, vcur);
                have = true;
#elif MK_NEGM
                f32x16 p0, p1;
                const bool cst = dj >= 3;
                const int dq = ql + 64 * dj;
                const LAS float* lp = tb + (dq - 4 * hi - 27 + 128);
                auto lk0 = [&](f32x16& t) {
#pragma unroll
                    for (int r = 0; r < 16; ++r) t[r] = lp[27 - ((r & 3) + 8 * (r >> 2))] - m; };
                auto lk1 = [&](f32x16& t) {
#pragma unroll
                    for (int r = 0; r < 16; ++r) t[r] = (lp - 32)[27 - ((r & 3) + 8 * (r >> 2))] - m; };
                fa::half_step_nm<4, 2, KP>(p0, qf, o, m, l, pf, pend, fresh, cinit, cb, cst, lk0, kb, vprev + 2048);
                fa::half_step_nm<4, 2, KP>(p1, qf, o, m, l, pf, pend, fresh, cinit, cb, cst, lk1, kb + 32 * KP, vcur);
#else
                f32x16 p0, p1;
                if (dj >= 3) { const float c = tb[256];
#pragma unroll
                    for (int r = 0; r < 16; ++r) { p0[r] = c; p1[r] = c; } }
                else {
#pragma unroll
                    for (int r = 0; r < 16; ++r) { const int kvl = (r & 3) + 8 * (r >> 2) + 4 * hi; int d0 = ql + 64 * dj - kvl, d1 = d0 - 32;
                        d0 = d0 > 128 ? 128 : d0; d1 = d1 > 128 ? 128 : d1; p0[r] = tb[d0 + 128]; p1[r] = tb[d1 + 128]; }
                }
                fa::half_step<4, 2, KP, 0, false>(p0, qf, nullptr, o, m, l, pf, pend, kb, vprev + 2048);
                fa::half_step<4, 2, KP, 0, false>(p1, qf, nullptr, o, m, l, pf, pend, kb + 32 * KP, vcur);
#endif
            }
#if MK_SP & 1
            else if (have) { fa::flush_sp<2>(P1, o, l, vprev + 2048);
#pragma unroll
                for (int r = 0; r < 16; ++r) P1[r] = -1e30f;
                have = false; }
#else
            else if (pend) { fa::pv_plain<2>(o, pf, vprev + 2048); pend = false; }
#endif
            if (j < jhi) FAA_WRITE(X, nxt);
            __syncthreads();
            prv = cur; cur = nxt;
        };
        for (int j = jlo; j <= jhi; j += 2) { step(j, sA, sB); step(j + 1, sB, sA); }
        FAA_PREFETCH(unit_id((ui + 1 < nun) ? ui + 1 : ui));
        v2u gw[8];
        fa::load_gates<2>(gw, Z + (size_t)qrow * DINP + ZC_GA + 64 * h, hi);
#if MK_SP & 1
        if (have) fa::flush_sp<2>(P1, o, l, (fa::lds_cptr)(F.lds + prv * STG) + 2 * KH + hsel * VH + vlane + 2048);
#else
        if (pend) fa::pv_plain<2>(o, pf, (fa::lds_cptr)(F.lds + prv * STG) + 2 * KH + hsel * VH + vlane + 2048);
#endif
        fa::store_o_g<2>(o, 1.0f / fa::half_sum(l), gw, MIX, (size_t)qrow * DM + 64 * h, hi);
        __syncthreads();
    }
#undef FAA_LOAD
#undef FAA_WRITE
#undef FAA_PREFETCH
}

__device__ __forceinline__ void fast_attn_b(const Frame& F, int L) {
    constexpr int KP = 400, KB = 64 * KP  , STG = KB + 16384  ;
    const bf16* Z = (const bf16*)(F.ws + WS_Z); const bf16* U = (const bf16*)(F.ws + WS_U); bf16* MIX = (bf16*)(F.ws + ((L & 1) ? WS_BUFA : WS_BUFB));
    const int wave = F.wave;
    const int nun = (F.G == 256) ? 2 : (512 + F.G - 1 - F.vcu) / F.G;
    for (int ui = 0; ui < nun; ++ui) {
        int tid = F.tid; asm volatile("" : "+v"(tid));
        const int lane = tid & 63, r32 = lane & 31, hi = lane >> 5;
        const int vlane = (4 * hi + ((lane & 15) >> 2)) * 64 + ((lane >> 4) & 1) * 32 + (lane & 3) * 8;
        const int skey = tid >> 3, c8 = tid & 7;
        const int kdst = skey * KP + c8 * 16;
        const int vdst = KB + (c8 >> 2) * 4096 + (skey >> 3) * 512 + (skey & 7) * 64 + (c8 & 3) * 16;
        int uid;
        if (F.G == 256) { const int s = F.vcu & 3; uid = (F.vcu >> 2) * 8 + ((ui == 0) ? 7 - s : s); }
        else uid = F.vcu + ui * F.G;
        const int qb = uid & 7, h = (uid >> 3) & 3, b = uid >> 5;
        const int R0 = b * SEQ + qb * 256, qrow = R0 + 32 * wave + r32, cq = 4 * qb + (wave >> 1), jhi = 4 * qb + 3;
        bf16x8 qf[12];
#pragma unroll
        for (int s = 0; s < 8; ++s) qf[s] = *(const bf16x8*)(U + (size_t)qrow * DUP + UC_QN + 128 * h + 16 * s + 8 * hi);
#pragma unroll
        for (int s = 0; s < 4; ++s) qf[8 + s] = *(const bf16x8*)(U + (size_t)qrow * DUP + UC_QR + 64 * h + 16 * s + 8 * hi);
        const bf16* kn = U + (size_t)(b * SEQ + skey) * DUP + UC_KN + 128 * h + 8 * c8;
        const bf16* kr = Z + (size_t)(b * SEQ + skey) * DINP + ZC_KR + 8 * c8;
        const bf16* vs = U + (size_t)(b * SEQ + skey) * DUP + UC_V + 128 * h + 8 * c8;
        v4u st[5];
        st[0] = *(const v4u*)kn; st[1] = *(const v4u*)(kn + 64); st[2] = *(const v4u*)kr; st[3] = *(const v4u*)vs; st[4] = *(const v4u*)(vs + 64);
        { LAS unsigned char* sb = F.lds;
          *(LAS v4u*)(sb + kdst) = st[0]; *(LAS v4u*)(sb + kdst + 128) = st[1]; *(LAS v4u*)(sb + kdst + 256) = st[2]; *(LAS v4u*)(sb + vdst) = st[3]; *(LAS v4u*)(sb + vdst + 8192) = st[4]; }
        __syncthreads();
        f32x16 o[4]; o[0] = (f32x16){}; o[1] = (f32x16){}; o[2] = (f32x16){}; o[3] = (f32x16){};
        float m = -1e30f, l = 0.f;
        bf16x8 pf[2];
        bool pend = false;
        int cur = 0, prv = 0;
        for (int j = 0; j <= jhi; ++j) {
            const int nxt = (cur == 2) ? 0 : cur + 1;
            fa::lds_cptr sb = (fa::lds_cptr)(F.lds + cur * STG);
            fa::lds_cptr vprev = (fa::lds_cptr)(F.lds + prv * STG) + KB + vlane;
            const bool valid = j <= cq;
            if (valid) { f32x16 p = (f32x16){}; fa::half_step<12, 4, KP>(p, qf, nullptr, o, m, l, pf, pend, sb + r32 * KP + hi * 16, vprev + 2048); }
            else if (pend) { fa::pv_plain<4>(o, pf, vprev + 2048); pend = false; }
            if (j < jhi) { const size_t ou = (size_t)(64 * (j + 1)) * DUP, oz = (size_t)(64 * (j + 1)) * DINP;
                st[0] = *(const v4u*)(kn + ou); st[1] = *(const v4u*)(kn + ou + 64); st[2] = *(const v4u*)(kr + oz); st[3] = *(const v4u*)(vs + ou); st[4] = *(const v4u*)(vs + ou + 64); }
            if (valid) { f32x16 p = (f32x16){}; fa::half_step<12, 4, KP>(p, qf, nullptr, o, m, l, pf, pend, sb + (32 + r32) * KP + hi * 16, sb + KB + vlane); }
            if (j < jhi) { LAS unsigned char* sw = F.lds + nxt * STG;
                *(LAS v4u*)(sw + kdst) = st[0]; *(LAS v4u*)(sw + kdst + 128) = st[1]; *(LAS v4u*)(sw + kdst + 256) = st[2]; *(LAS v4u*)(sw + vdst) = st[3]; *(LAS v4u*)(sw + vdst + 8192) = st[4]; }
            __syncthreads();
            prv = cur; cur = nxt;
        }
        if (pend) fa::pv_plain<4>(o, pf, (fa::lds_cptr)(F.lds + prv * STG) + KB + vlane + 2048);
        fa::store_o<4>(o, l, Z + (size_t)qrow * DINP + ZC_GB + 128 * h, MIX, (size_t)qrow * DM + 512 + 128 * h, hi);
        __syncthreads();
    }
}
__device__ __forceinline__ void fast_gemm_final(const Frame& F, const bf16* A, const bf16* Bt, const pg8::FinalEpi& E) {
    pg8::Gemm g{A, DM, Bt, T, DM, DM, 0, 0}; pg8::StaticOrder S; S.init(T, DM, F.G, F.bx);
    pg8::gemm_phase<pg8::FinalEpi>(F.lds, F.tid, g, S, E);
}
#if MK_ABSORB
__device__ __forceinline__ void fast_attn_b_abs(const Frame& F, int L) {
    constexpr int KP = 400, KB = 64 * KP  , STG = KB + 16384  ;
    const bf16* Z = (const bf16*)(F.ws + WS_Z); const bf16* U = (const bf16*)(F.ws + WS_U); const bf16* CK = (const bf16*)(F.ws + WS_CKVN); bf16* MIX = (bf16*)(F.ws + ((L & 1) ? WS_BUFA : WS_BUFB));
    const bf16* WVT = (const bf16*)(F.ws + WS_WVT) + (size_t)L * 65536;
    const int wave = F.wave, h = wave >> 1, rbk = wave & 1;
    const int nun = (F.G == 256) ? 2 : (512 + F.G - 1 - F.vcu) / F.G;
    auto unit_id = [&](int ui) -> int { if (F.G == 256) { const int s = F.vcu & 15; return (F.vcu >> 4) * 32 + ((ui == 0) ? 31 - s : s); } return F.vcu + ui * F.G; };
    v4u sA[3], sB[3];
#define FAB_LOADP(S, KN, KR, jj) do { const size_t ou_ = (size_t)(64 * (jj)) * 128, oz_ = (size_t)(64 * (jj)) * DINP; S[0] = *(const v4u*)((KN) + ou_); S[1] = *(const v4u*)((KN) + ou_ + 64); S[2] = *(const v4u*)((KR) + oz_); } while (0)
    if (nun <= 0) return;
    { const int u0 = unit_id(0), b0 = u0 >> 5, c0 = u0 & 31, skey0 = F.tid >> 3, c80 = F.tid & 7;
        const bf16* kn0 = CK + (size_t)(b0 * SEQ + skey0) * 128 + 8 * c80; const bf16* kr0 = Z + (size_t)(b0 * SEQ + skey0) * DINP + ZC_KR + 8 * c80;
        FAB_LOADP(sB, kn0, kr0, 0); FAB_LOADP(sA, kn0, kr0, (c0 >= 1) ? 1 : 0); }
    for (int ui = 0; ui < nun; ++ui) {
        int tid = F.tid; asm volatile("" : "+v"(tid));
        const int lane = tid & 63, r32 = lane & 31, hi = lane >> 5;
        const int vlane = (4 * hi + ((lane & 15) >> 2)) * 64 + ((lane >> 4) & 1) * 32 + (lane & 3) * 8;
        const int skey = tid >> 3, c8 = tid & 7;
        const int kdst = skey * KP + c8 * 16;
        const int vdst = KB + (c8 >> 2) * 4096 + (skey >> 3) * 512 + (skey & 7) * 64 + (c8 & 3) * 16;
        const int uid = unit_id(ui);
        const int c = uid & 31, b = uid >> 5;
        const int qrow = b * SEQ + 64 * c + 32 * rbk + r32, jhi = c;
        bf16x8 qf[12];
#pragma unroll
        for (int s = 0; s < 8; ++s) qf[s] = *(const bf16x8*)(U + (size_t)qrow * DUP + UC_QN + 128 * h + 16 * s + 8 * hi);
#pragma unroll
        for (int s = 0; s < 4; ++s) qf[8 + s] = *(const bf16x8*)(U + (size_t)qrow * DUP + UC_QR + 64 * h + 16 * s + 8 * hi);
        const bf16* kn = CK + (size_t)(b * SEQ + skey) * 128 + 8 * c8;
        const bf16* kr = Z + (size_t)(b * SEQ + skey) * DINP + ZC_KR + 8 * c8;
#define FAB_LOAD(S, jj) FAB_LOADP(S, kn, kr, jj)
#define FAB_WRITE(S, stage) do { LAS unsigned char* sw_ = F.lds + (stage) * STG; *(LAS v4u*)(sw_ + kdst) = S[0]; *(LAS v4u*)(sw_ + kdst + 128) = S[1]; *(LAS v4u*)(sw_ + kdst + 256) = S[2]; *(LAS v4u*)(sw_ + vdst) = S[0]; *(LAS v4u*)(sw_ + vdst + 8192) = S[1]; } while (0)
        FAB_WRITE(sB, 0);
        __syncthreads();
#pragma unroll
        for (int s = 0; s < 12; ++s) asm volatile("" : "+v"(qf[s]));
        f32x16 o[4]; o[0] = (f32x16){}; o[1] = (f32x16){}; o[2] = (f32x16){}; o[3] = (f32x16){};
#if MK_SP & 2
        float m = -1e30f, l = 0.f;
        bool fresh = false;
        f32x16 cinit, P0, P1;
#pragma unroll
        for (int r = 0; r < 16; ++r) P1[r] = -3e38f;
#else
        float m = -1e30f, l = 0.f;
        bf16x8 pf[2];
        bool pend = false;
#endif
        int cur = 0, prv = 0;
        auto step = [&](const int j, v4u (&X)[3], v4u (&Y)[3]) {
            const int nxt = (cur == 2) ? 0 : cur + 1;
            fa::lds_cptr sb = (fa::lds_cptr)(F.lds + cur * STG);
            fa::lds_cptr vprev = (fa::lds_cptr)(F.lds + prv * STG) + KB + vlane;
#if MK_SP & 2
            fa::half_step_sp<12, 4, KP, false, false>(P0, P1, qf, o, m, l, fresh, cinit, 0.f, true, fa::NoLookup(), sb + r32 * KP + hi * 16, vprev + 2048);
            FAB_LOAD(Y, (j + 2 <= jhi) ? j + 2 : jhi);
            fa::half_step_sp<12, 4, KP, false, false>(P1, P0, qf, o, m, l, fresh, cinit, 0.f, true, fa::NoLookup(), sb + (32 + r32) * KP + hi * 16, sb + KB + vlane);
#else
            { f32x16 p = (f32x16){}; fa::half_step<12, 4, KP>(p, qf, nullptr, o, m, l, pf, pend, sb + r32 * KP + hi * 16, vprev + 2048); }
            FAB_LOAD(Y, (j + 2 <= jhi) ? j + 2 : jhi);
            { f32x16 p = (f32x16){}; fa::half_step<12, 4, KP>(p, qf, nullptr, o, m, l, pf, pend, sb + (32 + r32) * KP + hi * 16, sb + KB + vlane); }
#endif
            FAB_WRITE(X, nxt);
            __syncthreads();
            prv = cur; cur = nxt;
        };
        { int j = 0;
            for (; j + 1 <= jhi; j += 2) { step(j, sA, sB); step(j + 1, sB, sA); }
            if (j <= jhi) step(j, sA, sB); }
        { const int un = unit_id((ui + 1 < nun) ? ui + 1 : ui), bn = un >> 5, cn = un & 31;
            const bf16* knn = CK + (size_t)(bn * SEQ + skey) * 128 + 8 * c8; const bf16* krn = Z + (size_t)(bn * SEQ + skey) * DINP + ZC_KR + 8 * c8;
            FAB_LOADP(sB, knn, krn, 0); FAB_LOADP(sA, knn, krn, (cn >= 1) ? 1 : 0); }
#undef FAB_LOAD
#undef FAB_WRITE
#if MK_SP & 2
        fa::flush_sp<4>(P1, o, l, (fa::lds_cptr)(F.lds + prv * STG) + KB + vlane + 2048, m);
#else
        if (pend) fa::pv_plain<4>(o, pf, (fa::lds_cptr)(F.lds + prv * STG) + KB + vlane + 2048);
#endif
        const float inv = 1.0f / fa::half_sum(l);
        bf16x8 bfr[4][2];
#pragma unroll
        for (int d = 0; d < 4; ++d)
#pragma unroll
            for (int sx = 0; sx < 2; ++sx) { v4u w; w.x = pk2(o[d][8 * sx] * inv, o[d][8 * sx + 1] * inv); w.y = pk2(o[d][8 * sx + 2] * inv, o[d][8 * sx + 3] * inv);
                w.z = pk2(o[d][8 * sx + 4] * inv, o[d][8 * sx + 5] * inv); w.w = pk2(o[d][8 * sx + 6] * inv, o[d][8 * sx + 7] * inv); bfr[d][sx] = __builtin_bit_cast(bf16x8, w); }
        f32x16 y[4]; y[0] = (f32x16){}; y[1] = (f32x16){}; y[2] = (f32x16){}; y[3] = (f32x16){};
        const bf16* wv = WVT + (size_t)h * 16384 + (hi * 32 + r32) * 8;
        v2u gw[16];
        fa::load_gates<4>(gw, Z + (size_t)qrow * DINP + ZC_GB + 128 * h, hi);
        bf16x8 wa[2][8];
#pragma unroll
        for (int i = 0; i < 8; ++i) wa[0][i] = *(const bf16x8*)(wv + (i * 2) * 256);
        __builtin_amdgcn_sched_barrier(0);
#pragma unroll
        for (int blk = 0; blk < 4; ++blk) {
            if (blk + 1 < 4) {
#pragma unroll
                for (int i = 0; i < 8; ++i) wa[(blk + 1) & 1][i] = *(const bf16x8*)(wv + ((((blk + 1) * 8 + i)) * 2) * 256);
            }
            __builtin_amdgcn_sched_barrier(0);
#pragma unroll
            for (int i = 0; i < 8; ++i) y[blk] = __builtin_amdgcn_mfma_f32_32x32x16_bf16(wa[blk & 1][i], bfr[i >> 1][i & 1], y[blk], 0, 0, 0);
            __builtin_amdgcn_sched_barrier(0);
        }
        fa::store_o_g<4>(y, 1.0f, gw, MIX, (size_t)qrow * DM + 512 + 128 * h, hi);
        __syncthreads();
    }
}
#endif

__device__ __forceinline__ void final_norm(const Frame& F) {
    const float* ssq = (const float*)(F.ws + WS_SSQ2); const float* nf = inp<15>(F);
    const int gw = F.vcu * NWAVES + F.wave, NGW = F.G * NWAVES;
    for (int m = gw; m < T; m += NGW) {
        float s = (F.lane < 32) ? ssq[(size_t)m * 32 + F.lane] : 0.f; s = wave_sum(s);
        const float r = rsqrtf(s * (1.0f / DM) + EPS);
        f32x4* o = (f32x4*)(F.out + (size_t)m * DM) + F.lane; const f32x4* g = (const f32x4*)nf + F.lane;
#pragma unroll
        for (int j = 0; j < 4; ++j) { f32x4 v = o[64 * j]; const f32x4 gg = g[64 * j]; v.x *= r * gg.x; v.y *= r * gg.y; v.z *= r * gg.z; v.w *= r * gg.w; o[64 * j] = v; }
    }
}

constexpr int N_PHASES = 12;
constexpr bool FUSE_FINAL_OK = (MK_FUSE_FINAL && !(MK_NAIVE & 1));
constexpr int CW_PANEL = 16384; static_assert(CW_PANEL == 16384, "FinalEpi hard-codes it");
__global__ void __launch_bounds__(NTHREADS, 2) trunk_fwd(Args args) {
    extern __shared__ __attribute__((aligned(16))) unsigned char lds[];
    const int G = gridDim.x; int vcu; { const int bx = blockIdx.x; vcu = (G % 8 == 0) ? (bx % 8) * (G / 8) + bx / 8 : bx; }
    volatile LAS unsigned* MISC = (volatile LAS unsigned*)((LAS unsigned char*)lds + MISC_OFF);
    for (int u = threadIdx.x; u < (LDS_BYTES - LDSCTL_OFF) / 4; u += NTHREADS) ((LAS unsigned*)((LAS unsigned char*)lds + LDSCTL_OFF))[u] = 0u;
    __syncthreads();
    const int wave0 = __builtin_amdgcn_readfirstlane((int)(threadIdx.x >> 6));
    XcdBarrier bar; bar.bar = (unsigned*)(args.ws + WS_CTL) + CW_BAR; bar.x = 0; bar.st = nullptr;
    if (MK_N_LAUNCHES == 1) bar = xcd_barrier_post((unsigned*)(args.ws + WS_CTL) + CW_BAR, MISC + 8);

    for (int ph = args.ph_lo; ph < args.ph_hi; ++ph) {
        Frame F; F.a = &args; F.G = opaque_i(G); F.vcu = opaque_i(vcu); F.bx = opaque_i((int)blockIdx.x);
        { const int wv = opaque_i(wave0);
          int tid = wv * 64 + (int)__builtin_amdgcn_mbcnt_hi(~0u, __builtin_amdgcn_mbcnt_lo(~0u, 0u)); asm volatile("" : "+v"(tid)); F.tid = tid; F.lane = tid & 63; F.wave = __builtin_amdgcn_readfirstlane(tid >> 6); }
        { GAS unsigned char* w = (GAS unsigned char*)args.ws; asm volatile("" : "+s"(w)); F.ws = (unsigned char*)w; }
        { GAS float* o = (GAS float*)args.out; asm volatile("" : "+s"(o)); F.out = (float*)o; }
        { unsigned lb = 0; asm volatile("" : "+s"(lb)); F.lds = (LAS unsigned char*)lds + lb; }
        bf16* Z = (bf16*)(F.ws + WS_Z); bf16* U = (bf16*)(F.ws + WS_U); bf16* PE = (bf16*)(F.ws + WS_Z);
        float* SSQ1 = (float*)(F.ws + WS_SSQ1); float* SSQ2 = (float*)(F.ws + WS_SSQ2); float* SSQQ = (float*)(F.ws + WS_SSQQ); float* SSQKV = (float*)(F.ws + WS_SSQKV);
        const f32x2* CS = (const f32x2*)(F.ws + WS_CS);
        if (opaque_i(ph) == 0) { REP(0) p0_prologue(F); }
        else if (opaque_i(ph) == N_PHASES - 1) final_norm(F);
        else {
            const int L = (ph - 1) / 5; int kind = (ph - 1) % 5;
#ifdef MK_ONLY
            if (kind != MK_ONLY) kind = 99;
#endif
            bf16* HIN = (bf16*)(F.ws + ((L & 1) ? WS_BUFB : WS_BUFA));
            bf16* MIX = (bf16*)(F.ws + ((L & 1) ? WS_BUFA : WS_BUFB));
            if (opaque_i(kind) == 0) {
                EpiP1 E{Z, SSQ2, SSQQ, SSQKV, CS};
                const bf16* Bt = (const bf16*)(F.ws + WS_WIN) + (size_t)L * DINP * DM;
                REP(1) { if (MK_NAIVE & 1) naive_gemm(F, HIN, DM, Bt, DM, DINP, E);
                else fast_gemm(F, HIN, DM, Bt, DM, DINP, E); }
            } else if (opaque_i(kind) == 1) {
                EpiUp E{U, SSQQ, SSQKV, CS};
                const bf16* Bt = (const bf16*)(F.ws + WS_WUP) + (size_t)L * DUP * KUP;
#if !defined(MK_SUB) || MK_SUB == 0
                REP(2) { if (MK_NAIVE & 1) naive_gemm(F, Z + ZC_CQ, DINP, Bt, KUP, DUP, E);
                else {
                    int deal = -1;
                    if (F.G == 256) deal = ((F.vcu & 2) ? 128 : 0) + (F.vcu >> 2) * 2 + (F.vcu & 1);
                    if (MK_ABSORB) fast_gemm(F, Z + ZC_CQ, DINP, Bt, KUP, DUP, E, 0, 0, deal);
                    else fast_gemm(F, Z + ZC_CQ, DINP, Bt, KUP, DUP, E, 3, 4, deal); } }
#if MK_ABSORB
                ckvn_pass(F, L);
#endif
#endif
                __syncthreads();
                relaunder(F);
#if !defined(MK_SUB) || MK_SUB == 1
                REP(3) { if (MK_NAIVE & 2) naive_attn_a(F, L); else fast_attn_a(F, L); }
#endif
            } else if (opaque_i(kind) == 2) {
#if MK_ABSORB
                REP(4) { if (MK_NAIVE & 4) naive_attn_b_abs(F, L); else fast_attn_b_abs(F, L); }
#else
                REP(4) { if (MK_NAIVE & 4) naive_attn_b(F, L); else fast_attn_b(F, L); }
#endif
            } else if (opaque_i(kind) == 3) {
                const int grp = MK_STAG_US > 0 ? (F.bx >> 3) & 1 : 0;
#define P4_PE() do { EpiPe E0{(bf16*)(F.ws + WS_Z)}; \
                        const bf16* Bpe = (const bf16*)(F.ws + WS_WPE) + (size_t)L * DM * DPLE; \
                        const bf16* PBl = (const bf16*)(F.ws + WS_PB) + (size_t)L * T * DPLE; \
                        REP(5) { if (MK_NAIVE & 1) naive_gemm(F, PBl, DPLE, Bpe, DPLE, DM, E0); \
                        else fast_gemm(F, PBl, DPLE, Bpe, DPLE, DM, E0); } } while (0)
#define P4_OUT() do { bf16* HIN2 = (bf16*)(F.ws + ((L & 1) ? WS_BUFB : WS_BUFA)); bf16* MIX2 = (bf16*)(F.ws + ((L & 1) ? WS_BUFA : WS_BUFB)); \
                        EpiOut E1{L == 0 ? inp<0>(F) : (const float*)nullptr, HIN2, (const bf16*)F.out, HIN2, (bf16*)(F.ws + WS_LO1), (float*)(F.ws + WS_SSQ1)}; \
                        const bf16* Bo = (const bf16*)(F.ws + WS_WOUT) + (size_t)L * DM * DM; \
                        if (MK_NAIVE & 1) naive_gemm(F, MIX2, DM, Bo, DM, DM, E1); \
                        else fast_gemm(F, MIX2, DM, Bo, DM, DM, E1); } while (0)
                if (grp == 0) { P4_PE(); __syncthreads(); relaunder(F); P4_OUT(); }
                else { P4_OUT(); __syncthreads(); relaunder(F); P4_PE(); }
#undef P4_PE
#undef P4_OUT
            } else if (opaque_i(kind) == 4) {
                if (MK_STAG_US > 0 && ((F.bx >> 3) & 1)) {
                    const unsigned long long t0 = __builtin_amdgcn_s_memrealtime();
                    while (__builtin_amdgcn_s_memrealtime() - t0 < (unsigned long long)(MK_STAG_US * 100)) __builtin_amdgcn_s_sleep(32);
                }
                const bf16* Bg = (const bf16*)(F.ws + WS_WPG) + (size_t)L * DM * DM;
                if (FUSE_FINAL_OK && args.pad != 0 && L == DEPTH - 1) {
                    pg8::FinalEpi EF{F.out, F.ws, inp<14>(F) + (size_t)L * DM, inp<15>(F)};
                    fast_gemm_final(F, HIN, Bg, EF);
                } else {
                EpiGate E{HIN, (const bf16*)(F.ws + WS_LO1), (L == DEPTH - 1) ? F.out : (float*)nullptr, MIX, (bf16*)F.out, PE, inp<14>(F) + (size_t)L * DM, SSQ1, SSQ2};
                if (MK_NAIVE & 1) naive_gemm(F, HIN, DM, Bg, DM, DM, E);
                else fast_gemm(F, HIN, DM, Bg, DM, DM, E);
                }
            }
        }
        if (ph + 1 < args.ph_hi) { xcd_barrier(bar, F.tid);
#if MK_PROBE == 4
            xcd_barrier(bar, F.tid);
#endif
        }
    }
}

extern "C" void kernel_launch(void* const* d_in, const int* in_sizes, int n_in, void* d_out, int out_size, void* d_ws, size_t ws_size, hipStream_t stream) {
    static int grid = 0;
    if (grid == 0) {
        if (n_in != 16 || in_sizes[0] != T * DM || out_size != T * DM || ws_size < WS_END) {
            fprintf(stderr, "kernel_launch: unexpected shapes (n_in %d, in0 %d, out %d, ws %zu); nothing launched\n", n_in, n_in > 0 ? in_sizes[0] : -1, out_size, ws_size); grid = -1; return; }
        int dev = 0, cus = 0, per_cu = 0;
        if (hipGetDevice(&dev) != hipSuccess || hipDeviceGetAttribute(&cus, hipDeviceAttributeMultiprocessorCount, dev) != hipSuccess) { grid = -1; return; }
        if (hipFuncSetAttribute((const void*)trunk_fwd, hipFuncAttributeMaxDynamicSharedMemorySize, LDS_BYTES) != hipSuccess) { fprintf(stderr, "kernel_launch: hipFuncSetAttribute failed\n"); grid = -1; return; }
        if (hipOccupancyMaxActiveBlocksPerMultiprocessor(&per_cu, (const void*)trunk_fwd, NTHREADS, LDS_BYTES) != hipSuccess || per_cu < 1)
            fprintf(stderr, "kernel_launch: note: occupancy query reports %d workgroups per CU\n", per_cu);
        (void)hipGetLastError();
        grid = cus;
    }
    if (grid < 0) return;
    if (hipMemsetAsync((char*)d_ws + WS_CTL, 0, CTL_ZERO_BYTES, stream) != hipSuccess) { fprintf(stderr, "kernel_launch: hipMemsetAsync failed\n"); return; }
    Args a{};
    const bool fuse_final = FUSE_FINAL_OK && grid == 256 && MK_N_LAUNCHES == 1;
    a.pad = fuse_final ? 1 : 0;
    for (int i = 0; i < 16; ++i) a.in[i] = d_in[i];
    a.out = (float*)d_out; a.ws = (unsigned char*)d_ws;
    for (int li = 0; li < MK_N_LAUNCHES; ++li) {
        a.ph_lo = (MK_N_LAUNCHES == 1) ? 0 : li; a.ph_hi = (MK_N_LAUNCHES == 1) ? (fuse_final ? N_PHASES - 1 : N_PHASES) : li + 1; a.li = li;
        hipLaunchKernelGGL(trunk_fwd, dim3(grid), dim3(NTHREADS), LDS_BYTES, stream, a);
        const hipError_t le = hipPeekAtLastError();
        if (le != hipSuccess) { fprintf(stderr, "kernel_launch: launch %d failed: %s\n", li, hipGetErrorName(le)); break; }
    }
}
```

```cpp
#include <hip/hip_runtime.h>
#include <cstdio>
#include <cstdint>

#ifndef MK_N_LAUNCHES
#define MK_N_LAUNCHES 1
#endif
#ifndef MK_NAIVE
#define MK_NAIVE 0x0
#endif

#ifndef MK_STAG_US
#define MK_STAG_US 0
#endif
#ifndef MK_FUSE_FINAL
#define MK_FUSE_FINAL 1
#endif
#ifndef MK_PRIO
#define MK_PRIO 1
#endif
#ifndef MK_KPF
#define MK_KPF 4
#endif
#ifndef MK_LO
#define MK_LO 0
#endif
#ifndef MK_NOHOIST
#define MK_NOHOIST 0
#endif
#ifndef MK_PROBE
#define MK_PROBE 0
#endif
#ifndef MK_DUP
#define MK_DUP 0
#endif
__device__ __forceinline__ int opaque_i(int v) { asm volatile("" : "+s"(v)); return v; }
#if MK_DUP
#define REP(k) _Pragma("nounroll") for (int rep_ = 0, nrep_ = (((MK_DUP >> (k)) & 1) ? opaque_i(2) : 1); rep_ < nrep_; ++rep_, relaunder(F))
#define REP6 _Pragma("nounroll") for (int rep_ = 0, nrep_ = (((MK_DUP >> 6) & 1) ? opaque_i(1 + (L == 0)) : 1); rep_ < nrep_; ++rep_, relaunder(F))
#else
#define REP(k)
#define REP6
#endif
constexpr int NB = 16, SEQ = 2048, T = NB * SEQ, DM = 1024, DIN = 3008, DINP = 3072, DPLE = 256, DEPTH = 2;
#ifndef MK_ABSORB
#define MK_ABSORB 1
#endif
constexpr int DUP = MK_ABSORB ? 768 : 1792, KUP = MK_ABSORB ? 256 : 384;
constexpr float EPS = 1e-6f;
constexpr float LOG2E = 1.4426950408889634f;
constexpr float QA_SCALE = 0.125f * LOG2E;
constexpr float QB_SCALE = 0.07216878364870322f * LOG2E;
constexpr int ZC_QA = 0, ZC_KA = 512, ZC_VA = 1024, ZC_GA = 1536, ZC_GB = 2048, ZC_CQ = 2560, ZC_CKV = 2816, ZC_KR = 2944, ZC_PAD = 3008;
constexpr int UC_QN = 0, UC_QR = 512, UC_KN = 768, UC_V = 1280;

constexpr size_t MiB = 1u << 20;
constexpr size_t WS_CTL = 0, CTL_ZERO_BYTES = 128 * 1024;
constexpr size_t WS_WIN = 1 * MiB;
constexpr size_t WS_WUP = 13 * MiB;
constexpr size_t WS_WOUT = 16 * MiB;
constexpr size_t WS_WPG = 20 * MiB;
constexpr size_t WS_WPE = 24 * MiB;
constexpr size_t WS_CS = 25 * MiB;
constexpr size_t WS_SSQ1 = 33 * MiB;
constexpr size_t WS_SSQ2 = 37 * MiB;
constexpr size_t WS_SSQQ = 41 * MiB;
constexpr size_t WS_SSQKV = 42 * MiB;
constexpr size_t WS_PB = 43 * MiB;
constexpr size_t WS_BUFA = 75 * MiB;
constexpr size_t WS_BUFB = 139 * MiB;
constexpr size_t WS_Z = 203 * MiB;
constexpr size_t WS_U = 395 * MiB;
constexpr size_t WS_END = 507 * MiB;
constexpr size_t WS_LO1 = WS_Z + 64 * MiB;
constexpr size_t WS_CKVN = WS_U + 48 * MiB;
constexpr size_t WS_WVT = WS_WUP + 2 * MiB;

constexpr int NWAVES = 8, NTHREADS = 512;
constexpr int RING_BYTES = 131072, LDSCTL_OFF = RING_BYTES, MISC_OFF = LDSCTL_OFF + 320, LDS_BYTES = 147456;

#define GAS __attribute__((address_space(1)))
#define LAS __attribute__((address_space(3)))
typedef unsigned short bf16;
typedef unsigned v4u __attribute__((ext_vector_type(4)));
typedef unsigned v2u __attribute__((ext_vector_type(2)));
typedef float f32x4 __attribute__((ext_vector_type(4)));
typedef float f32x2 __attribute__((ext_vector_type(2)));
typedef float f32x16 __attribute__((ext_vector_type(16)));
typedef short bf16x8 __attribute__((ext_vector_type(8)));
typedef short s16x4 __attribute__((ext_vector_type(4)));
typedef __bf16 bf16x2_t __attribute__((ext_vector_type(2)));
typedef GAS unsigned gu32;
#define RLX_AGENT __ATOMIC_RELAXED, __HIP_MEMORY_SCOPE_AGENT

constexpr float LOG2E_ = 1.4426950408889634f;
__device__ __forceinline__ float bf2f(unsigned b) { return __uint_as_float(b << 16); }
__device__ __forceinline__ unsigned f2bf(float f) { unsigned u = __float_as_uint(f); return (u + 0x7fffu + ((u >> 16) & 1u)) >> 16; }
__device__ __forceinline__ unsigned pk2(float lo, float hi) { f32x2 v = {lo, hi}; bf16x2_t b = __builtin_convertvector(v, bf16x2_t); return __builtin_bit_cast(unsigned, b); }
__device__ __forceinline__ float sigmoid_f(float v) { return __builtin_amdgcn_rcpf(1.0f + __builtin_amdgcn_exp2f(v * -LOG2E_)); }
__device__ __forceinline__ float silu_f(float v) { return v * sigmoid_f(v); }
__device__ __forceinline__ void unpack8(v4u w, float (&f)[8]) {
    f[0] = bf2f(w.x & 0xffffu); f[1] = bf2f(w.x >> 16); f[2] = bf2f(w.y & 0xffffu); f[3] = bf2f(w.y >> 16);
    f[4] = bf2f(w.z & 0xffffu); f[5] = bf2f(w.z >> 16); f[6] = bf2f(w.w & 0xffffu); f[7] = bf2f(w.w >> 16);
}
__device__ __forceinline__ v4u pack8(const float (&f)[8]) { v4u w; w.x = pk2(f[0], f[1]); w.y = pk2(f[2], f[3]); w.z = pk2(f[4], f[5]); w.w = pk2(f[6], f[7]); return w; }

__device__ __forceinline__ void join8(v4u hi, v4u lo, float (&f)[8]) { float a[8], b[8]; unpack8(hi, a); unpack8(lo, b);
#pragma unroll
    for (int j = 0; j < 8; ++j) f[j] = MK_LO ? a[j] + b[j] : a[j]; }
__device__ __forceinline__ void split8(const float (&f)[8], v4u& hi, v4u& lo) { hi = pack8(f); float a[8], d[8]; unpack8(hi, a);
#pragma unroll
    for (int j = 0; j < 8; ++j) d[j] = f[j] - a[j];
    lo = pack8(d); }
__device__ const float INV_FREQ[32] = {
    1.000000000e+00f, 7.498942614e-01f, 5.623413324e-01f, 4.216965139e-01f, 3.162277639e-01f, 2.371373773e-01f, 1.778279394e-01f, 1.333521307e-01f,
    1.000000015e-01f, 7.498941571e-02f, 5.623413250e-02f, 4.216965288e-02f, 3.162277490e-02f, 2.371373773e-02f, 1.778279431e-02f, 1.333521493e-02f,
    9.999999776e-03f, 7.498941850e-03f, 5.623413250e-03f, 4.216964822e-03f, 3.162277630e-03f, 2.371373586e-03f, 1.778279431e-03f, 1.333521446e-03f,
    1.000000047e-03f, 7.498942432e-04f, 5.623413017e-04f, 4.216965172e-04f, 3.162277571e-04f, 2.371373703e-04f, 1.778279402e-04f, 1.333521504e-04f};

#define XB_TMO      128
#define XB_XCNT(j)  (256  + 64 * (j))
#define XB_XSUB(j)  (1280 + 64 * (j))
#define XB_XGEN(j)  (2304 + 64 * (j))
#define XB_TOP      3328
#define XB_TOPGEN   3392
#define XCD_BAR_WORDS 3456
#define XB_SPIN_CAP (1u << 22)
constexpr int CW_BAR = 4096;

__device__ __forceinline__ unsigned xb_ld(unsigned* p)              { return __hip_atomic_load(p, __ATOMIC_RELAXED, __HIP_MEMORY_SCOPE_AGENT); }
__device__ __forceinline__ unsigned xb_add(unsigned* p, unsigned v) { return __hip_atomic_fetch_add(p, v, __ATOMIC_RELAXED, __HIP_MEMORY_SCOPE_AGENT); }
__device__ __forceinline__ unsigned xb_xcc_id() { return (unsigned)__builtin_amdgcn_s_getreg((3 << 11) | 20) & 0xFu; }
#define XB_SPIN(cond, bar) do { unsigned _sp = 0; while (cond) { __builtin_amdgcn_s_sleep(1); \
    if ((++_sp & 255u) == 0u) { if (xb_ld(&(bar)[XB_TMO])) break; if (_sp > XB_SPIN_CAP) { atomicAdd(&(bar)[XB_TMO], 1u); break; } } } } while (0)
struct XcdBarrier { unsigned* bar; unsigned x; volatile LAS unsigned* st; };
__device__ __forceinline__ XcdBarrier xcd_barrier_post(unsigned* bar, volatile LAS unsigned* st) {
    XcdBarrier b; b.bar = bar; b.x = xb_xcc_id(); b.st = st;
    if (threadIdx.x == 0) (void)xb_add(&bar[XB_XCNT(b.x)], 1u);
    return b;
}
__device__ __forceinline__ void xcd_barrier_complete(unsigned* bar, unsigned x_, unsigned& nloc, unsigned& nx) {
    const unsigned G = gridDim.x * gridDim.y * gridDim.z;
    unsigned x = x_; asm volatile("" : "+s"(x));
    unsigned sum, cnt, mine, sp = 0u;
    for (;;) {
        sum = 0u; cnt = 0u; mine = 0u;
#pragma unroll
        for (unsigned j = 0; j < 16; ++j) { const unsigned c = xb_ld(&bar[XB_XCNT(j)]); sum += c; cnt += (c > 0u) ? 1u : 0u; mine = (j == x) ? c : mine; }
        if (sum == G) break;
        __builtin_amdgcn_s_sleep(1);
        if ((++sp & 255u) == 0u) { if (xb_ld(&bar[XB_TMO])) break; if (sp > XB_SPIN_CAP) { atomicAdd(&bar[XB_TMO], 1u); break; } }
    }
    nloc = mine > 0u ? mine : 1u; nx = cnt > 0u ? cnt : 1u;
}
__device__ __forceinline__ void xcd_barrier(const XcdBarrier& b, const int tid) {
    asm volatile("s_waitcnt vmcnt(0)" ::: "memory");
    __syncthreads();
    if (tid == 0) {
        unsigned* bar = b.bar;
        __builtin_amdgcn_s_waitcnt(0);
        unsigned nloc = b.st[0], nx = b.st[1];
        if (nloc == 0u) { xcd_barrier_complete(bar, b.x, nloc, nx); b.st[0] = nloc; b.st[1] = nx; }
        const unsigned old = xb_add(&bar[XB_XSUB(b.x)], 1u);
        const unsigned gen = old / nloc;
        if (old + 1u == (gen + 1u) * nloc) {
            __builtin_amdgcn_fence(__ATOMIC_RELEASE, "agent");
            asm volatile("s_waitcnt vmcnt(0)" ::: "memory");
            const unsigned og = xb_add(&bar[XB_TOP], 1u);
            const unsigned tg = og / nx;
            if (og + 1u == (tg + 1u) * nx) xb_add(&bar[XB_TOPGEN], 1u);
            else XB_SPIN(xb_ld(&bar[XB_TOPGEN]) == tg, bar);
            __builtin_amdgcn_fence(__ATOMIC_ACQUIRE, "agent");
            xb_add(&bar[XB_XGEN(b.x)], 1u);
            asm volatile("s_waitcnt vmcnt(0)" ::: "memory");
        } else {
            XB_SPIN(xb_ld(&bar[XB_XGEN(b.x)]) == gen, bar);
            __builtin_amdgcn_fence(__ATOMIC_ACQUIRE, "agent");
            asm volatile("s_waitcnt vmcnt(0)" ::: "memory");
        }
    }
    __syncthreads();
}

struct Args { const void* in[16]; float* out; unsigned char* ws; int ph_lo, ph_hi, li, pad; };
struct Frame {
    LAS unsigned char* lds;
    unsigned char* ws;
    const Args* a;
    int tid, lane, wave, vcu, G, bx;
    float* out;
};
__device__ __forceinline__ void relaunder(Frame& F) {
    int tid = F.tid; asm volatile("" : "+v"(tid)); F.tid = tid; F.lane = tid & 63; F.wave = __builtin_amdgcn_readfirstlane(tid >> 6);
    GAS unsigned char* w = (GAS unsigned char*)F.ws; asm volatile("" : "+s"(w)); F.ws = (unsigned char*)w;
    GAS float* o = (GAS float*)F.out; asm volatile("" : "+s"(o)); F.out = (float*)o;
    unsigned lb = 0; asm volatile("" : "+s"(lb)); F.lds = F.lds + lb;
}
template <int I> __device__ __forceinline__ const float* inp(const Frame& F) { const GAS float* p = (const GAS float*)F.a->in[I]; asm volatile("" : "+s"(p)); return (const float*)p; }
__device__ __forceinline__ float wave_sum(float v) {
#pragma unroll
    for (int o = 1; o < 64; o <<= 1) v += __shfl_xor(v, o);
    return v;
}
__device__ __forceinline__ float wave_max(float v) {
#pragma unroll
    for (int o = 1; o < 64; o <<= 1) v = fmaxf(v, __shfl_xor(v, o));
    return v;
}

#ifndef MK_NEGM
#define MK_NEGM 1
#endif
#ifndef MK_SP
#define MK_SP 3
#endif
#ifndef MK_SPKPF
#define MK_SPKPF 4
#endif
#ifndef MK_OROWS
#define MK_OROWS 1
#endif
#ifndef MK_RES32
#define MK_RES32 0
#endif
#ifndef MK_WT
#define MK_WT 0
#endif
template <int BIT = 1> __device__ __forceinline__ void st16(void* base, size_t byte_off, const v4u& v) {
    if (MK_WT & BIT) { const __amdgpu_buffer_rsrc_t r = __builtin_amdgcn_make_buffer_rsrc(base, (short)0, 0x7fffffff, 0x00020000); __builtin_amdgcn_raw_buffer_store_b128(v, r, (int)(unsigned)byte_off, 0, 16); }
    else *(v4u*)((unsigned char*)base + byte_off) = v;
}
__device__ __forceinline__ void st8(void* base, size_t byte_off, const v2u& v) {
    if (MK_WT & 2) { const __amdgpu_buffer_rsrc_t r = __builtin_amdgcn_make_buffer_rsrc(base, (short)0, 0x7fffffff, 0x00020000); __builtin_amdgcn_raw_buffer_store_b64(v, r, (int)(unsigned)byte_off, 0, 16); }
    else *(v2u*)((unsigned char*)base + byte_off) = v;
}

struct WPtrs { const float *norm_mix, *w_in, *g_q, *w_uq, *g_kv, *w_ukv, *w_out, *norm_ple, *w_pe, *w_pg; };
__device__ __forceinline__ float wsrc(const WPtrs& F, int mat, int L, int n, int k) {
    if (mat == 0) {
        int sc;
        if (n < 2048) sc = n;
        else if (n < ZC_CQ) sc = 2496 + (n - ZC_GB);
        else if (n < ZC_CKV) sc = 2048 + (n - ZC_CQ);
        else if (n < ZC_KR) sc = 2304 + (n - ZC_CKV);
        else if (n < ZC_PAD) { const int j = n - ZC_KR; sc = 2432 + (j >> 1) + 32 * (j & 1); }
        else return 0.f;
        return F.w_in[((size_t)L * DM + k) * DIN + sc] * F.norm_mix[L * DM + k];
    } else if (mat == 1 && MK_ABSORB) {
        if (n < UC_QR) return 0.f;
        const int j = (n - UC_QR) & 63, hh = (n - UC_QR) >> 6;
        return F.w_uq[((size_t)L * 256 + k) * 768 + hh * 192 + 128 + (j >> 1) + 32 * (j & 1)] * F.g_q[L * 256 + k];
    } else if (mat == 1) {
        if (n < UC_KN) {
            if (k >= 256) return 0.f;
            int sc;
            if (n < UC_QR) sc = (n >> 7) * 192 + (n & 127);
            else { const int j = (n - UC_QR) & 63, hh = (n - UC_QR) >> 6; sc = hh * 192 + 128 + (j >> 1) + 32 * (j & 1); }
            return F.w_uq[((size_t)L * 256 + k) * 768 + sc] * F.g_q[L * 256 + k];
        } else {
            if (k < 256) return 0.f;
            const int kk = k - 256; int sc;
            if (n < UC_V) { const int m = n - UC_KN; sc = (m >> 7) * 256 + (m & 127); }
            else { const int m = n - UC_V; sc = (m >> 7) * 256 + 128 + (m & 127); }
            return F.w_ukv[((size_t)L * 128 + kk) * 1024 + sc] * F.g_kv[L * 128 + kk];
        }
    } else if (mat == 2) return F.w_out[((size_t)L * DM + k) * DM + n];
    else if (mat == 3) return F.w_pg[((size_t)L * DM + k) * DM + n] * F.norm_ple[L * DM + k];
    else return F.w_pe[((size_t)L * DPLE + k) * DM + n];
}
__device__ __forceinline__ void p0_prologue(const Frame& F) {
    const WPtrs W{inp<3>(F), inp<4>(F), inp<6>(F), inp<7>(F), inp<8>(F), inp<9>(F), inp<10>(F), inp<11>(F), inp<12>(F), inp<13>(F)};
    const float* xin = inp<0>(F); const float* pin = inp<1>(F); const int* positions = (const int*)inp<2>(F);
    const int gw = F.vcu * NWAVES + F.wave, NGW = F.G * NWAVES;
    {
        LAS float* scr = (LAS float*)F.lds + F.wave * (64 * 33);
        constexpr int UPN0 = MK_ABSORB ? UC_QR : 0;
        constexpr int NI0 = (DINP / 32) * (DM / 64), NI1 = ((DUP - UPN0) / 32) * (KUP / 64), NI2 = 32 * 16, NI3 = 32 * 16, NI4 = 32 * 4;
        constexpr int NIL = NI0 + NI1 + NI2 + NI3 + NI4;
        const int lane = F.lane;
        for (int it = gw; it < 2 * NIL; it += NGW) {
            const int L = it / NIL; int r = it % NIL; int mat, K; size_t base;
            if (r < NI0) { mat = 0; K = DM; base = WS_WIN + (size_t)L * DINP * DM * 2; }
            else if ((r -= NI0) < NI1) { mat = 1; K = KUP; base = WS_WUP + (size_t)L * DUP * KUP * 2; }
            else if ((r -= NI1) < NI2) { mat = 2; K = DM; base = WS_WOUT + (size_t)L * DM * DM * 2; }
            else if ((r -= NI2) < NI3) { mat = 3; K = DM; base = WS_WPG + (size_t)L * DM * DM * 2; }
            else { r -= NI3; mat = 4; K = DPLE; base = WS_WPE + (size_t)L * DM * DPLE * 2; }
            const int nkt = K / 64, tn = r / nkt, tk = r % nkt, n0 = tn * 32 + (mat == 1 ? UPN0 : 0), k0 = tk * 64;
            float wv[32];
#if MK_ABSORB
            {
                const int n = n0 + (lane & 31);
                const float* src; const float* scl = nullptr; int ld, col; float mul = 1.0f;
                if (mat == 0) { ld = DIN; src = W.w_in + (size_t)L * DM * DIN; scl = W.norm_mix + L * DM;
                    if (n < 2048) col = n;
                    else if (n < ZC_CQ) col = 2496 + (n - ZC_GB);
                    else if (n < ZC_CKV) col = 2048 + (n - ZC_CQ);
                    else if (n < ZC_KR) col = 2304 + (n - ZC_CKV);
                    else if (n < ZC_PAD) { const int j = n - ZC_KR; col = 2432 + (j >> 1) + 32 * (j & 1); }
                    else { col = 0; mul = 0.f; } }
                else if (mat == 1) { const int j = (n - UC_QR) & 63, hh = (n - UC_QR) >> 6; ld = 768; src = W.w_uq + (size_t)L * 256 * 768; scl = W.g_q + L * 256; col = hh * 192 + 128 + (j >> 1) + 32 * (j & 1); }
                else if (mat == 2) { ld = DM; src = W.w_out + (size_t)L * DM * DM; col = n; }
                else if (mat == 3) { ld = DM; src = W.w_pg + (size_t)L * DM * DM; scl = W.norm_ple + L * DM; col = n; }
                else { ld = DM; src = W.w_pe + (size_t)L * DPLE * DM; col = n; }
                const float sc = (scl != nullptr) ? scl[k0 + lane] * mul : mul;
                const bool contig = (mat != 1) && !(mat == 0 && n0 >= ZC_KR);
                if (contig) {
                    const int kk = lane >> 3, n4 = lane & 7;
                    const int col0 = __shfl(col, 0);
                    const f32x4* p4 = (const f32x4*)(src + (size_t)(k0 + kk) * ld + col0 + 4 * n4);
                    f32x4 w4[8];
#pragma unroll
                    for (int i = 0; i < 8; ++i) w4[i] = *(const f32x4*)((const float*)p4 + (size_t)(8 * i) * ld);
#pragma unroll
                    for (int i = 0; i < 8; ++i) { const float sk = __shfl(sc, 8 * i + kk); LAS float* d = scr + (8 * i + kk) * 33 + 4 * n4;
                        d[0] = w4[i].x * sk; d[1] = w4[i].y * sk; d[2] = w4[i].z * sk; d[3] = w4[i].w * sk; }
                } else {
                    const float* p = src + (size_t)(k0 + (lane >> 5)) * ld + col;
#pragma unroll
                    for (int i = 0; i < 32; ++i) wv[i] = p[(size_t)(2 * i) * ld];
#pragma unroll
                    for (int i = 0; i < 32; ++i) wv[i] *= __shfl(sc, 2 * i + (lane >> 5));
#pragma unroll
                    for (int i = 0; i < 32; ++i) scr[(2 * i + (lane >> 5)) * 33 + (lane & 31)] = wv[i];
                }
            }
#else
#pragma unroll
            for (int i = 0; i < 32; ++i) wv[i] = wsrc(W, mat, L, n0 + (lane & 31), k0 + 2 * i + (lane >> 5));
#pragma unroll
            for (int i = 0; i < 32; ++i) scr[(2 * i + (lane >> 5)) * 33 + (lane & 31)] = wv[i];
#endif
            asm volatile("s_waitcnt lgkmcnt(0)" ::: "memory");
            bf16* dst = (bf16*)(F.ws + base);
            const int c = lane & 7;
#pragma unroll
            for (int j = 0; j < 4; ++j) { const int n = (lane >> 3) + 8 * j; const LAS float* sp = scr + (8 * c) * 33 + n;
                v4u o; o.x = pk2(sp[0 * 33], sp[1 * 33]); o.y = pk2(sp[2 * 33], sp[3 * 33]); o.z = pk2(sp[4 * 33], sp[5 * 33]); o.w = pk2(sp[6 * 33], sp[7 * 33]);
                *(v4u*)(dst + (size_t)(n0 + n) * K + k0 + 8 * c) = o; }
            asm volatile("s_waitcnt lgkmcnt(0)" ::: "memory");
        }
    }
    {
        bf16* hb = (bf16*)(F.ws + WS_BUFA); float* ssq = (float*)(F.ws + WS_SSQ2);
        for (int m0 = gw * 4; m0 < T; m0 += NGW * 4) {
            f32x4 v[4][4];
#pragma unroll
            for (int r = 0; r < 4; ++r) { const f32x4* xr = (const f32x4*)(xin + (size_t)(m0 + r) * DM) + F.lane;
#pragma unroll
                for (int j = 0; j < 4; ++j) v[r][j] = xr[64 * j]; }
#pragma unroll
            for (int r = 0; r < 4; ++r) {
                float sq = 0.f;
#pragma unroll
                for (int j = 0; j < 4; ++j) sq += (v[r][j].x * v[r][j].x + v[r][j].y * v[r][j].y) + (v[r][j].z * v[r][j].z + v[r][j].w * v[r][j].w);
                sq = wave_sum(sq);
                v2u* o8 = (v2u*)(hb + (size_t)(m0 + r) * DM) + F.lane;
#pragma unroll
                for (int j = 0; j < 4; ++j) { v2u w; w.x = pk2(v[r][j].x, v[r][j].y); w.y = pk2(v[r][j].z, v[r][j].w); o8[64 * j] = w; }
                if (F.lane < 32) ssq[(size_t)(m0 + r) * 32 + F.lane] = (F.lane == 0) ? sq : 0.f;
            }
        }
    }
    const int gt = F.vcu * NTHREADS + F.tid, NGT = F.G * NTHREADS;
    {
        v4u* pb = (v4u*)(F.ws + WS_PB);
        constexpr int NPI = 2 * T * DPLE / 8;
        for (int i0 = gt; i0 < NPI; i0 += 4 * NGT) {
            f32x4 a[4], b[4];
#pragma unroll
            for (int q = 0; q < 4; ++q) { const int i = i0 + q * NGT; if (i < NPI) { a[q] = ((const f32x4*)pin)[2 * i]; b[q] = ((const f32x4*)pin)[2 * i + 1]; } }
#pragma unroll
            for (int q = 0; q < 4; ++q) { const int i = i0 + q * NGT; if (i < NPI) { v4u w; w.x = pk2(a[q].x, a[q].y); w.y = pk2(a[q].z, a[q].w); w.z = pk2(b[q].x, b[q].y); w.w = pk2(b[q].z, b[q].w); pb[i] = w; } }
        }
    }
#if MK_ABSORB
    {
        {
            __syncthreads();
            LAS float* As = (LAS float*)F.lds;
            LAS float* Bs = As + 8 * 129;
            bf16* wup = (bf16*)(F.ws + WS_WUP);
            for (int it = F.vcu; it < 256; it += F.G) {
                const int L = it >> 7, hh = (it >> 5) & 3, k0 = (it & 31) * 8;
                {
                    float ta[2], tg[2], tb[32];
#pragma unroll
                    for (int i = 0; i < 2; ++i) { const int e = F.tid + i * NTHREADS, kk = e >> 7, d = e & 127; ta[i] = W.w_uq[((size_t)L * 256 + k0 + kk) * 768 + hh * 192 + d]; tg[i] = W.g_q[L * 256 + k0 + kk]; }
#pragma unroll
                    for (int i = 0; i < 32; ++i) { const int e = F.tid + i * NTHREADS, l = e >> 7, d = e & 127; tb[i] = W.w_ukv[((size_t)L * 128 + l) * 1024 + hh * 256 + d]; }
#pragma unroll
                    for (int i = 0; i < 2; ++i) { const int e = F.tid + i * NTHREADS, kk = e >> 7, d = e & 127; As[kk * 129 + d] = ta[i] * tg[i]; }
#pragma unroll
                    for (int i = 0; i < 32; ++i) { const int e = F.tid + i * NTHREADS, l = e >> 7, d = e & 127; Bs[l * 129 + d] = tb[i]; }
                }
                __syncthreads();
                const int kk = F.tid & 7, l0 = F.tid >> 3;
                float acc0 = 0.f, acc1 = 0.f;
                for (int d = 0; d < 128; ++d) { const float av = As[kk * 129 + d]; acc0 += av * Bs[l0 * 129 + d]; acc1 += av * Bs[(l0 + 64) * 129 + d]; }
                wup[((size_t)L * DUP + hh * 128 + l0) * KUP + k0 + kk] = (bf16)f2bf(acc0);
                wup[((size_t)L * DUP + hh * 128 + l0 + 64) * KUP + k0 + kk] = (bf16)f2bf(acc1);
                __syncthreads();
            }
        }
        bf16* wvt = (bf16*)(F.ws + WS_WVT);
        for (int i = gt; i < 2 * 65536; i += NGT) {
            const int j = i & 7, r32 = (i >> 3) & 31, hi = (i >> 8) & 1, sx = (i >> 9) & 1, d = (i >> 10) & 3, blk = (i >> 12) & 3, hh = (i >> 14) & 3, L = i >> 16;
            const int lat = 32 * d + 16 * sx + 8 * (j >> 2) + 4 * hi + (j & 3);
            wvt[i] = (bf16)f2bf(W.w_ukv[((size_t)L * 128 + lat) * 1024 + hh * 256 + 128 + 32 * blk + r32]);
        }
    }
#endif
    {
        f32x2* cs = (f32x2*)(F.ws + WS_CS);
        for (int i = gt; i < T * 32; i += NGT) {
            const int t = i >> 5, fi = i & 31;
            const float angf = (float)positions[t] * INV_FREQ[fi];
            const double a = (double)angf;
            const double kq = __builtin_rint(a * 0.63661977236758134308);
            const double r = (a - kq * 1.57079632679489655800) - kq * 6.12323399573676603587e-17;
            const double r2 = r * r;
            const double sn = r * (1.0 + r2 * (-1.0 / 6 + r2 * (1.0 / 120 + r2 * (-1.0 / 5040 + r2 * (1.0 / 362880 + r2 * (-1.0 / 39916800))))));
            const double cn = 1.0 + r2 * (-0.5 + r2 * (1.0 / 24 + r2 * (-1.0 / 720 + r2 * (1.0 / 40320 + r2 * (-1.0 / 3628800 + r2 * (1.0 / 479001600))))));
            const int q = (int)((long long)kq & 3);
            const double c = (q == 0) ? cn : (q == 1) ? -sn : (q == 2) ? -cn : sn;
            const double s = (q == 0) ? sn : (q == 1) ? cn : (q == 2) ? -sn : -cn;
            cs[i] = (f32x2){(float)c, (float)s};
        }
    }
}

__device__ __forceinline__ void ckvn_pass(const Frame& F, int L) {
    const bf16* Z = (const bf16*)(F.ws + WS_Z); bf16* CK = (bf16*)(F.ws + WS_CKVN); const float* ssq = (const float*)(F.ws + WS_SSQKV); const float* gk = inp<8>(F) + L * 128;
    const int gt = F.vcu * NTHREADS + F.tid, NGT = F.G * NTHREADS;
    for (int i0 = gt; i0 < T * 16; i0 += 4 * NGT) {
        f32x4 sq[4], g0[4], g1[4]; v4u zz[4];
#pragma unroll
        for (int q = 0; q < 4; ++q) { const int i = (i0 + q * NGT < T * 16) ? i0 + q * NGT : i0; const int row = i >> 4, c = i & 15;
            sq[q] = *(const f32x4*)(ssq + (size_t)row * 4); zz[q] = *(const v4u*)(Z + (size_t)row * DINP + ZC_CKV + 8 * c);
            if (q == 0 || (NGT & 15) != 0) { g0[q] = *(const f32x4*)(gk + 8 * c); g1[q] = *(const f32x4*)(gk + 8 * c + 4); } else { g0[q] = g0[0]; g1[q] = g1[0]; } }
#pragma unroll
        for (int q = 0; q < 4; ++q) { const int i = i0 + q * NGT; if (i < T * 16) { const int row = i >> 4, c = i & 15;
            const float r = rsqrtf(((sq[q].x + sq[q].y) + (sq[q].z + sq[q].w)) * (1.0f / 128) + EPS);
            float v[8]; unpack8(zz[q], v);
            v[0] *= r * g0[q].x; v[1] *= r * g0[q].y; v[2] *= r * g0[q].z; v[3] *= r * g0[q].w; v[4] *= r * g1[q].x; v[5] *= r * g1[q].y; v[6] *= r * g1[q].z; v[7] *= r * g1[q].w;
            st16<4>(CK, ((size_t)row * 128 + 8 * c) * 2, pack8(v)); } }
    }
}

struct EpiP1 {
    static constexpr bool HAS_SSQ = true; static constexpr int NB = 4; static constexpr bool PRE_RS = true;
    bf16* Z; const float* ssq_h; float* ssq_q; float* ssq_kv; const f32x2* cs; const LAS float* rs_lds = nullptr; bool rs_ok = false;
    __device__ __forceinline__ float rowsum_part(int row, int part, int) const { const f32x4* s = (const f32x4*)(ssq_h + (size_t)row * 32 + part * 8); const f32x4 a = s[0], b = s[1]; return ((a.x + a.y) + (a.z + a.w)) + ((b.x + b.y) + (b.z + b.w)); }
    __device__ __forceinline__ float rowscale_from(float tot, int) const { return rsqrtf(tot * (1.0f / DM) + EPS); }
    struct Pre {}; struct ColPre {};
    __device__ __forceinline__ ColPre colpre(int) const { return ColPre{}; }
    __device__ __forceinline__ Pre pre8(int, int) const { return Pre{}; }
    __device__ __forceinline__ float run8(int row, int col0, float rs, float (&v)[8], const Pre&, const ColPre&) const {
        float ss = 0.f;
#pragma unroll
        for (int j = 0; j < 8; ++j) v[j] *= rs;
        if (col0 < ZC_KA) {
#pragma unroll
            for (int j = 0; j < 8; ++j) v[j] *= QA_SCALE;
        } else if (col0 >= ZC_GA && col0 < ZC_CQ) {
#pragma unroll
            for (int j = 0; j < 8; ++j) v[j] = silu_f(v[j]);
        } else if (col0 >= ZC_KR && col0 < ZC_PAD) {
            const f32x4* c4 = (const f32x4*)(cs + (size_t)row * 32 + ((col0 - ZC_KR) >> 1));
            const f32x4 c01 = c4[0], c23 = c4[1];
            const float cc[4] = {c01.x, c01.z, c23.x, c23.z}, sn[4] = {c01.y, c01.w, c23.y, c23.w};
#pragma unroll
            for (int i = 0; i < 4; ++i) { const float x1 = v[2 * i], x2 = v[2 * i + 1]; v[2 * i] = x1 * cc[i] - x2 * sn[i]; v[2 * i + 1] = x2 * cc[i] + x1 * sn[i]; }
        }
        const v4u w = pack8(v);
        st16(Z, ((size_t)row * DINP + col0) * 2, w);
        if (col0 >= ZC_CQ && col0 < ZC_KR) { float f[8]; unpack8(w, f);
#pragma unroll
            for (int j = 0; j < 8; ++j) ss += f[j] * f[j]; }
        return ss;
    }
    __device__ __forceinline__ void ssq(int row, int grp, float s) const {
        if (grp >= ZC_CQ / 32 && grp < ZC_CKV / 32) ssq_q[(size_t)row * 8 + (grp - ZC_CQ / 32)] = s;
        else if (grp >= ZC_CKV / 32 && grp < ZC_KR / 32) ssq_kv[(size_t)row * 4 + (grp - ZC_CKV / 32)] = s;
    }
};
struct EpiUp {
    static constexpr bool HAS_SSQ = false; static constexpr bool PRE_RS = false; static constexpr bool rs_ok = false; static constexpr int NB = 4;
    bf16* U; const float* ssq_q; const float* ssq_kv; const f32x2* cs;
    __device__ __forceinline__ float rowsum_part(int row, int part, int col0) const {
        if (col0 < UC_KN) { const f32x2 a = *(const f32x2*)(ssq_q + (size_t)row * 8 + part * 2); return a.x + a.y; }
        return ssq_kv[(size_t)row * 4 + part];
    }
    __device__ __forceinline__ float rowscale_from(float tot, int col0) const { return (col0 < UC_KN) ? rsqrtf(tot * (1.0f / 256) + EPS) * QB_SCALE : rsqrtf(tot * (1.0f / 128) + EPS); }
    struct Pre {}; struct ColPre {};
    __device__ __forceinline__ ColPre colpre(int) const { return ColPre{}; }
    __device__ __forceinline__ Pre pre8(int, int) const { return Pre{}; }
    __device__ __forceinline__ float run8(int row, int col0, float rs, float (&v)[8], const Pre&, const ColPre&) const {
#pragma unroll
        for (int j = 0; j < 8; ++j) v[j] *= rs;
        if (col0 >= UC_QR && col0 < UC_KN) {
            const f32x4* c4 = (const f32x4*)(cs + (size_t)row * 32 + (((col0 - UC_QR) & 63) >> 1));
            const f32x4 c01 = c4[0], c23 = c4[1];
            const float cc[4] = {c01.x, c01.z, c23.x, c23.z}, sn[4] = {c01.y, c01.w, c23.y, c23.w};
#pragma unroll
            for (int i = 0; i < 4; ++i) { const float x1 = v[2 * i], x2 = v[2 * i + 1]; v[2 * i] = x1 * cc[i] - x2 * sn[i]; v[2 * i + 1] = x2 * cc[i] + x1 * sn[i]; }
        }
        st16(U, ((size_t)row * DUP + col0) * 2, pack8(v));
        return 0.f;
    }
    __device__ __forceinline__ void ssq(int, int, float) const {}
};
struct EpiPe {
    static constexpr bool HAS_SSQ = false; static constexpr bool PRE_RS = false; static constexpr bool rs_ok = false; static constexpr int NB = 4;
    bf16* PE;
    __device__ __forceinline__ float rowsum_part(int, int, int) const { return 0.f; }
    __device__ __forceinline__ float rowscale_from(float, int) const { return 1.f; }
    struct Pre {}; struct ColPre {};
    __device__ __forceinline__ ColPre colpre(int) const { return ColPre{}; }
    __device__ __forceinline__ Pre pre8(int, int) const { return Pre{}; }
    __device__ __forceinline__ float run8(int row, int col0, float, float (&v)[8], const Pre&, const ColPre&) const { st16(PE, ((size_t)row * DM + col0) * 2, pack8(v)); return 0.f; }
    __device__ __forceinline__ void ssq(int, int, float) const {}
};
struct EpiOut {
    static constexpr bool HAS_SSQ = true; static constexpr bool PRE_RS = false; static constexpr bool rs_ok = false; static constexpr int NB = MK_LO ? 2 : 4;
    const float* res32; const bf16* rhi; const bf16* rlo; bf16* hb; bf16* lo; float* ssq_o;
    __device__ __forceinline__ float rowsum_part(int, int, int) const { return 0.f; }
    __device__ __forceinline__ float rowscale_from(float, int) const { return 1.f; }
    struct Pre { v4u a, b; }; struct ColPre {};
    __device__ __forceinline__ ColPre colpre(int) const { return ColPre{}; }
    __device__ __forceinline__ Pre pre8(int row, int col0) const { const size_t off = (size_t)row * DM + col0;
        if (res32) return Pre{*(const v4u*)(res32 + off), *(const v4u*)(res32 + off + 4)};
        return Pre{*(const v4u*)(rhi + off), MK_LO ? *(const v4u*)(rlo + off) : (v4u){0u, 0u, 0u, 0u}}; }
    __device__ __forceinline__ float run8(int row, int col0, float, float (&v)[8], const Pre& pr, const ColPre&) const {
        const size_t off = (size_t)row * DM + col0;
        float r[8];
        if (res32) { r[0] = __uint_as_float(pr.a.x); r[1] = __uint_as_float(pr.a.y); r[2] = __uint_as_float(pr.a.z); r[3] = __uint_as_float(pr.a.w);
                     r[4] = __uint_as_float(pr.b.x); r[5] = __uint_as_float(pr.b.y); r[6] = __uint_as_float(pr.b.z); r[7] = __uint_as_float(pr.b.w); }
        else join8(pr.a, pr.b, r);
        float ss = 0.f;
#pragma unroll
        for (int j = 0; j < 8; ++j) { v[j] += r[j]; ss += v[j] * v[j]; }
        v4u h, l; split8(v, h, l);
        st16(hb, off * 2, h); if (MK_LO) *(v4u*)(lo + off) = l;
        return ss;
    }
    __device__ __forceinline__ void ssq(int row, int grp, float s) const { ssq_o[(size_t)row * 32 + grp] = s; }
};
struct EpiGate {
    static constexpr bool HAS_SSQ = true; static constexpr bool PRE_RS = true; static constexpr int NB = MK_LO ? 1 : 2;
    const bf16* hi_in; const bf16* lo_in; float* outw; bf16* hb; bf16* lo; const bf16* PE; const float* bias; const float* ssq_i; float* ssq_o; const LAS float* rs_lds = nullptr; bool rs_ok = false;
    __device__ __forceinline__ float rowsum_part(int row, int part, int) const { const f32x4* s = (const f32x4*)(ssq_i + (size_t)row * 32 + part * 8); const f32x4 a = s[0], b = s[1]; return ((a.x + a.y) + (a.z + a.w)) + ((b.x + b.y) + (b.z + b.w)); }
    __device__ __forceinline__ float rowscale_from(float tot, int) const { return rsqrtf(tot * (1.0f / DM) + EPS); }
    struct Pre { v4u hi, lo, pe; }; struct ColPre { f32x4 ba, bb; };
    __device__ __forceinline__ ColPre colpre(int col0) const { return ColPre{*(const f32x4*)(bias + col0), *(const f32x4*)(bias + col0 + 4)}; }
    __device__ __forceinline__ Pre pre8(int row, int col0) const { const size_t off = (size_t)row * DM + col0; return Pre{*(const v4u*)(hi_in + off), MK_LO ? *(const v4u*)(lo_in + off) : (v4u){0u, 0u, 0u, 0u}, *(const v4u*)(PE + off)}; }
    __device__ __forceinline__ float run8(int row, int col0, float rs, float (&v)[8], const Pre& pr, const ColPre& cp) const {
        const size_t off = (size_t)row * DM + col0;
        float h[8]; join8(pr.hi, pr.lo, h);
        float pe[8]; unpack8(pr.pe, pe);
        const float bs[8] = {cp.ba.x, cp.ba.y, cp.ba.z, cp.ba.w, cp.bb.x, cp.bb.y, cp.bb.z, cp.bb.w};
        float ss = 0.f;
#pragma unroll
        for (int j = 0; j < 8; ++j) { v[j] = h[j] + pe[j] * sigmoid_f(v[j] * rs + bs[j]); ss += v[j] * v[j]; }
        if (outw) { *(f32x4*)(outw + off) = (f32x4){v[0], v[1], v[2], v[3]}; *(f32x4*)(outw + off + 4) = (f32x4){v[4], v[5], v[6], v[7]}; }
        else { v4u hh, ll; split8(v, hh, ll); st16(hb, off * 2, hh); if (MK_LO) *(v4u*)(lo + off) = ll; }
        return ss;
    }
    __device__ __forceinline__ void ssq(int row, int grp, float s) const { ssq_o[(size_t)row * 32 + grp] = s; }
};
template <class EP> __device__ __forceinline__ void naive_gemm(const Frame& F, const bf16* A, int lda, const bf16* Bt, int K, int N, const EP& E) {
    const int gt = F.vcu * NTHREADS + F.tid, NGT = F.G * NTHREADS;
    const int ng = N / 32;
    for (int it = gt; it < T * ng; it += NGT) {
        const int row = it % T, cg = it / T, col0 = cg * 32;
        float acc[32];
#pragma unroll
        for (int j = 0; j < 32; ++j) acc[j] = 0.f;
        const bf16* ap = A + (size_t)row * lda; const bf16* bp = Bt + (size_t)col0 * K;
        for (int k0 = 0; k0 < K; k0 += 8) {
            float a[8]; unpack8(*(const v4u*)(ap + k0), a);
#pragma unroll
            for (int j = 0; j < 32; ++j) { float b[8]; unpack8(*(const v4u*)(bp + (size_t)j * K + k0), b);
#pragma unroll
                for (int e = 0; e < 8; ++e) acc[j] += a[e] * b[e]; }
        }
        float tot = 0.f;
#pragma unroll
        for (int part = 0; part < 4; ++part) tot += E.rowsum_part(row, part, col0);
        const float rs = E.rowscale_from(tot, col0);
        float ss = 0.f;
#pragma unroll
        for (int g = 0; g < 4; ++g) { float v[8];
#pragma unroll
            for (int j = 0; j < 8; ++j) v[j] = acc[g * 8 + j];
            ss += E.run8(row, col0 + g * 8, rs, v, E.pre8(row, col0 + g * 8), E.colpre(col0 + g * 8)); }
        if (EP::HAS_SSQ) E.ssq(row, cg, ss);
    }
}
__device__ __forceinline__ void naive_attn_a(const Frame& F, int L) {
    const bf16* Z = (const bf16*)(F.ws + WS_Z); bf16* MIX = (bf16*)(F.ws + ((L & 1) ? WS_BUFA : WS_BUFB));
    LAS float* sc = (LAS float*)F.lds + F.wave * 640;
    const float* rb = inp<5>(F) + (size_t)L * 8 * 257;
    const int gw = F.vcu * NWAVES + F.wave, NGW = F.G * NWAVES;
    for (int it = gw; it < T * 8; it += NGW) {
        const int row = it >> 3, h = it & 7, b = row >> 11, sq = row & 2047, cq = sq >> 6, ql = sq & 63;
        float q[64];
#pragma unroll
        for (int c = 0; c < 8; ++c) { float f[8]; unpack8(*(const v4u*)(Z + (size_t)row * DINP + ZC_QA + 64 * h + 8 * c), f);
#pragma unroll
            for (int e = 0; e < 8; ++e) q[8 * c + e] = f[e]; }
        float s[9]; float mx = -1e30f;
#pragma unroll
        for (int bi = 0; bi < 9; ++bi) {
            const int j = cq - 8 + bi; s[bi] = -1e30f;
            if (j >= 0) {
                const bf16* kp = Z + (size_t)(b * SEQ + 64 * j + F.lane) * DINP + ZC_KA + 64 * h; float d = 0.f;
#pragma unroll
                for (int c = 0; c < 8; ++c) { float f[8]; unpack8(*(const v4u*)(kp + 8 * c), f);
#pragma unroll
                    for (int e = 0; e < 8; ++e) d += q[8 * c + e] * f[e]; }
                int rel = (ql + 512) - (64 * bi + F.lane); rel = rel > 128 ? 128 : rel;
                s[bi] = d + rb[h * 257 + rel + 128] * LOG2E; mx = fmaxf(mx, s[bi]);
            }
        }
        mx = wave_max(mx); float l = 0.f;
#pragma unroll
        for (int bi = 0; bi < 9; ++bi) { const float pv = (cq - 8 + bi >= 0) ? exp2f(s[bi] - mx) : 0.f; l += pv; sc[64 * bi + F.lane] = pv; }
        l = wave_sum(l);
        asm volatile("s_waitcnt lgkmcnt(0)" ::: "memory");
        float o = 0.f;
        for (int bi = 0; bi < 9; ++bi) { const int j = cq - 8 + bi; if (j < 0) continue;
            const bf16* vp = Z + (size_t)(b * SEQ + 64 * j) * DINP + ZC_VA + 64 * h + F.lane;
            for (int kl = 0; kl < 64; ++kl) o += sc[64 * bi + kl] * bf2f(vp[(size_t)kl * DINP]); }
        const float g = bf2f(Z[(size_t)row * DINP + ZC_GA + 64 * h + F.lane]);
        MIX[(size_t)row * DM + 64 * h + F.lane] = (bf16)f2bf(o / l * g);
        asm volatile("s_waitcnt lgkmcnt(0)" ::: "memory");
    }
}
__device__ __forceinline__ void naive_attn_b(const Frame& F, int L) {
    const bf16* Z = (const bf16*)(F.ws + WS_Z); const bf16* U = (const bf16*)(F.ws + WS_U); bf16* MIX = (bf16*)(F.ws + ((L & 1) ? WS_BUFA : WS_BUFB));
    LAS float* sc = (LAS float*)F.lds + F.wave * 2048;
    const int gw = F.vcu * NWAVES + F.wave, NGW = F.G * NWAVES;
    for (int it = gw; it < T * 4; it += NGW) {
        const int row = it >> 2, h = it & 3, b = row >> 11, sq = row & 2047, cq = sq >> 6;
        const int nk = (cq + 1) * 64;
        const bf16* qn = U + (size_t)row * DUP + UC_QN + 128 * h; const bf16* qr = U + (size_t)row * DUP + UC_QR + 64 * h;
        float mx = -1e30f;
        for (int k0 = 0; k0 < nk; k0 += 64) {
            const int key = b * SEQ + k0 + F.lane;
            const bf16* kn = U + (size_t)key * DUP + UC_KN + 128 * h; const bf16* kr = Z + (size_t)key * DINP + ZC_KR;
            float d = 0.f;
            for (int c = 0; c < 16; ++c) { float a[8], f[8]; unpack8(*(const v4u*)(qn + 8 * c), a); unpack8(*(const v4u*)(kn + 8 * c), f);
#pragma unroll
                for (int e = 0; e < 8; ++e) d += a[e] * f[e]; }
            for (int c = 0; c < 8; ++c) { float a[8], f[8]; unpack8(*(const v4u*)(qr + 8 * c), a); unpack8(*(const v4u*)(kr + 8 * c), f);
#pragma unroll
                for (int e = 0; e < 8; ++e) d += a[e] * f[e]; }
            sc[k0 + F.lane] = d; mx = fmaxf(mx, d);
        }
        mx = wave_max(mx); float l = 0.f;
        for (int k0 = 0; k0 < nk; k0 += 64) { const float pv = exp2f(sc[k0 + F.lane] - mx); l += pv; sc[k0 + F.lane] = pv; }
        l = wave_sum(l);
        asm volatile("s_waitcnt lgkmcnt(0)" ::: "memory");
        float o0 = 0.f, o1 = 0.f;
        const bf16* vp = U + (size_t)(b * SEQ) * DUP + UC_V + 128 * h + F.lane;
        for (int k = 0; k < nk; ++k) { const float pv = sc[k]; o0 += pv * bf2f(vp[(size_t)k * DUP]); o1 += pv * bf2f(vp[(size_t)k * DUP + 64]); }
        const float g0 = bf2f(Z[(size_t)row * DINP + ZC_GB + 128 * h + F.lane]), g1 = bf2f(Z[(size_t)row * DINP + ZC_GB + 128 * h + 64 + F.lane]);
        MIX[(size_t)row * DM + 512 + 128 * h + F.lane] = (bf16)f2bf(o0 / l * g0);
        MIX[(size_t)row * DM + 512 + 128 * h + 64 + F.lane] = (bf16)f2bf(o1 / l * g1);
        asm volatile("s_waitcnt lgkmcnt(0)" ::: "memory");
    }
}

#if MK_ABSORB
__device__ __forceinline__ void naive_attn_b_abs(const Frame& F, int L) {
    const bf16* Z = (const bf16*)(F.ws + WS_Z); const bf16* U = (const bf16*)(F.ws + WS_U); const bf16* CK = (const bf16*)(F.ws + WS_CKVN); bf16* MIX = (bf16*)(F.ws + ((L & 1) ? WS_BUFA : WS_BUFB));
    const float* wukv = inp<9>(F) + (size_t)L * 128 * 1024;
    LAS float* sc = (LAS float*)F.lds + F.wave * 2304;
    const int gw = F.vcu * NWAVES + F.wave, NGW = F.G * NWAVES;
    for (int it = gw; it < T * 4; it += NGW) {
        const int row = it >> 2, h = it & 3, b = row >> 11, sq = row & 2047, cq = sq >> 6;
        const int nk = (cq + 1) * 64;
        const bf16* ql = U + (size_t)row * DUP + UC_QN + 128 * h; const bf16* qr = U + (size_t)row * DUP + UC_QR + 64 * h;
        float mx = -1e30f;
        for (int k0 = 0; k0 < nk; k0 += 64) {
            const int key = b * SEQ + k0 + F.lane;
            const bf16* kn = CK + (size_t)key * 128; const bf16* kr = Z + (size_t)key * DINP + ZC_KR;
            float d = 0.f;
            for (int c = 0; c < 16; ++c) { float a[8], f[8]; unpack8(*(const v4u*)(ql + 8 * c), a); unpack8(*(const v4u*)(kn + 8 * c), f);
#pragma unroll
                for (int e = 0; e < 8; ++e) d += a[e] * f[e]; }
            for (int c = 0; c < 8; ++c) { float a[8], f[8]; unpack8(*(const v4u*)(qr + 8 * c), a); unpack8(*(const v4u*)(kr + 8 * c), f);
#pragma unroll
                for (int e = 0; e < 8; ++e) d += a[e] * f[e]; }
            sc[k0 + F.lane] = d; mx = fmaxf(mx, d);
        }
        mx = wave_max(mx); float l = 0.f;
        for (int k0 = 0; k0 < nk; k0 += 64) { const float pv = exp2f(sc[k0 + F.lane] - mx); l += pv; sc[k0 + F.lane] = pv; }
        l = wave_sum(l);
        asm volatile("s_waitcnt lgkmcnt(0)" ::: "memory");
        float o0 = 0.f, o1 = 0.f;
        const bf16* vp = CK + (size_t)(b * SEQ) * 128 + F.lane;
        for (int k = 0; k < nk; ++k) { const float pv = sc[k]; o0 += pv * bf2f(vp[(size_t)k * 128]); o1 += pv * bf2f(vp[(size_t)k * 128 + 64]); }
        asm volatile("s_waitcnt lgkmcnt(0)" ::: "memory");
        sc[2048 + F.lane] = bf2f(f2bf(o0 / l)); sc[2048 + 64 + F.lane] = bf2f(f2bf(o1 / l));
        asm volatile("s_waitcnt lgkmcnt(0)" ::: "memory");
        float y0 = 0.f, y1 = 0.f;
        for (int lat = 0; lat < 128; ++lat) { const float ol = sc[2048 + lat]; const float* wr = wukv + (size_t)lat * 1024 + h * 256 + 128;
            y0 += ol * bf2f(f2bf(wr[F.lane])); y1 += ol * bf2f(f2bf(wr[64 + F.lane])); }
        const float g0 = bf2f(Z[(size_t)row * DINP + ZC_GB + 128 * h + F.lane]), g1 = bf2f(Z[(size_t)row * DINP + ZC_GB + 128 * h + 64 + F.lane]);
        MIX[(size_t)row * DM + 512 + 128 * h + F.lane] = (bf16)f2bf(y0 * g0);
        MIX[(size_t)row * DM + 512 + 128 * h + 64 + F.lane] = (bf16)f2bf(y1 * g1);
        asm volatile("s_waitcnt lgkmcnt(0)" ::: "memory");
    }
}
#endif
namespace pg8 {
#define PG8_LAS __attribute__((address_space(3)))
constexpr int BM = 256, BK = 64, HALF = 128, HTB = HALF * BK * 2, STAGE_BYTES = 8 * HTB, NXCD = 8, WGM = 8;
__host__ __device__ __forceinline__ int lds_byte(int r, int c) { const int st = (r >> 4) * 2 + (c >> 5), rr = r & 15, cc = c & 31, ob = rr * 64 + cc * 2; return st * 1024 + (ob ^ (((ob >> 9) & 1) << 5)); }
__host__ __device__ __forceinline__ void stage_rc(int b, int& R, int& C) { const int st = b / 1024, sb = b % 1024, swz = sb ^ (((sb >> 9) & 1) << 5); R = (st >> 1) * 16 + swz / 64; C = (st & 1) * 32 + (swz % 64) / 2; }
__host__ __device__ __forceinline__ int perm32(int rho) { const int n = rho >> 4, i = rho & 15; return 8 * (i >> 2) + 4 * n + (i & 3); }
struct Unit { int pm, pn; };
struct Gemm { const bf16* A; int lda; const bf16* Bt; int M, N, K; int ks_pn, ks_nt0; };
struct StaticOrder {
    int nM, nN, nwg, G, c;
    __device__ void init(int M, int N, int G_, int c_) { nM = M / BM; nN = N / BM; nwg = nM * nN; G = G_; c = c_; }
    __device__ bool next(int i, Unit& u) const {
        const long L = (long)i * G + c; if (L >= nwg) return false;
        int wgid = (int)L; { const int q = nwg / NXCD, r = nwg % NXCD, xcd = wgid % NXCD, off = wgid / NXCD; wgid = (xcd < r ? xcd * (q + 1) : r * (q + 1) + (xcd - r) * q) + off; }
        const int nig = WGM * nN, gid = wgid / nig, fm = gid * WGM, gsz = (nM - fm) < WGM ? (nM - fm) : WGM;
        u.pm = fm + ((wgid % nig) % gsz); u.pn = (wgid % nig) / gsz; return true;
    }
};
template <class EP> struct FastEpi {
    EP e;
    __device__ __forceinline__ void operator()(const f32x4 (&acc)[2][2][4][2], const Unit& u_, int wr, int wc, int fr, int fq) const {
        constexpr int NB = EP::NB;
        Unit u; u.pm = opaque_i(u_.pm); u.pn = opaque_i(u_.pn);
        const int colt = u.pn * BM + wc * 32 + 8 * fq;
        typename EP::ColPre cp[2] = {e.colpre(colt), e.colpre(colt + HALF)};
#pragma unroll
        for (int ai = 0; ai < 2; ++ai)
#pragma unroll
            for (int mp = 0; mp < 4 / NB; ++mp) {
                float part[NB]; typename EP::Pre pre[NB][2];
#pragma unroll
                for (int mm = 0; mm < NB; ++mm) {
                    const int row = u.pm * BM + ai * HALF + wr * 64 + (NB * mp + mm) * 16 + fr;
                    part[mm] = (EP::PRE_RS && e.rs_ok) ? 0.f : e.rowsum_part(row, fq, u.pn * BM);
#pragma unroll
                    for (int bj = 0; bj < 2; ++bj) pre[mm][bj] = e.pre8(row, colt + bj * HALF);
                }
#pragma unroll
                for (int mm = 0; mm < NB; ++mm) {
                    const int m = NB * mp + mm, row = u.pm * BM + ai * HALF + wr * 64 + m * 16 + fr;
                    float rs;
                    if constexpr (EP::PRE_RS) {
                        if (e.rs_ok) rs = e.rs_lds[((u.pm >> 3) & 1) * 256 + (row & 255)];
                        else { float pt = part[mm]; pt += __shfl_xor(pt, 16); pt += __shfl_xor(pt, 32); rs = e.rowscale_from(pt, u.pn * BM); }
                    } else { float pt = part[mm]; pt += __shfl_xor(pt, 16); pt += __shfl_xor(pt, 32); rs = e.rowscale_from(pt, u.pn * BM); }
#pragma unroll
                    for (int bj = 0; bj < 2; ++bj) {
                        float v[8] = {acc[ai][bj][m][0][0], acc[ai][bj][m][0][1], acc[ai][bj][m][0][2], acc[ai][bj][m][0][3], acc[ai][bj][m][1][0], acc[ai][bj][m][1][1], acc[ai][bj][m][1][2], acc[ai][bj][m][1][3]};
                        float s = e.run8(row, colt + bj * HALF, rs, v, pre[mm][bj], cp[bj]);
                        if (EP::HAS_SSQ) { s += __shfl_xor(s, 16); s += __shfl_xor(s, 32); if (fq == 0) e.ssq(row, (u.pn * BM + bj * HALF + wc * 32) >> 5, s); }
                    }
                }
            }
    }
};

struct FinalEpi {
    float* out; unsigned char* ws; const float* bias; const float* gfin;
    const LAS float* rs_lds = nullptr; bool rs_ok = false;
    __device__ __forceinline__ void operator()(f32x4 (&acc)[2][2][4][2], const Unit& u, int wr, int wc, int fr, int fq) const {
        asm volatile("" : "+v"(fr), "+v"(fq));
        const bf16* hin = (const bf16*)(ws + (((DEPTH - 1) & 1) ? WS_BUFB : WS_BUFA)); const bf16* lin = (const bf16*)(ws + WS_LO1); const bf16* PE = (const bf16*)(ws + WS_Z); const float* ssq_i = (const float*)(ws + WS_SSQ1); float* ssq_x = (float*)(ws + WS_SSQ2);
        unsigned* cnt = (unsigned*)(ws + WS_CTL) + 16384;
        const int colt = u.pn * BM + wc * 32 + 8 * fq;
        f32x4 bb[2][2];
#pragma unroll
        for (int bj = 0; bj < 2; ++bj) { bb[bj][0] = *(const f32x4*)(bias + colt + bj * HALF); bb[bj][1] = *(const f32x4*)(bias + colt + bj * HALF + 4); }
#pragma unroll
        for (int ai = 0; ai < 2; ++ai)
#pragma unroll
            for (int m = 0; m < 4; ++m) {
                const int row = u.pm * BM + ai * HALF + wr * 64 + m * 16 + fr;
                float rs;
                if (rs_ok) rs = rs_lds[((u.pm >> 3) & 1) * 256 + (row & 255)];
                else { const f32x4* sp = (const f32x4*)(ssq_i + (size_t)row * 32 + fq * 8); const f32x4 s0 = sp[0], s1 = sp[1];
                    float pt = ((s0.x + s0.y) + (s0.z + s0.w)) + ((s1.x + s1.y) + (s1.z + s1.w)); pt += __shfl_xor(pt, 16); pt += __shfl_xor(pt, 32);
                    rs = rsqrtf(pt * (1.0f / DM) + EPS); }
#pragma unroll
                for (int bj = 0; bj < 2; ++bj) {
                    const size_t off = (size_t)row * DM + colt + bj * HALF;
                    const v4u hhi = *(const v4u*)(hin + off), hlo = MK_LO ? *(const v4u*)(lin + off) : (v4u){0u, 0u, 0u, 0u}; const v4u pe = *(const v4u*)(PE + off);
                    const f32x4 b0 = bb[bj][0], b1 = bb[bj][1];
                    float hj[8]; join8(hhi, hlo, hj);
                    const f32x4 ha = (f32x4){hj[0], hj[1], hj[2], hj[3]}, hb_ = (f32x4){hj[4], hj[5], hj[6], hj[7]};
                    float pv[8]; unpack8(pe, pv);
                    f32x4 v0 = acc[ai][bj][m][0], v1 = acc[ai][bj][m][1];
                    v0.x = ha.x + pv[0] * sigmoid_f(v0.x * rs + b0.x); v0.y = ha.y + pv[1] * sigmoid_f(v0.y * rs + b0.y);
                    v0.z = ha.z + pv[2] * sigmoid_f(v0.z * rs + b0.z); v0.w = ha.w + pv[3] * sigmoid_f(v0.w * rs + b0.w);
                    v1.x = hb_.x + pv[4] * sigmoid_f(v1.x * rs + b1.x); v1.y = hb_.y + pv[5] * sigmoid_f(v1.y * rs + b1.y);
                    v1.z = hb_.z + pv[6] * sigmoid_f(v1.z * rs + b1.z); v1.w = hb_.w + pv[7] * sigmoid_f(v1.w * rs + b1.w);
                    acc[ai][bj][m][0] = v0; acc[ai][bj][m][1] = v1;
                    float ss = ((v0.x * v0.x + v0.y * v0.y) + (v0.z * v0.z + v0.w * v0.w)) + ((v1.x * v1.x + v1.y * v1.y) + (v1.z * v1.z + v1.w * v1.w));
                    ss += __shfl_xor(ss, 16); ss += __shfl_xor(ss, 32);
                    if (fq == 0) __hip_atomic_store(ssq_x + (size_t)row * 32 + ((u.pn * BM + bj * HALF + wc * 32) >> 5), ss, __ATOMIC_RELAXED, __HIP_MEMORY_SCOPE_AGENT);
                    asm volatile("" ::: "memory");
                }
                asm volatile("" ::: "memory");
            }
        asm volatile("s_waitcnt vmcnt(0)" ::: "memory");
        __builtin_amdgcn_s_barrier(); asm volatile("" ::: "memory");
        if (wr == 0 && wc == 0) {
            unsigned* c = cnt + 64 * u.pm;
            if (fr == 0 && fq == 0) __hip_atomic_fetch_add(c, 1u, __ATOMIC_RELAXED, __HIP_MEMORY_SCOPE_AGENT);
            unsigned sp_ = 0;
            while ((unsigned)__builtin_amdgcn_readfirstlane((int)__hip_atomic_load(c, __ATOMIC_RELAXED, __HIP_MEMORY_SCOPE_AGENT)) < 4u) { __builtin_amdgcn_s_sleep(2); if (++sp_ > (1u << 20)) break; }
            __builtin_amdgcn_fence(__ATOMIC_ACQUIRE, "agent");
            asm volatile("s_waitcnt vmcnt(0)" ::: "memory");
        }
        __builtin_amdgcn_s_barrier(); asm volatile("" ::: "memory");
        f32x4 gg[2][2];
#pragma unroll
        for (int bj = 0; bj < 2; ++bj) { gg[bj][0] = *(const f32x4*)(gfin + colt + bj * HALF); gg[bj][1] = *(const f32x4*)(gfin + colt + bj * HALF + 4); }
#pragma unroll
        for (int ai = 0; ai < 2; ++ai)
#pragma unroll
            for (int m = 0; m < 4; ++m) {
                const int row = u.pm * BM + ai * HALF + wr * 64 + m * 16 + fr;
                const f32x4* sp = (const f32x4*)(ssq_x + (size_t)row * 32 + fq * 8); const f32x4 s0 = sp[0], s1 = sp[1];
                float pt = ((s0.x + s0.y) + (s0.z + s0.w)) + ((s1.x + s1.y) + (s1.z + s1.w)); pt += __shfl_xor(pt, 16); pt += __shfl_xor(pt, 32);
                const float r = rsqrtf(pt * (1.0f / DM) + EPS);
#pragma unroll
                for (int bj = 0; bj < 2; ++bj) { const size_t off = (size_t)row * DM + colt + bj * HALF;
                    const f32x4 g0 = gg[bj][0], g1 = gg[bj][1];
                    *(f32x4*)(out + off) = acc[ai][bj][m][0] * r * g0; *(f32x4*)(out + off + 4) = acc[ai][bj][m][1] * r * g1; }
                if (m & 1) asm volatile("" ::: "memory");
            }
    }
};

template <class Epi>
__device__ __forceinline__ void gemm_phase(PG8_LAS unsigned char* lds, const int tid, const Gemm g, const StaticOrder& S, const Epi& E) {
    const int wid = __builtin_amdgcn_readfirstlane(tid >> 6), lane = tid & 63, wr = wid >> 2, wc = wid & 3, fr = lane & 15, fq = lane >> 4;
    const int K = g.K, ntK = K / BK, lda = g.lda;
#define PG8_NT(u) (((u).pn < g.ks_pn) ? g.ks_nt0 : ntK - g.ks_nt0)
#define PG8_KOFF(u) (((u).pn < g.ks_pn) ? (size_t)0 : (size_t)g.ks_nt0 * kstep)
    unsigned voffA[2], voffB[2];
#pragma unroll
    for (int i = 0; i < 2; ++i) { int R, C; stage_rc(tid * 16 + i * 8192, R, C); const int Rb = (R & ~31) + perm32(R & 31);
        voffA[i] = (unsigned)(R * lda + C) * 2u; voffB[i] = (unsigned)(Rb * K + C) * 2u; }
    const size_t kstep = (size_t)(BK * 2);
    const size_t hstepA = (size_t)HALF * lda * 2, hstepB = (size_t)HALF * K * 2;
    const size_t tstepA = 2 * hstepA, tstepB = 2 * hstepB;
    const unsigned ldsw = (unsigned)wid * 1024u;
    const int aoff = lds_byte(wr * 64 + fr, fq * 8), boff = lds_byte(wc * 32 + fr, fq * 8);
#define PG8_SA(b, h) (((b) * 2 + (h)) * HTB)
#define PG8_SB(b, h) ((4 + (b) * 2 + (h)) * HTB)
#define PG8_STAGE(bufoff, gbase, voff) do { _Pragma("unroll") for (int _i = 0; _i < 2; ++_i) \
        __builtin_amdgcn_global_load_lds((const unsigned*)((const char*)(gbase) + (voff)[_i]), (PG8_LAS unsigned*)(lds + (bufoff) + ldsw + _i * 8192), 16, 0, 0); } while (0)
#define PG8_LDA(dst, b, h) do { _Pragma("unroll") for (int m = 0; m < 4; ++m) _Pragma("unroll") for (int k = 0; k < 2; ++k) dst[m][k] = *(const PG8_LAS bf16x8*)(lds + PG8_SA(b, h) + aoff + m * 2048 + k * 1024); } while (0)
#define PG8_LDB(dst, b, h) do { _Pragma("unroll") for (int n = 0; n < 2; ++n) _Pragma("unroll") for (int k = 0; k < 2; ++k) dst[n][k] = *(const PG8_LAS bf16x8*)(lds + PG8_SB(b, h) + boff + n * 2048 + k * 1024); } while (0)
#define PG8_MMA(ai, bj, At, Bt) do { __builtin_amdgcn_s_setprio(1); _Pragma("unroll") for (int m = 0; m < 4; ++m) _Pragma("unroll") for (int n = 0; n < 2; ++n) _Pragma("unroll") for (int k = 0; k < 2; ++k) \
        acc[ai][bj][m][n] = __builtin_amdgcn_mfma_f32_16x16x32_bf16(Bt[n][k], At[m][k], acc[ai][bj][m][n], 0, 0, 0); __builtin_amdgcn_s_setprio(0); } while (0)
#define PG8_WAIT_V(n) asm volatile("s_waitcnt vmcnt(" #n ")" ::: "memory")
#define PG8_WAIT_L(n) asm volatile("s_waitcnt lgkmcnt(" #n ")" ::: "memory")
#define PG8_BAR __builtin_amdgcn_s_barrier()
#define PG8_SCHED __builtin_amdgcn_sched_barrier(0)
    Unit cur, nxt; int ui = 0;
    if (!S.next(0, cur)) return;
    f32x4 acc[2][2][4][2];
#pragma unroll
    for (int a = 0; a < 2; ++a)
#pragma unroll
        for (int b = 0; b < 2; ++b)
#pragma unroll
            for (int m = 0; m < 4; ++m)
#pragma unroll
                for (int n = 0; n < 2; ++n) acc[a][b][m][n] = (f32x4){0.f, 0.f, 0.f, 0.f};
    bf16x8 At[4][2], B0[2][2], B1[2][2];
    const char* cA = (const char*)g.A + (size_t)cur.pm * tstepA + PG8_KOFF(cur); const char* cB = (const char*)g.Bt + (size_t)cur.pn * tstepB + PG8_KOFF(cur);
    int nt = PG8_NT(cur);
    PG8_STAGE(PG8_SB(0, 0), cB, voffB); PG8_STAGE(PG8_SB(0, 1), cB + hstepB, voffB); PG8_STAGE(PG8_SA(0, 0), cA, voffA); PG8_STAGE(PG8_SA(0, 1), cA + hstepA, voffA);
    if (wr == 1) PG8_BAR;
    PG8_WAIT_V(2); PG8_BAR;
    PG8_STAGE(PG8_SB(1, 0), cB + kstep, voffB); PG8_STAGE(PG8_SA(1, 0), cA + kstep, voffA); PG8_STAGE(PG8_SB(1, 1), cB + hstepB + kstep, voffB);
    PG8_WAIT_V(6); PG8_BAR;
    for (;;) {
        const bool has_next = S.next(ui + 1, nxt);
        const char* nA = has_next ? (const char*)g.A + (size_t)nxt.pm * tstepA + PG8_KOFF(nxt) : cA; const char* nB = has_next ? (const char*)g.Bt + (size_t)nxt.pn * tstepB + PG8_KOFF(nxt) : cB;
#pragma unroll 1
        for (int t = 0; t < nt; t += 2) {
            const bool last = (t == nt - 2);
            const char* a1 = cA + (size_t)(t + 1) * kstep;
            const char* a2 = last ? nA : cA + (size_t)(t + 2) * kstep; const char* b2 = last ? nB : cB + (size_t)(t + 2) * kstep;
            const char* a3 = a2 + kstep; const char* b3 = b2 + kstep;
            PG8_LDB(B0, 0, 0); PG8_LDB(B1, 0, 1); PG8_SCHED; PG8_LDA(At, 0, 0); PG8_STAGE(PG8_SA(1, 1), a1 + hstepA, voffA);
            PG8_WAIT_V(8); PG8_WAIT_L(0); PG8_BAR; PG8_MMA(0, 0, At, B0); PG8_MMA(0, 1, At, B1); PG8_BAR; PG8_SCHED;
            PG8_LDA(At, 0, 1); PG8_STAGE(PG8_SB(0, 0), b2, voffB); PG8_STAGE(PG8_SB(0, 1), b2 + hstepB, voffB); PG8_STAGE(PG8_SA(0, 0), a2, voffA);
            PG8_WAIT_V(8); PG8_WAIT_L(0); PG8_BAR; PG8_MMA(1, 0, At, B0); PG8_MMA(1, 1, At, B1); PG8_BAR; PG8_SCHED;
            PG8_LDB(B0, 1, 0); PG8_LDB(B1, 1, 1); PG8_SCHED; PG8_LDA(At, 1, 0); PG8_STAGE(PG8_SA(0, 1), a2 + hstepA, voffA);
            PG8_WAIT_V(8); PG8_WAIT_L(0); PG8_BAR; PG8_MMA(0, 0, At, B0); PG8_MMA(0, 1, At, B1); PG8_BAR; PG8_SCHED;
            PG8_LDA(At, 1, 1); PG8_STAGE(PG8_SB(1, 0), b3, voffB); PG8_STAGE(PG8_SB(1, 1), b3 + hstepB, voffB); PG8_STAGE(PG8_SA(1, 0), a3, voffA);
            PG8_WAIT_V(8); PG8_WAIT_L(0); PG8_BAR; PG8_MMA(1, 0, At, B0); PG8_MMA(1, 1, At, B1); PG8_BAR; PG8_SCHED;
        }
        if (wr == 0) PG8_BAR;
        E(acc, cur, wr, wc, fr, fq);
        if (!has_next) break;
#pragma unroll
        for (int a = 0; a < 2; ++a)
#pragma unroll
            for (int b = 0; b < 2; ++b)
#pragma unroll
                for (int m = 0; m < 4; ++m)
#pragma unroll
                    for (int n = 0; n < 2; ++n) acc[a][b][m][n] = (f32x4){0.f, 0.f, 0.f, 0.f};
        cur = nxt; cA = nA; cB = nB; ++ui; nt = PG8_NT(cur);
        if (wr == 1) PG8_BAR;
    }
    PG8_WAIT_V(0);
    PG8_BAR;
#undef PG8_NT
#undef PG8_KOFF
#undef PG8_SA
#undef PG8_SB
#undef PG8_STAGE
#undef PG8_LDA
#undef PG8_LDB
#undef PG8_MMA
#undef PG8_WAIT_V
#undef PG8_WAIT_L
#undef PG8_BAR
#undef PG8_SCHED
}
}
__device__ __forceinline__ bool rs_prepass(const Frame& F, const float* ssq, int N) {
    pg8::StaticOrder S; S.init(T, N, F.G, F.bx);
    int pma = -1, pmb = -1; bool ok = true;
    pg8::Unit u;
    for (int i = 0; S.next(i, u); ++i) {
        if (pma < 0 || u.pm == pma) pma = u.pm;
        else if (pmb < 0 || u.pm == pmb) pmb = u.pm;
        else ok = false;
    }
    if (pma >= 0 && pmb >= 0 && (((pma >> 3) ^ (pmb >> 3)) & 1) == 0) ok = false;
    if (pma < 0) ok = false;
    LAS float* tab = (LAS float*)(F.lds + LDSCTL_OFF + 4096);
    if (ok) {
        const int slot = F.tid >> 8, r = F.tid & 255;
        const int pm = (pmb >= 0 && (((pmb >> 3) & 1) == slot)) ? pmb : ((((pma >> 3) & 1) == slot) ? pma : -1);
        if (pm >= 0) {
            const f32x4* sp = (const f32x4*)(ssq + (size_t)(pm * 256 + r) * 32);
            f32x4 v[8];
#pragma unroll
            for (int j = 0; j < 8; ++j) v[j] = sp[j];
            float tot = 0.f;
#pragma unroll
            for (int j = 0; j < 8; ++j) tot += (v[j].x + v[j].y) + (v[j].z + v[j].w);
            tab[slot * 256 + r] = rsqrtf(tot * (1.0f / DM) + EPS);
        }
    }
    __syncthreads();
    return ok;
}
template <class EP> __device__ __forceinline__ void fast_gemm(const Frame& F, const bf16* A, int lda, const bf16* Bt, int K, int N, const EP& E, int ks_pn = 0, int ks_nt0 = 0, int deal = -1) {
    pg8::Gemm g{A, lda, Bt, T, N, K, ks_pn, ks_nt0}; pg8::StaticOrder S; S.init(T, N, F.G, deal >= 0 ? deal : F.bx);
    pg8::FastEpi<EP> FE{E};
    pg8::gemm_phase<pg8::FastEpi<EP>>(F.lds, F.tid, g, S, FE);
}
namespace fa {
typedef __attribute__((address_space(3))) const char* lds_cptr;
typedef short v4i16_t __attribute__((ext_vector_type(4)));
__device__ __forceinline__ s16x4 vtr(lds_cptr p) { return __builtin_bit_cast(s16x4, __builtin_amdgcn_ds_read_tr16_b64_v4i16((LAS v4i16_t*)p)); }
__device__ __forceinline__ float half_max(float v) { auto rr = __builtin_amdgcn_permlane32_swap(__float_as_uint(v), __float_as_uint(v), false, false); return fmaxf(__uint_as_float(rr[0]), __uint_as_float(rr[1])); }
__device__ __forceinline__ float half_sum(float v) { auto rr = __builtin_amdgcn_permlane32_swap(__float_as_uint(v), __float_as_uint(v), false, false); return __uint_as_float(rr[0]) + __uint_as_float(rr[1]); }
__device__ __forceinline__ bf16x8 packp(const f32x16& p, int b) { v4u w; w.x = pk2(p[b], p[b + 1]); w.y = pk2(p[b + 2], p[b + 3]); w.z = pk2(p[b + 4], p[b + 5]); w.w = pk2(p[b + 6], p[b + 7]); return __builtin_bit_cast(bf16x8, w); }

struct NoHook { __device__ __forceinline__ void operator()() const {} };
template <int NS, int KPITCH, int NG = 0, class Hook = NoHook>
__device__ __forceinline__ void qk_half(f32x16& p, const bf16x8 (&qf)[NS - NG], const bf16* qg, lds_cptr kb  , const Hook& hook = Hook()) {
    constexpr int PF = MK_KPF, RING = PF + 1;
    bf16x8 kr[RING];
    bf16x8 qr[NG > 0 ? NG : 1];
#pragma unroll
    for (int s = 0; s < NG; ++s) qr[s] = *(const bf16x8*)(qg + 16 * s);
    hook();
#pragma unroll
    for (int s = 0; s < PF; ++s) kr[s] = *(const LAS bf16x8*)(kb + s * 32);
#pragma unroll
    for (int s = 0; s < NS; ++s) {
        if (s + PF < NS) kr[(s + PF) % RING] = *(const LAS bf16x8*)(kb + (s + PF) * 32);
        p = __builtin_amdgcn_mfma_f32_32x32x16_bf16(kr[s % RING], (s < NS - NG) ? qf[s < NS - NG ? s : 0] : qr[s >= NS - NG ? s - (NS - NG) : 0], p, 0, 0, 0);
        __builtin_amdgcn_sched_barrier(0);
    }
}
__device__ __forceinline__ bf16x8 vfrag(lds_cptr vb, int i) {
    const int off = (i >> 1) * 4096 + (i & 1) * 1024;
    const s16x4 lo = vtr(vb + off), hh = vtr(vb + off + 512);
    return (bf16x8){lo[0], lo[1], lo[2], lo[3], hh[0], hh[1], hh[2], hh[3]};
}
template <int ND>
__device__ __forceinline__ void pv_plain(f32x16 (&o)[ND], const bf16x8 (&pf)[2], lds_cptr vb) {
    constexpr int NM = ND * 2;
    bf16x8 vr[3]; vr[0] = vfrag(vb, 0); vr[1] = vfrag(vb, 1);
#pragma unroll
    for (int i = 0; i < NM; ++i) {
        if (i + 2 < NM) vr[(i + 2) % 3] = vfrag(vb, i + 2);
        o[i >> 1] = __builtin_amdgcn_mfma_f32_32x32x16_bf16(vr[i % 3], pf[i & 1], o[i >> 1], 0, 0, 0);
        __builtin_amdgcn_sched_barrier(0);
    }
}
template <int NS, int ND, int KPITCH, class LK>
__device__ __forceinline__ void half_step_nm(f32x16& p, const bf16x8 (&qf)[NS], f32x16 (&o)[ND], float& m, float& l, bf16x8 (&pf)[2], bool& pend, bool& fresh, f32x16& cinit, const float cbias, const bool cst, const LK& lookup, lds_cptr kb, lds_cptr vprev) {
    constexpr int NM = ND * 2;
    {
        bf16x8 kr[NS];
#pragma unroll
        for (int s = 0; s < NS; ++s) kr[s] = *(const LAS bf16x8*)(kb + s * 32);
        if (cst) p = __builtin_amdgcn_mfma_f32_32x32x16_bf16(kr[0], qf[0], cinit, 0, 0, 0);
        else { f32x16 t; lookup(t); p = __builtin_amdgcn_mfma_f32_32x32x16_bf16(kr[0], qf[0], t, 0, 0, 0); }
        __builtin_amdgcn_sched_barrier(0);
#pragma unroll
        for (int s = 1; s < NS; ++s) { p = __builtin_amdgcn_mfma_f32_32x32x16_bf16(kr[s], qf[s], p, 0, 0, 0); __builtin_amdgcn_sched_barrier(0); }
    }
    float mx = p[0];
#pragma unroll
    for (int r = 1; r < 16; ++r) mx = fmaxf(mx, p[r]);
    mx = half_max(mx);
    if (fresh || !__all(mx <= 6.0f)) {
        if (pend) { pv_plain<ND>(o, pf, vprev); pend = false; }
        const float delta = fresh ? mx : fmaxf(mx, 0.f);
        const float alpha = fresh ? 1.0f : __builtin_amdgcn_exp2f(-delta);
        m += delta; l *= alpha;
#pragma unroll
        for (int d = 0; d < ND; ++d)
#pragma unroll
            for (int r = 0; r < 16; ++r) o[d][r] *= alpha;
        const float cm = cbias - m;
#pragma unroll
        for (int r = 0; r < 16; ++r) { p[r] -= delta; cinit[r] = cm; }
        fresh = false;
    }
    bf16x8 pfn[2];
    float rs = 0.f;
    if (pend) {
        constexpr int EPM = 16 / NM;
        bf16x8 vr[3]; vr[0] = vfrag(vprev, 0); vr[1] = vfrag(vprev, 1);
#pragma unroll
        for (int i = 0; i < NM; ++i) {
            if (i + 2 < NM) vr[(i + 2) % 3] = vfrag(vprev, i + 2);
            o[i >> 1] = __builtin_amdgcn_mfma_f32_32x32x16_bf16(vr[i % 3], pf[i & 1], o[i >> 1], 0, 0, 0);
#pragma unroll
            for (int e = 0; e < EPM; ++e) { const int idx = i * EPM + e; p[idx] = __builtin_amdgcn_exp2f(p[idx]); rs += p[idx]; }
            if (((i + 1) * EPM) % 8 == 0) { const int k = ((i + 1) * EPM) / 8 - 1; pfn[k] = packp(p, 8 * k); }
            __builtin_amdgcn_sched_barrier(0);
        }
    } else {
#pragma unroll
        for (int r = 0; r < 16; ++r) { p[r] = __builtin_amdgcn_exp2f(p[r]); rs += p[r]; }
        pfn[0] = packp(p, 0); pfn[1] = packp(p, 8);
    }
    l += rs;
    pf[0] = pfn[0]; pf[1] = pfn[1];
    pend = true;
}
__device__ __forceinline__ float max3f(float a, float b, float c) { float r; asm("v_max3_f32 %0, %1, %2, %3" : "=v"(r) : "v"(a), "v"(b), "v"(c)); return r; }
struct NoLookup { __device__ __forceinline__ void operator()(f32x16&) const {} };
template <int NS, int ND, int KPITCH, bool LKUP, bool NEGM, class LK>
__device__ __forceinline__ void half_step_sp(f32x16& pn, f32x16& pp, const bf16x8 (&qf)[NS], f32x16 (&o)[ND], float& m, float& l, bool& fresh, f32x16& cinit, const float cbias, const bool cst, const LK& lookup, lds_cptr kb, lds_cptr vprev) {
    constexpr int NM = ND * 2;
    constexpr int PF = (NS > 4) ? MK_SPKPF : NS, RING = (NS > 4) ? PF + 1 : NS;
    constexpr int EG = (NS >= 8) ? 2 : 16 / NS;
    unsigned pw[8];
    __builtin_amdgcn_s_setprio(1);
    {
        bf16x8 kr[RING];
#pragma unroll
        for (int s = 0; s < PF; ++s) kr[s] = *(const LAS bf16x8*)(kb + s * 32);
#pragma unroll
        for (int s = 0; s < NS; ++s) {
            if (s + PF < NS) kr[(s + PF) % RING] = *(const LAS bf16x8*)(kb + (s + PF) * 32);
            if (s == 0) {
                if (!NEGM) pn = __builtin_amdgcn_mfma_f32_32x32x16_bf16(kr[0], qf[0], (f32x16){}, 0, 0, 0);
                else if (!LKUP || cst) pn = __builtin_amdgcn_mfma_f32_32x32x16_bf16(kr[0], qf[0], cinit, 0, 0, 0);
                else { f32x16 t; lookup(t); bf16x8 k0 = kr[0], q0 = qf[0]; asm volatile("" : "+v"(k0), "+v"(q0));
                    pn = __builtin_amdgcn_mfma_f32_32x32x16_bf16(k0, q0, t, 0, 0, 0); }
            } else pn = __builtin_amdgcn_mfma_f32_32x32x16_bf16(kr[s % RING], qf[s], pn, 0, 0, 0);
            if (s * EG < 16) {
#pragma unroll
                for (int e = 0; e < EG; ++e) { const int i = s * EG + e; float x = __builtin_amdgcn_exp2f(NEGM ? pp[i] : pp[i] - m); asm volatile("" : "+v"(x)); pp[i] = x; }
#pragma unroll
                for (int e = 0; e < EG; e += 2) { const int i = s * EG + e; unsigned w = pk2(pp[i], pp[i + 1]); asm volatile("" : "+v"(w)); pw[i >> 1] = w; }
            }
            __builtin_amdgcn_sched_barrier(0);
        }
    }
    const bf16x8 pf0 = __builtin_bit_cast(bf16x8, (v4u){pw[0], pw[1], pw[2], pw[3]}), pf1 = __builtin_bit_cast(bf16x8, (v4u){pw[4], pw[5], pw[6], pw[7]});
    float rs = 0.f, mx = pn[0];
    {
        constexpr int AG = 16 / NM;
        bf16x8 vr[3]; vr[0] = vfrag(vprev, 0); vr[1] = vfrag(vprev, 1);
#pragma unroll
        for (int i = 0; i < NM; ++i) {
            if (i + 2 < NM) vr[(i + 2) % 3] = vfrag(vprev, i + 2);
            o[i >> 1] = __builtin_amdgcn_mfma_f32_32x32x16_bf16(vr[i % 3], (i & 1) ? pf1 : pf0, o[i >> 1], 0, 0, 0);
#pragma unroll
            for (int e = 0; e < AG; ++e) rs += pp[i * AG + e];
            asm volatile("" : "+v"(rs));
#pragma unroll
            for (int e = 0; e < AG; e += 2) mx = max3f(mx, pn[i * AG + e], pn[i * AG + e + 1]);
            asm volatile("" : "+v"(mx));
            __builtin_amdgcn_sched_barrier(0);
        }
    }
    __builtin_amdgcn_s_setprio(0);
    l += rs;
    mx = half_max(mx);
    if (!NEGM) {
        if (!__all(mx <= m + 6.0f)) {
            const float mn = fmaxf(m, mx);
            const float alpha = __builtin_amdgcn_exp2f(m - mn);
            m = mn; l *= alpha;
#pragma unroll
            for (int d = 0; d < ND; ++d)
#pragma unroll
                for (int r = 0; r < 16; ++r) o[d][r] *= alpha;
        }
    } else if (fresh || !__all(mx <= 6.0f)) {
        const float delta = fresh ? mx : fmaxf(mx, 0.f);
        const float alpha = fresh ? 1.0f : __builtin_amdgcn_exp2f(-delta);
        m += delta; l *= alpha;
#pragma unroll
        for (int d = 0; d < ND; ++d)
#pragma unroll
            for (int r = 0; r < 16; ++r) o[d][r] *= alpha;
        const float cm = cbias - m;
#pragma unroll
        for (int r = 0; r < 16; ++r) { pn[r] -= delta; cinit[r] = cm; }
        fresh = false;
    }
}
template <int ND>
__device__ __forceinline__ void flush_sp(f32x16& pp, f32x16 (&o)[ND], float& l, lds_cptr vprev, const float msub = 0.f) {
    float rs = 0.f;
#pragma unroll
    for (int r = 0; r < 16; ++r) { pp[r] = __builtin_amdgcn_exp2f(pp[r] - msub); rs += pp[r]; }
    bf16x8 pf[2]; pf[0] = packp(pp, 0); pf[1] = packp(pp, 8);
    pv_plain<ND>(o, pf, vprev);
    l += rs;
}
template <int NS, int ND, int KPITCH, int NG = 0, bool ILV = false, class Hook = NoHook>
__device__ __forceinline__ void half_step(f32x16& p, const bf16x8 (&qf)[NS - NG], const bf16* qg, f32x16 (&o)[ND], float& m, float& l, bf16x8 (&pf)[2], bool& pend, lds_cptr kb, lds_cptr vprev, const Hook& hook = Hook()) {
    constexpr int NM = ND * 2;
    bf16x8 vall[ILV ? NM : 1];
    if (ILV) { if (opaque_i(pend)) {
#pragma unroll
        for (int i = 0; i < NM; ++i) vall[ILV ? i : 0] = vfrag(vprev, i); } }
    qk_half<NS, KPITCH, NG, Hook>(p, qf, qg, kb, hook);
    float mx = p[0];
#pragma unroll
    for (int r = 1; r < 16; ++r) mx = fmaxf(mx, p[r]);
    mx = half_max(mx);
    if (!__all(mx <= m + 6.0f)) {
        if (pend) { pv_plain<ND>(o, pf, vprev); pend = false; }
        const float mn = fmaxf(m, mx);
        const float alpha = __builtin_amdgcn_exp2f(m - mn);
        m = mn; l *= alpha;
#pragma unroll
        for (int d = 0; d < ND; ++d)
#pragma unroll
            for (int r = 0; r < 16; ++r) o[d][r] *= alpha;
    }
    bf16x8 pfn[2];
    float rs = 0.f;
    if (ILV) {
        constexpr int EPM = 16 / NM;
#pragma unroll
        for (int i = 0; i < NM; ++i) {
            if (opaque_i(pend)) o[i >> 1] = __builtin_amdgcn_mfma_f32_32x32x16_bf16(vall[ILV ? i : 0], pf[i & 1], o[i >> 1], 0, 0, 0);
#pragma unroll
            for (int e = 0; e < EPM; ++e) { const int idx = i * EPM + e; float x = p[idx];
                asm volatile("" : "+v"(x));
                x = __builtin_amdgcn_exp2f(x - m);
                asm volatile("" : "+v"(x));
                p[idx] = x; rs += x; }
            if (((i + 1) * EPM) % 8 == 0) { const int k = ((i + 1) * EPM) / 8 - 1; pfn[k] = packp(p, 8 * k); }
            __builtin_amdgcn_sched_barrier(0);
        }
    } else if (pend) {
        constexpr int EPM = 16 / NM;
        bf16x8 vr[3]; vr[0] = vfrag(vprev, 0); vr[1] = vfrag(vprev, 1);
#pragma unroll
        for (int i = 0; i < NM; ++i) {
            if (i + 2 < NM) vr[(i + 2) % 3] = vfrag(vprev, i + 2);
            o[i >> 1] = __builtin_amdgcn_mfma_f32_32x32x16_bf16(vr[i % 3], pf[i & 1], o[i >> 1], 0, 0, 0);
#pragma unroll
            for (int e = 0; e < EPM; ++e) { const int idx = i * EPM + e; p[idx] = __builtin_amdgcn_exp2f(p[idx] - m); rs += p[idx]; }
            if (((i + 1) * EPM) % 8 == 0) { const int k = ((i + 1) * EPM) / 8 - 1; pfn[k] = packp(p, 8 * k); }
            __builtin_amdgcn_sched_barrier(0);
        }
    } else {
        float m2 = m;
#if MK_NOHOIST
        asm volatile("" : "+v"(m2));
#endif
#pragma unroll
        for (int r = 0; r < 16; ++r) { p[r] = __builtin_amdgcn_exp2f(p[r] - m2); rs += p[r]; }
        pfn[0] = packp(p, 0); pfn[1] = packp(p, 8);
    }
    l += rs;
    pf[0] = pfn[0]; pf[1] = pfn[1];
    pend = true;
}
template <int ND>
__device__ __forceinline__ void load_gates(v2u (&gw)[ND * 4], const bf16* gate_row, int hi) {
#pragma unroll
    for (int i = 0; i < ND * 4; ++i) gw[i] = *(const v2u*)(gate_row + 32 * (i >> 2) + 8 * (i & 3) + 4 * hi);
    __builtin_amdgcn_sched_barrier(0);
}
template <int ND> __device__ __forceinline__ void store_o_g(const f32x16 (&o)[ND], const float inv, const v2u (&gw)[ND * 4], bf16* mix, size_t mix_row, int hi);
template <int ND>
__device__ __forceinline__ void store_o(const f32x16 (&o)[ND], float l, const bf16* gate_row, bf16* mix, size_t mix_row, int hi) {
    const float inv = 1.0f / half_sum(l);
    v2u gw[ND * 4];
    load_gates<ND>(gw, gate_row, hi);
    store_o_g<ND>(o, inv, gw, mix, mix_row, hi);
}
template <int ND>
__device__ __forceinline__ void store_o_g(const f32x16 (&o)[ND], const float inv, const v2u (&gw)[ND * 4], bf16* mix, size_t mix_row, int hi) {
#pragma unroll
    for (int d = 0; d < ND; ++d)
#pragma unroll
        for (int g4 = 0; g4 < 4; ++g4) {
            const int c = 32 * d + 8 * g4 + 4 * hi;
            const v2u g = gw[d * 4 + g4];
            const float g0 = bf2f(g.x & 0xffffu), g1 = bf2f(g.x >> 16), g2 = bf2f(g.y & 0xffffu), g3 = bf2f(g.y >> 16);
            v2u w; w.x = pk2(o[d][4 * g4] * inv * g0, o[d][4 * g4 + 1] * inv * g1); w.y = pk2(o[d][4 * g4 + 2] * inv * g2, o[d][4 * g4 + 3] * inv * g3);
            st8(mix, (mix_row + c) * 2, w);
        }
}
template <int ND>
__device__ __forceinline__ void load_gates_rows(v4u (&gw)[ND * 2], const bf16* gate_base, int lane) {
    constexpr int CPR = 4 * ND, RPI = 64 / CPR;
    const int rr = lane / CPR, ch = lane % CPR;
#pragma unroll
    for (int it = 0; it < ND * 2; ++it) gw[it] = *(const v4u*)(gate_base + (size_t)(it * RPI + rr) * DINP + ch * 8);
    __builtin_amdgcn_sched_barrier(0);
}
template <int ND>
__device__ __forceinline__ void store_o_rows(const f32x16 (&o)[ND], const float inv, const v4u (&gw)[ND * 2], LAS unsigned char* reg, bf16* mix_base, int lane) {
    constexpr int NC = 32 * ND, PITCH = NC * 4 + 16, CPR = 4 * ND, RPI = 64 / CPR;
    const int r32 = lane & 31, hi = lane >> 5, rr = lane / CPR, ch = lane % CPR;
#pragma unroll
    for (int d = 0; d < ND; ++d)
#pragma unroll
        for (int g4 = 0; g4 < 4; ++g4)
            *(LAS f32x4*)(reg + r32 * PITCH + (32 * d + 8 * g4 + 4 * hi) * 4) = (f32x4){o[d][4 * g4] * inv, o[d][4 * g4 + 1] * inv, o[d][4 * g4 + 2] * inv, o[d][4 * g4 + 3] * inv};
#pragma unroll
    for (int it = 0; it < ND * 2; ++it) {
        const int row = it * RPI + rr;
        const f32x4 a = *(const LAS f32x4*)(reg + row * PITCH + ch * 32), b = *(const LAS f32x4*)(reg + row * PITCH + ch * 32 + 16);
        float g[8]; unpack8(gw[it], g);
        float v[8] = {a.x * g[0], a.y * g[1], a.z * g[2], a.w * g[3], b.x * g[4], b.y * g[5], b.z * g[6], b.w * g[7]};
        *(v4u*)(mix_base + (size_t)row * DM + ch * 8) = pack8(v);
    }
}
}


__device__ __forceinline__ void fast_attn_a(const Frame& F, int L) {
    constexpr int KP = 144, KH = 64 * KP  , VH = 8192, STG = 2 * KH + 2 * VH  , TAB = 3 * STG;
    const bf16* Z = (const bf16*)(F.ws + WS_Z); bf16* MIX = (bf16*)(F.ws + ((L & 1) ? WS_BUFA : WS_BUFB));
    const float* rbias = inp<5>(F) + (size_t)L * 8 * 257;
    const int tid = F.tid, lane = F.lane, wave = F.wave, r32 = lane & 31, hi = lane >> 5;
    const int hsel = (wave >> 1) & 1, rb = (wave & 1) | ((wave >> 2) << 1);
    LAS float* tab = (LAS float*)(F.lds + TAB);
    const int vlane = (4 * hi + ((lane & 15) >> 2)) * 64 + ((lane >> 4) & 1) * 32 + (lane & 3) * 8;
    const int sc = tid & 15, sk = tid >> 4, shd = sc >> 3, scc = sc & 7;
    const int kdst0 = shd * KH + sk * KP + scc * 16, kdst1 = kdst0 + 32 * KP;
    const int vdst0 = 2 * KH + shd * VH + (scc >> 2) * 4096 + (sk >> 3) * 512 + (sk & 7) * 64 + (scc & 3) * 16, vdst1 = vdst0 + 4 * 512;
    const int nun = (F.G == 256) ? 4 : (1024 + F.G - 1 - F.vcu) / F.G;
    auto unit_id = [&](int ui) -> int {
        if (F.G == 256) { const int s = F.vcu & 3; const int blk = s + 4 * ui; return (F.vcu >> 2) * 16 + blk; }
        return F.vcu + ui * F.G; };
    v4u sA[4], sB[4]; bf16x8 qfn[4];
#define FAA_LOAD(S, KS, jj) do { const bf16* p_ = (KS) + (size_t)(64 * (jj)) * DINP; S[0] = *(const v4u*)p_; S[1] = *(const v4u*)(p_ + (size_t)32 * DINP); S[2] = *(const v4u*)(p_ + 512); S[3] = *(const v4u*)(p_ + (size_t)32 * DINP + 512); } while (0)
#define FAA_WRITE(S, stage) do { LAS unsigned char* sw_ = F.lds + (stage) * STG; *(LAS v4u*)(sw_ + kdst0) = S[0]; *(LAS v4u*)(sw_ + kdst1) = S[1]; *(LAS v4u*)(sw_ + vdst0) = S[2]; *(LAS v4u*)(sw_ + vdst1) = S[3]; } while (0)
#define FAA_PREFETCH(uidv) do { const int blk_ = (uidv) & 15, hp_ = ((uidv) >> 4) & 3, b_ = (uidv) >> 6; const int jlo_ = (2 * blk_ - 8 > 0) ? 2 * blk_ - 8 : 0; \
        const bf16* qp_ = Z + (size_t)(b_ * SEQ + blk_ * 128 + 32 * rb + r32) * DINP + ZC_QA + 64 * (2 * hp_ + hsel) + 8 * hi; \
        _Pragma("unroll") for (int s_ = 0; s_ < 4; ++s_) qfn[s_] = *(const bf16x8*)(qp_ + 16 * s_); \
        const bf16* ks_ = Z + (size_t)(b_ * SEQ + sk) * DINP + ZC_KA + 128 * hp_ + 8 * sc; FAA_LOAD(sB, ks_, jlo_); FAA_LOAD(sA, ks_, jlo_ + 1); } while (0)
    if (nun <= 0) return;
    int tab_hp = -1;
    FAA_PREFETCH(unit_id(0));
    for (int ui = 0; ui < nun; ++ui) {
        const int uid = unit_id(ui);
        const int blk = uid & 15, hp = (uid >> 4) & 3, b = uid >> 6;
        const int R0 = b * SEQ + blk * 128, h = 2 * hp + hsel;
        const int qrow = R0 + 32 * rb + r32, cq = 2 * blk + (rb >> 1), ql = 32 * (rb & 1) + r32;
        const int jlo = (2 * blk - 8 > 0) ? 2 * blk - 8 : 0, jhi = 2 * blk + 1;
        if (hp != tab_hp) { tab_hp = hp;
            for (int i = tid; i < 2 * 320; i += NTHREADS) { const int hh = i / 320, e = i - hh * 320; tab[hh * 324 + e] = rbias[(2 * hp + hh) * 257 + (e < 256 ? e : 256)] * LOG2E; } }
        bf16x8 qf[4];
#pragma unroll
        for (int s = 0; s < 4; ++s) qf[s] = qfn[s];
        const bf16* ksrc = Z + (size_t)(b * SEQ + sk) * DINP + ZC_KA + 128 * hp + 8 * sc;
        FAA_WRITE(sB, 0);
        __syncthreads();
        f32x16 o[2]; o[0] = (f32x16){}; o[1] = (f32x16){};
        float m = MK_NEGM ? 0.f : -1e30f, l = 0.f;
        const LAS float* tb = tab + hsel * 324;
        bf16x8 pf[2];
        bool pend = false;
#if MK_NEGM
        bool fresh = true;
        const float cb = tb[256];
        f32x16 cinit;
#pragma unroll
        for (int r = 0; r < 16; ++r) cinit[r] = cb;
#endif
#if MK_SP & 1
        f32x16 P0, P1; bool have = false;
#pragma unroll
        for (int r = 0; r < 16; ++r) P1[r] = -1e30f;
#endif
        int cur = 0, prv = 0;
        auto step = [&](const int j, v4u (&X)[4], v4u (&Y)[4]) {
            const int nxt = (cur == 2) ? 0 : cur + 1;
            FAA_LOAD(Y, ksrc, (j + 2 <= jhi) ? j + 2 : jhi);
            const int dj = cq - j; const bool valid = (dj >= 0 && dj <= 8);
            fa::lds_cptr sb = (fa::lds_cptr)(F.lds + cur * STG);
            fa::lds_cptr vprev = (fa::lds_cptr)(F.lds + prv * STG) + 2 * KH + hsel * VH + vlane;
            if (valid) {
                fa::lds_cptr kb = sb + hsel * KH + r32 * KP + hi * 16, vcur = sb + 2 * KH + hsel * VH + vlane;
#if MK_SP & 1
                const bool cst = dj >= 3;
                const int dq = ql + 64 * dj;
                const LAS float* lp = tb + (dq - 4 * hi - 27 + 128);
                auto lk0 = [&](f32x16& t) {
#pragma unroll
                    for (int r = 0; r < 16; ++r) t[r] = lp[27 - ((r & 3) + 8 * (r >> 2))] - m; };
                auto lk1 = [&](f32x16& t) {
#pragma unroll
                    for (int r = 0; r < 16; ++r) t[r] = (lp - 32)[27 - ((r & 3) + 8 * (r >> 2))] - m; };
                fa::half_step_sp<4, 2, KP, true, true>(P0, P1, qf, o, m, l, fresh, cinit, cb, cst, lk0, kb, vprev + 2048);
                fa::half_step_sp<4, 2, KP, true, true>(P1, P0, qf, o, m, l, fresh, cinit, cb, cst, lk1, kb + 32 * KP, vcur);
                have = true;
#elif MK_NEGM
                f32x16 p0, p1;
                const bool cst = dj >= 3;
                const int dq = ql + 64 * dj;
                const LAS float* lp = tb + (dq - 4 * hi - 27 + 128);
                auto lk0 = [&](f32x16& t) {
#pragma unroll
                    for (int r = 0; r < 16; ++r) t[r] = lp[27 - ((r & 3) + 8 * (r >> 2))] - m; };
                auto lk1 = [&](f32x16& t) {
#pragma unroll
                    for (int r = 0; r < 16; ++r) t[r] = (lp - 32)[27 - ((r & 3) + 8 * (r >> 2))] - m; };
                fa::half_step_nm<4, 2, KP>(p0, qf, o, m, l, pf, pend, fresh, cinit, cb, cst, lk0, kb, vprev + 2048);
                fa::half_step_nm<4, 2, KP>(p1, qf, o, m, l, pf, pend, fresh, cinit, cb, cst, lk1, kb + 32 * KP, vcur);
#else
                f32x16 p0, p1;
                if (dj >= 3) { const float c = tb[256];
#pragma unroll
                    for (int r = 0; r < 16; ++r) { p0[r] = c; p1[r] = c; } }
                else {
#pragma unroll
                    for (int r = 0; r < 16; ++r) { const int kvl = (r & 3) + 8 * (r >> 2) + 4 * hi; int d0 = ql + 64 * dj - kvl, d1 = d0 - 32;
                        d0 = d0 > 128 ? 128 : d0; d1 = d1 > 128 ? 128 : d1; p0[r] = tb[d0 + 128]; p1[r] = tb[d1 + 128]; }
                }
                fa::half_step<4, 2, KP, 0, false>(p0, qf, nullptr, o, m, l, pf, pend, kb, vprev + 2048);
                fa::half_step<4, 2, KP, 0, false>(p1, qf, nullptr, o, m, l, pf, pend, kb + 32 * KP, vcur);
#endif
            }
#if MK_SP & 1
            else if (have) { fa::flush_sp<2>(P1, o, l, vprev + 2048);
#pragma unroll
                for (int r = 0; r < 16; ++r) P1[r] = -1e30f;
                have = false; }
#else
            else if (pend) { fa::pv_plain<2>(o, pf, vprev + 2048); pend = false; }
#endif
            if (j < jhi) FAA_WRITE(X, nxt);
            __syncthreads();
            prv = cur; cur = nxt;
        };
        for (int j = jlo; j <= jhi; j += 2) { step(j, sA, sB); step(j + 1, sB, sA); }
        FAA_PREFETCH(unit_id((ui + 1 < nun) ? ui + 1 : ui));
#if MK_OROWS
        v4u gwr[4];
        fa::load_gates_rows<2>(gwr, Z + (size_t)(qrow - r32) * DINP + ZC_GA + 64 * h, lane);
#else
        v2u gw[8];
        fa::load_gates<2>(gw, Z + (size_t)qrow * DINP + ZC_GA + 64 * h, hi);
#endif
#if MK_SP & 1
        if (have) fa::flush_sp<2>(P1, o, l, (fa::lds_cptr)(F.lds + prv * STG) + 2 * KH + hsel * VH + vlane + 2048);
#else
        if (pend) fa::pv_plain<2>(o, pf, (fa::lds_cptr)(F.lds + prv * STG) + 2 * KH + hsel * VH + vlane + 2048);
#endif
#if MK_OROWS
        __syncthreads();
        fa::store_o_rows<2>(o, 1.0f / fa::half_sum(l), gwr, F.lds + wave * 8704, MIX + (size_t)(qrow - r32) * DM + 64 * h, lane);
#else
        fa::store_o_g<2>(o, 1.0f / fa::half_sum(l), gw, MIX, (size_t)qrow * DM + 64 * h, hi);
#endif
        __syncthreads();
    }
#undef FAA_LOAD
#undef FAA_WRITE
#undef FAA_PREFETCH
}

__device__ __forceinline__ void fast_attn_b(const Frame& F, int L) {
    constexpr int KP = 400, KB = 64 * KP  , STG = KB + 16384  ;
    const bf16* Z = (const bf16*)(F.ws + WS_Z); const bf16* U = (const bf16*)(F.ws + WS_U); bf16* MIX = (bf16*)(F.ws + ((L & 1) ? WS_BUFA : WS_BUFB));
    const int wave = F.wave;
    const int nun = (F.G == 256) ? 2 : (512 + F.G - 1 - F.vcu) / F.G;
    for (int ui = 0; ui < nun; ++ui) {
        int tid = F.tid; asm volatile("" : "+v"(tid));
        const int lane = tid & 63, r32 = lane & 31, hi = lane >> 5;
        const int vlane = (4 * hi + ((lane & 15) >> 2)) * 64 + ((lane >> 4) & 1) * 32 + (lane & 3) * 8;
        const int skey = tid >> 3, c8 = tid & 7;
        const int kdst = skey * KP + c8 * 16;
        const int vdst = KB + (c8 >> 2) * 4096 + (skey >> 3) * 512 + (skey & 7) * 64 + (c8 & 3) * 16;
        int uid;
        if (F.G == 256) { const int s = F.vcu & 3; uid = (F.vcu >> 2) * 8 + ((ui == 0) ? 7 - s : s); }
        else uid = F.vcu + ui * F.G;
        const int qb = uid & 7, h = (uid >> 3) & 3, b = uid >> 5;
        const int R0 = b * SEQ + qb * 256, qrow = R0 + 32 * wave + r32, cq = 4 * qb + (wave >> 1), jhi = 4 * qb + 3;
        bf16x8 qf[12];
#pragma unroll
        for (int s = 0; s < 8; ++s) qf[s] = *(const bf16x8*)(U + (size_t)qrow * DUP + UC_QN + 128 * h + 16 * s + 8 * hi);
#pragma unroll
        for (int s = 0; s < 4; ++s) qf[8 + s] = *(const bf16x8*)(U + (size_t)qrow * DUP + UC_QR + 64 * h + 16 * s + 8 * hi);
        const bf16* kn = U + (size_t)(b * SEQ + skey) * DUP + UC_KN + 128 * h + 8 * c8;
        const bf16* kr = Z + (size_t)(b * SEQ + skey) * DINP + ZC_KR + 8 * c8;
        const bf16* vs = U + (size_t)(b * SEQ + skey) * DUP + UC_V + 128 * h + 8 * c8;
        v4u st[5];
        st[0] = *(const v4u*)kn; st[1] = *(const v4u*)(kn + 64); st[2] = *(const v4u*)kr; st[3] = *(const v4u*)vs; st[4] = *(const v4u*)(vs + 64);
        { LAS unsigned char* sb = F.lds;
          *(LAS v4u*)(sb + kdst) = st[0]; *(LAS v4u*)(sb + kdst + 128) = st[1]; *(LAS v4u*)(sb + kdst + 256) = st[2]; *(LAS v4u*)(sb + vdst) = st[3]; *(LAS v4u*)(sb + vdst + 8192) = st[4]; }
        __syncthreads();
        f32x16 o[4]; o[0] = (f32x16){}; o[1] = (f32x16){}; o[2] = (f32x16){}; o[3] = (f32x16){};
        float m = -1e30f, l = 0.f;
        bf16x8 pf[2];
        bool pend = false;
        int cur = 0, prv = 0;
        for (int j = 0; j <= jhi; ++j) {
            const int nxt = (cur == 2) ? 0 : cur + 1;
            fa::lds_cptr sb = (fa::lds_cptr)(F.lds + cur * STG);
            fa::lds_cptr vprev = (fa::lds_cptr)(F.lds + prv * STG) + KB + vlane;
            const bool valid = j <= cq;
            if (valid) { f32x16 p = (f32x16){}; fa::half_step<12, 4, KP>(p, qf, nullptr, o, m, l, pf, pend, sb + r32 * KP + hi * 16, vprev + 2048); }
            else if (pend) { fa::pv_plain<4>(o, pf, vprev + 2048); pend = false; }
            if (j < jhi) { const size_t ou = (size_t)(64 * (j + 1)) * DUP, oz = (size_t)(64 * (j + 1)) * DINP;
                st[0] = *(const v4u*)(kn + ou); st[1] = *(const v4u*)(kn + ou + 64); st[2] = *(const v4u*)(kr + oz); st[3] = *(const v4u*)(vs + ou); st[4] = *(const v4u*)(vs + ou + 64); }
            if (valid) { f32x16 p = (f32x16){}; fa::half_step<12, 4, KP>(p, qf, nullptr, o, m, l, pf, pend, sb + (32 + r32) * KP + hi * 16, sb + KB + vlane); }
            if (j < jhi) { LAS unsigned char* sw = F.lds + nxt * STG;
                *(LAS v4u*)(sw + kdst) = st[0]; *(LAS v4u*)(sw + kdst + 128) = st[1]; *(LAS v4u*)(sw + kdst + 256) = st[2]; *(LAS v4u*)(sw + vdst) = st[3]; *(LAS v4u*)(sw + vdst + 8192) = st[4]; }
            __syncthreads();
            prv = cur; cur = nxt;
        }
        if (pend) fa::pv_plain<4>(o, pf, (fa::lds_cptr)(F.lds + prv * STG) + KB + vlane + 2048);
        fa::store_o<4>(o, l, Z + (size_t)qrow * DINP + ZC_GB + 128 * h, MIX, (size_t)qrow * DM + 512 + 128 * h, hi);
        __syncthreads();
    }
}
__device__ __forceinline__ void fast_gemm_final(const Frame& F, const bf16* A, const bf16* Bt, const pg8::FinalEpi& E) {
    pg8::Gemm g{A, DM, Bt, T, DM, DM, 0, 0}; pg8::StaticOrder S; S.init(T, DM, F.G, F.bx);
    pg8::gemm_phase<pg8::FinalEpi>(F.lds, F.tid, g, S, E);
}
#if MK_ABSORB
__device__ __forceinline__ void fast_attn_b_abs(const Frame& F, int L) {
    constexpr int KP = 400, KB = 64 * KP  , STG = KB + 16384  ;
    const bf16* Z = (const bf16*)(F.ws + WS_Z); const bf16* U = (const bf16*)(F.ws + WS_U); const bf16* CK = (const bf16*)(F.ws + WS_CKVN); bf16* MIX = (bf16*)(F.ws + ((L & 1) ? WS_BUFA : WS_BUFB));
    const bf16* WVT = (const bf16*)(F.ws + WS_WVT) + (size_t)L * 65536;
    const int wave = F.wave, h = wave >> 1, rbk = wave & 1;
    const int nun = (F.G == 256) ? 2 : (512 + F.G - 1 - F.vcu) / F.G;
    auto unit_id = [&](int ui) -> int { if (F.G == 256) { const int s = F.vcu & 15; return (F.vcu >> 4) * 32 + ((ui == 0) ? 31 - s : s); } return F.vcu + ui * F.G; };
    v4u sA[3], sB[3];
#define FAB_LOADP(S, KN, KR, jj) do { const size_t ou_ = (size_t)(64 * (jj)) * 128, oz_ = (size_t)(64 * (jj)) * DINP; S[0] = *(const v4u*)((KN) + ou_); S[1] = *(const v4u*)((KN) + ou_ + 32 * 128); S[2] = *(const v4u*)((KR) + oz_); } while (0)
    if (nun <= 0) return;
    { const int u0 = unit_id(0), b0 = u0 >> 5, c0 = u0 & 31, skey0 = F.tid >> 3, c80 = F.tid & 7, key20 = F.tid >> 4, c160 = F.tid & 15;
        const bf16* kn0 = CK + (size_t)(b0 * SEQ + key20) * 128 + 8 * c160; const bf16* kr0 = Z + (size_t)(b0 * SEQ + skey0) * DINP + ZC_KR + 8 * c80;
        FAB_LOADP(sB, kn0, kr0, 0); FAB_LOADP(sA, kn0, kr0, (c0 >= 1) ? 1 : 0); }
    for (int ui = 0; ui < nun; ++ui) {
        int tid = F.tid; asm volatile("" : "+v"(tid));
        const int lane = tid & 63, r32 = lane & 31, hi = lane >> 5;
        const int vlane = (4 * hi + ((lane & 15) >> 2)) * 64 + ((lane >> 4) & 1) * 32 + (lane & 3) * 8;
        const int skey = tid >> 3, c8 = tid & 7;
        const int key2 = tid >> 4, c16 = tid & 15;
        const int kdst = key2 * KP + c16 * 16, krdst = skey * KP + 256 + c8 * 16;
        const int vdst = KB + (c16 >> 2) * 4096 + (key2 >> 3) * 512 + (key2 & 7) * 64 + (c16 & 3) * 16;
        const int uid = unit_id(ui);
        const int c = uid & 31, b = uid >> 5;
        const int qrow = b * SEQ + 64 * c + 32 * rbk + r32, jhi = c;
        bf16x8 qf[12];
#pragma unroll
        for (int s = 0; s < 8; ++s) qf[s] = *(const bf16x8*)(U + (size_t)qrow * DUP + UC_QN + 128 * h + 16 * s + 8 * hi);
#pragma unroll
        for (int s = 0; s < 4; ++s) qf[8 + s] = *(const bf16x8*)(U + (size_t)qrow * DUP + UC_QR + 64 * h + 16 * s + 8 * hi);
        const bf16* kn = CK + (size_t)(b * SEQ + key2) * 128 + 8 * c16;
        const bf16* kr = Z + (size_t)(b * SEQ + skey) * DINP + ZC_KR + 8 * c8;
#define FAB_LOAD(S, jj) FAB_LOADP(S, kn, kr, jj)
#define FAB_WRITE(S, stage) do { LAS unsigned char* sw_ = F.lds + (stage) * STG; *(LAS v4u*)(sw_ + kdst) = S[0]; *(LAS v4u*)(sw_ + kdst + 32 * KP) = S[1]; *(LAS v4u*)(sw_ + krdst) = S[2]; *(LAS v4u*)(sw_ + vdst) = S[0]; *(LAS v4u*)(sw_ + vdst + 2048) = S[1]; } while (0)
        FAB_WRITE(sB, 0);
        __syncthreads();
#pragma unroll
        for (int s = 0; s < 12; ++s) asm volatile("" : "+v"(qf[s]));
        f32x16 o[4]; o[0] = (f32x16){}; o[1] = (f32x16){}; o[2] = (f32x16){}; o[3] = (f32x16){};
#if MK_SP & 2
        float m = -1e30f, l = 0.f;
        bool fresh = false;
        f32x16 cinit, P0, P1;
#pragma unroll
        for (int r = 0; r < 16; ++r) P1[r] = -3e38f;
#else
        float m = -1e30f, l = 0.f;
        bf16x8 pf[2];
        bool pend = false;
#endif
        int cur = 0, prv = 0;
        auto step = [&](const int j, v4u (&X)[3], v4u (&Y)[3]) {
            const int nxt = (cur == 2) ? 0 : cur + 1;
            fa::lds_cptr sb = (fa::lds_cptr)(F.lds + cur * STG);
            fa::lds_cptr vprev = (fa::lds_cptr)(F.lds + prv * STG) + KB + vlane;
#if MK_SP & 2
            fa::half_step_sp<12, 4, KP, false, false>(P0, P1, qf, o, m, l, fresh, cinit, 0.f, true, fa::NoLookup(), sb + r32 * KP + hi * 16, vprev + 2048);
            FAB_LOAD(Y, (j + 2 <= jhi) ? j + 2 : jhi);
            fa::half_step_sp<12, 4, KP, false, false>(P1, P0, qf, o, m, l, fresh, cinit, 0.f, true, fa::NoLookup(), sb + (32 + r32) * KP + hi * 16, sb + KB + vlane);
#else
            { f32x16 p = (f32x16){}; fa::half_step<12, 4, KP>(p, qf, nullptr, o, m, l, pf, pend, sb + r32 * KP + hi * 16, vprev + 2048); }
            FAB_LOAD(Y, (j + 2 <= jhi) ? j + 2 : jhi);
            { f32x16 p = (f32x16){}; fa::half_step<12, 4, KP>(p, qf, nullptr, o, m, l, pf, pend, sb + (32 + r32) * KP + hi * 16, sb + KB + vlane); }
#endif
            FAB_WRITE(X, nxt);
            __syncthreads();
            prv = cur; cur = nxt;
        };
        { int j = 0;
            for (; j + 1 <= jhi; j += 2) { step(j, sA, sB); step(j + 1, sB, sA); }
            if (j <= jhi) step(j, sA, sB); }
        { const int un = unit_id((ui + 1 < nun) ? ui + 1 : ui), bn = un >> 5, cn = un & 31;
            const bf16* knn = CK + (size_t)(bn * SEQ + key2) * 128 + 8 * c16; const bf16* krn = Z + (size_t)(bn * SEQ + skey) * DINP + ZC_KR + 8 * c8;
            FAB_LOADP(sB, knn, krn, 0); FAB_LOADP(sA, knn, krn, (cn >= 1) ? 1 : 0); }
#undef FAB_LOAD
#undef FAB_WRITE
#if MK_SP & 2
        fa::flush_sp<4>(P1, o, l, (fa::lds_cptr)(F.lds + prv * STG) + KB + vlane + 2048, m);
#else
        if (pend) fa::pv_plain<4>(o, pf, (fa::lds_cptr)(F.lds + prv * STG) + KB + vlane + 2048);
#endif
        const float inv = 1.0f / fa::half_sum(l);
        bf16x8 bfr[4][2];
#pragma unroll
        for (int d = 0; d < 4; ++d)
#pragma unroll
            for (int sx = 0; sx < 2; ++sx) { v4u w; w.x = pk2(o[d][8 * sx] * inv, o[d][8 * sx + 1] * inv); w.y = pk2(o[d][8 * sx + 2] * inv, o[d][8 * sx + 3] * inv);
                w.z = pk2(o[d][8 * sx + 4] * inv, o[d][8 * sx + 5] * inv); w.w = pk2(o[d][8 * sx + 6] * inv, o[d][8 * sx + 7] * inv); bfr[d][sx] = __builtin_bit_cast(bf16x8, w); }
        f32x16 y[4]; y[0] = (f32x16){}; y[1] = (f32x16){}; y[2] = (f32x16){}; y[3] = (f32x16){};
        const bf16* wv = WVT + (size_t)h * 16384 + (hi * 32 + r32) * 8;
#if MK_OROWS
        v4u gwa[4], gwb[4];
        fa::load_gates_rows<2>(gwa, Z + (size_t)(qrow - r32) * DINP + ZC_GB + 128 * h, lane);
        fa::load_gates_rows<2>(gwb, Z + (size_t)(qrow - r32) * DINP + ZC_GB + 128 * h + 64, lane);
        __syncthreads();
#else
        v2u gw[16];
        fa::load_gates<4>(gw, Z + (size_t)qrow * DINP + ZC_GB + 128 * h, hi);
#endif
        bf16x8 wa[2][8];
#pragma unroll
        for (int i = 0; i < 8; ++i) wa[0][i] = *(const bf16x8*)(wv + (i * 2) * 256);
        __builtin_amdgcn_sched_barrier(0);
#pragma unroll
        for (int blk = 0; blk < 4; ++blk) {
            if (blk + 1 < 4) {
#pragma unroll
                for (int i = 0; i < 8; ++i) wa[(blk + 1) & 1][i] = *(const bf16x8*)(wv + ((((blk + 1) * 8 + i)) * 2) * 256);
            }
            __builtin_amdgcn_sched_barrier(0);
#pragma unroll
            for (int i = 0; i < 8; ++i) y[blk] = __builtin_amdgcn_mfma_f32_32x32x16_bf16(wa[blk & 1][i], bfr[i >> 1][i & 1], y[blk], 0, 0, 0);
            __builtin_amdgcn_sched_barrier(0);
        }
#if MK_OROWS
        { const f32x16 (&ya)[2] = *reinterpret_cast<const f32x16 (*)[2]>(&y[0]); const f32x16 (&yb)[2] = *reinterpret_cast<const f32x16 (*)[2]>(&y[2]);
          fa::store_o_rows<2>(ya, 1.0f, gwa, F.lds + wave * 8704, MIX + (size_t)(qrow - r32) * DM + 512 + 128 * h, lane);
          fa::store_o_rows<2>(yb, 1.0f, gwb, F.lds + wave * 8704, MIX + (size_t)(qrow - r32) * DM + 512 + 128 * h + 64, lane); }
#else
        fa::store_o_g<4>(y, 1.0f, gw, MIX, (size_t)qrow * DM + 512 + 128 * h, hi);
#endif
        __syncthreads();
    }
}
#endif

__device__ __forceinline__ void final_norm(const Frame& F) {
    const float* ssq = (const float*)(F.ws + WS_SSQ2); const float* nf = inp<15>(F);
    const int gw = F.vcu * NWAVES + F.wave, NGW = F.G * NWAVES;
    for (int m = gw; m < T; m += NGW) {
        float s = (F.lane < 32) ? ssq[(size_t)m * 32 + F.lane] : 0.f; s = wave_sum(s);
        const float r = rsqrtf(s * (1.0f / DM) + EPS);
        f32x4* o = (f32x4*)(F.out + (size_t)m * DM) + F.lane; const f32x4* g = (const f32x4*)nf + F.lane;
#pragma unroll
        for (int j = 0; j < 4; ++j) { f32x4 v = o[64 * j]; const f32x4 gg = g[64 * j]; v.x *= r * gg.x; v.y *= r * gg.y; v.z *= r * gg.z; v.w *= r * gg.w; o[64 * j] = v; }
    }
}

constexpr int N_PHASES = 12;
constexpr bool FUSE_FINAL_OK = (MK_FUSE_FINAL && !(MK_NAIVE & 1));
constexpr int CW_PANEL = 16384; static_assert(CW_PANEL == 16384, "FinalEpi hard-codes it");
__global__ void __launch_bounds__(NTHREADS, 2) trunk_fwd(Args args) {
    extern __shared__ __attribute__((aligned(16))) unsigned char lds[];
    const int G = gridDim.x; int vcu; { const int bx = blockIdx.x; vcu = (G % 8 == 0) ? (bx % 8) * (G / 8) + bx / 8 : bx; }
    volatile LAS unsigned* MISC = (volatile LAS unsigned*)((LAS unsigned char*)lds + MISC_OFF);
    for (int u = threadIdx.x; u < (LDS_BYTES - LDSCTL_OFF) / 4; u += NTHREADS) ((LAS unsigned*)((LAS unsigned char*)lds + LDSCTL_OFF))[u] = 0u;
    __syncthreads();
    const int wave0 = __builtin_amdgcn_readfirstlane((int)(threadIdx.x >> 6));
    XcdBarrier bar; bar.bar = (unsigned*)(args.ws + WS_CTL) + CW_BAR; bar.x = 0; bar.st = nullptr;
    if (MK_N_LAUNCHES == 1) bar = xcd_barrier_post((unsigned*)(args.ws + WS_CTL) + CW_BAR, MISC + 8);

    for (int ph = args.ph_lo; ph < args.ph_hi; ++ph) {
        Frame F; F.a = &args; F.G = opaque_i(G); F.vcu = opaque_i(vcu); F.bx = opaque_i((int)blockIdx.x);
        { const int wv = opaque_i(wave0);
          int tid = wv * 64 + (int)__builtin_amdgcn_mbcnt_hi(~0u, __builtin_amdgcn_mbcnt_lo(~0u, 0u)); asm volatile("" : "+v"(tid)); F.tid = tid; F.lane = tid & 63; F.wave = __builtin_amdgcn_readfirstlane(tid >> 6); }
        { GAS unsigned char* w = (GAS unsigned char*)args.ws; asm volatile("" : "+s"(w)); F.ws = (unsigned char*)w; }
        { GAS float* o = (GAS float*)args.out; asm volatile("" : "+s"(o)); F.out = (float*)o; }
        { unsigned lb = 0; asm volatile("" : "+s"(lb)); F.lds = (LAS unsigned char*)lds + lb; }
        bf16* Z = (bf16*)(F.ws + WS_Z); bf16* U = (bf16*)(F.ws + WS_U); bf16* PE = (bf16*)(F.ws + WS_Z);
        float* SSQ1 = (float*)(F.ws + WS_SSQ1); float* SSQ2 = (float*)(F.ws + WS_SSQ2); float* SSQQ = (float*)(F.ws + WS_SSQQ); float* SSQKV = (float*)(F.ws + WS_SSQKV);
        const f32x2* CS = (const f32x2*)(F.ws + WS_CS);
        if (opaque_i(ph) == 0) { REP(0) p0_prologue(F); }
        else if (opaque_i(ph) == N_PHASES - 1) final_norm(F);
        else {
            const int L = (ph - 1) / 5; int kind = (ph - 1) % 5;
#ifdef MK_ONLY
            if (kind != MK_ONLY) kind = 99;
#endif
            bf16* HIN = (bf16*)(F.ws + ((L & 1) ? WS_BUFB : WS_BUFA));
            bf16* MIX = (bf16*)(F.ws + ((L & 1) ? WS_BUFA : WS_BUFB));
            if (opaque_i(kind) == 0) {
                EpiP1 E{Z, SSQ2, SSQQ, SSQKV, CS};
                if (!(MK_NAIVE & 1)) { E.rs_lds = (const LAS float*)(F.lds + LDSCTL_OFF + 4096); E.rs_ok = rs_prepass(F, SSQ2, DINP); relaunder(F); }
                const bf16* Bt = (const bf16*)(F.ws + WS_WIN) + (size_t)L * DINP * DM;
                REP(1) { if (MK_NAIVE & 1) naive_gemm(F, HIN, DM, Bt, DM, DINP, E);
                else fast_gemm(F, HIN, DM, Bt, DM, DINP, E); }
            } else if (opaque_i(kind) == 1) {
                EpiUp E{U, SSQQ, SSQKV, CS};
                const bf16* Bt = (const bf16*)(F.ws + WS_WUP) + (size_t)L * DUP * KUP;
#if !defined(MK_SUB) || MK_SUB == 0
                REP(2) { if (MK_NAIVE & 1) naive_gemm(F, Z + ZC_CQ, DINP, Bt, KUP, DUP, E);
                else {
                    int deal = -1;
                    if (F.G == 256) deal = ((F.vcu & 2) ? 128 : 0) + (F.vcu >> 2) * 2 + (F.vcu & 1);
                    if (MK_ABSORB) fast_gemm(F, Z + ZC_CQ, DINP, Bt, KUP, DUP, E, 0, 0, deal);
                    else fast_gemm(F, Z + ZC_CQ, DINP, Bt, KUP, DUP, E, 3, 4, deal); } }
#if MK_ABSORB
                ckvn_pass(F, L);
#endif
#endif
                __syncthreads();
                relaunder(F);
#if !defined(MK_SUB) || MK_SUB == 1
                REP(3) { if (MK_NAIVE & 2) naive_attn_a(F, L); else fast_attn_a(F, L); }
#endif
            } else if (opaque_i(kind) == 2) {
#if MK_ABSORB
                REP(4) { if (MK_NAIVE & 4) naive_attn_b_abs(F, L); else fast_attn_b_abs(F, L); }
#else
                REP(4) { if (MK_NAIVE & 4) naive_attn_b(F, L); else fast_attn_b(F, L); }
#endif
            } else if (opaque_i(kind) == 3) {
                const int grp = MK_STAG_US > 0 ? (F.bx >> 3) & 1 : 0;
#define P4_PE() do { EpiPe E0{(bf16*)(F.ws + WS_Z)}; \
                        const bf16* Bpe = (const bf16*)(F.ws + WS_WPE) + (size_t)L * DM * DPLE; \
                        const bf16* PBl = (const bf16*)(F.ws + WS_PB) + (size_t)L * T * DPLE; \
                        REP(5) { if (MK_NAIVE & 1) naive_gemm(F, PBl, DPLE, Bpe, DPLE, DM, E0); \
                        else fast_gemm(F, PBl, DPLE, Bpe, DPLE, DM, E0); } } while (0)
#define P4_OUT() do { bf16* HIN2 = (bf16*)(F.ws + ((L & 1) ? WS_BUFB : WS_BUFA)); bf16* MIX2 = (bf16*)(F.ws + ((L & 1) ? WS_BUFA : WS_BUFB)); \
                        EpiOut E1{(MK_RES32 && L == 0) ? inp<0>(F) : (const float*)nullptr, HIN2, (const bf16*)F.out, HIN2, (bf16*)(F.ws + WS_LO1), (float*)(F.ws + WS_SSQ1)}; \
                        const bf16* Bo = (const bf16*)(F.ws + WS_WOUT) + (size_t)L * DM * DM; \
                        if (MK_NAIVE & 1) naive_gemm(F, MIX2, DM, Bo, DM, DM, E1); \
                        else fast_gemm(F, MIX2, DM, Bo, DM, DM, E1); } while (0)
                if (grp == 0) { P4_PE(); __syncthreads(); relaunder(F); P4_OUT(); }
                else { P4_OUT(); __syncthreads(); relaunder(F); P4_PE(); }
#undef P4_PE
#undef P4_OUT
            } else if (opaque_i(kind) == 4) {
                if (MK_STAG_US > 0 && ((F.bx >> 3) & 1)) {
                    const unsigned long long t0 = __builtin_amdgcn_s_memrealtime();
                    while (__builtin_amdgcn_s_memrealtime() - t0 < (unsigned long long)(MK_STAG_US * 100)) __builtin_amdgcn_s_sleep(32);
                }
                const bf16* Bg = (const bf16*)(F.ws + WS_WPG) + (size_t)L * DM * DM;
                if (FUSE_FINAL_OK && args.pad != 0 && L == DEPTH - 1) {
                    pg8::FinalEpi EF{F.out, F.ws, inp<14>(F) + (size_t)L * DM, inp<15>(F)};
                    EF.rs_lds = (const LAS float*)(F.lds + LDSCTL_OFF + 4096); EF.rs_ok = rs_prepass(F, SSQ1, DM); relaunder(F);
                    fast_gemm_final(F, HIN, Bg, EF);
                } else {
                EpiGate E{HIN, (const bf16*)(F.ws + WS_LO1), (L == DEPTH - 1) ? F.out : (float*)nullptr, MIX, (bf16*)F.out, PE, inp<14>(F) + (size_t)L * DM, SSQ1, SSQ2};
                if (!(MK_NAIVE & 1)) { E.rs_lds = (const LAS float*)(F.lds + LDSCTL_OFF + 4096); E.rs_ok = rs_prepass(F, SSQ1, DM); relaunder(F); }
                if (MK_NAIVE & 1) naive_gemm(F, HIN, DM, Bg, DM, DM, E);
                else fast_gemm(F, HIN, DM, Bg, DM, DM, E);
                }
            }
        }
        if (ph + 1 < args.ph_hi) { xcd_barrier(bar, F.tid);
#if MK_PROBE == 4
            xcd_barrier(bar, F.tid);
#endif
        }
    }
}

extern "C" void kernel_launch(void* const* d_in, const int* in_sizes, int n_in, void* d_out, int out_size, void* d_ws, size_t ws_size, hipStream_t stream) {
    static int grid = 0;
    if (grid == 0) {
        if (n_in != 16 || in_sizes[0] != T * DM || out_size != T * DM || ws_size < WS_END) {
            fprintf(stderr, "kernel_launch: unexpected shapes (n_in %d, in0 %d, out %d, ws %zu); nothing launched\n", n_in, n_in > 0 ? in_sizes[0] : -1, out_size, ws_size); grid = -1; return; }
        int dev = 0, cus = 0, per_cu = 0;
        if (hipGetDevice(&dev) != hipSuccess || hipDeviceGetAttribute(&cus, hipDeviceAttributeMultiprocessorCount, dev) != hipSuccess) { grid = -1; return; }
        if (hipFuncSetAttribute((const void*)trunk_fwd, hipFuncAttributeMaxDynamicSharedMemorySize, LDS_BYTES) != hipSuccess) { fprintf(stderr, "kernel_launch: hipFuncSetAttribute failed\n"); grid = -1; return; }
        if (hipOccupancyMaxActiveBlocksPerMultiprocessor(&per_cu, (const void*)trunk_fwd, NTHREADS, LDS_BYTES) != hipSuccess || per_cu < 1)
            fprintf(stderr, "kernel_launch: note: occupancy query reports %d workgroups per CU\n", per_cu);
        (void)hipGetLastError();
        grid = cus;
    }
    if (grid < 0) return;
    if (hipMemsetAsync((char*)d_ws + WS_CTL, 0, CTL_ZERO_BYTES, stream) != hipSuccess) { fprintf(stderr, "kernel_launch: hipMemsetAsync failed\n"); return; }
    Args a{};
    const bool fuse_final = FUSE_FINAL_OK && grid == 256 && MK_N_LAUNCHES == 1;
    a.pad = fuse_final ? 1 : 0;
    for (int i = 0; i < 16; ++i) a.in[i] = d_in[i];
    a.out = (float*)d_out; a.ws = (unsigned char*)d_ws;
    for (int li = 0; li < MK_N_LAUNCHES; ++li) {
        a.ph_lo = (MK_N_LAUNCHES == 1) ? 0 : li; a.ph_hi = (MK_N_LAUNCHES == 1) ? (fuse_final ? N_PHASES - 1 : N_PHASES) : li + 1; a.li = li;
        hipLaunchKernelGGL(trunk_fwd, dim3(grid), dim3(NTHREADS), LDS_BYTES, stream, a);
        const hipError_t le = hipPeekAtLastError();
        if (le != hipSuccess) { fprintf(stderr, "kernel_launch: launch %d failed: %s\n", li, hipGetErrorName(le)); break; }
    }
}
```
